# Optimizing an MI355X kernel written in HIP

```python
import math, functools
import jax, jax.numpy as jnp
from jax import lax
import numpy as np

D_MODEL = 1024
BATCH = 4
SEQ = 4096
DEPTH = 2
DEC_BATCH = 32
DEC_SEQ = 4
PAST_LEN = 8192
PAGE_SIZE = 128

HEAD_DIM = 64
H_A = 6
H_B = 6
H_C = 4
W_A = H_A * HEAD_DIM
W_B = H_B * HEAD_DIM
W_C = H_C * HEAD_DIM
MIX_WIDTH = W_A + W_B + W_C
LORA_W = 64
LORA_A = 64
LORA_G = 128
A_COLS = 3 * W_A + LORA_W + LORA_A + LORA_G
B_COLS = 3 * W_B
C_COLS = 4 * W_C
IN_COLS = A_COLS + B_COLS + C_COLS
DILATED = ((128, 1), (512, 4), (2048, 16))
WIN_MAX = max(w for w, _ in DILATED)
ROT_DIM = HEAD_DIM // 4
ROPE_THETA = 500000.0
RET_THETA = 10000.0
RET_CHUNK = 128
D_FF = -(-8 * D_MODEL // (3 * 256)) * 256
DEEPNORM_ALPHA = (2 * DEPTH) ** 0.25
DEEPNORM_BETA = (8 * DEPTH) ** -0.25
RWKV_DECAY_SCALE = math.exp(-0.5)
RWKV_GN_EPS = 64e-5
LN_EPS = 1e-5
NEG = -1e30

kernel_name = 'hybrid_rwkv7_dilated_retention_step'

F32 = jnp.float32


def _layer_norm(x, g, b):
    mu = jnp.mean(x, axis=-1, keepdims=True)
    var = jnp.mean(jnp.square(x - mu), axis=-1, keepdims=True)
    return (x - mu) * lax.rsqrt(var + LN_EPS) * g + b


def _head_norm(x, g, b, eps):
    h, e = x.shape[-2], x.shape[-1]
    mu = jnp.mean(x, axis=-1, keepdims=True)
    var = jnp.mean(jnp.square(x - mu), axis=-1, keepdims=True)
    return (x - mu) * lax.rsqrt(var + eps) * g.reshape(h, e) + b.reshape(h, e)


def _rope_inv_freq():
    return ROPE_THETA ** (-jnp.arange(0, ROT_DIM, 2, dtype=F32) / ROT_DIM)


def _ret_inv_freq():
    return 1.0 / (RET_THETA ** jnp.linspace(0.0, 1.0, HEAD_DIM // 2, dtype=F32))


def _apply_rotary(x, pos, inv_freq):
    half = inv_freq.shape[0]
    ang = pos[:, None] * inv_freq[None, :]
    cos = jnp.cos(ang)[None, :, None, :]
    sin = jnp.sin(ang)[None, :, None, :]
    x1 = x[..., :half]
    x2 = x[..., half:2 * half]
    return jnp.concatenate([x1 * cos - x2 * sin, x2 * cos + x1 * sin, x[..., 2 * half:]], axis=-1)


def _wkv7_scan(r, w, k, v, kk, a, s0):
    def step(s, inp):
        r_t, w_t, k_t, v_t, kk_t, a_t = inp
        sa = jnp.einsum('bhvk,bhk->bhv', s, kk_t)
        s = (s * w_t[:, :, None, :] - sa[..., None] * (kk_t * a_t)[:, :, None, :]
             + v_t[..., None] * k_t[:, :, None, :])
        return s, jnp.einsum('bhvk,bhk->bhv', s, r_t)
    seq = tuple(jnp.swapaxes(z, 0, 1) for z in (r, w, k, v, kk, a))
    s_fin, o = lax.scan(step, s0, seq)
    return jnp.swapaxes(o, 0, 1), s_fin


def _rwkv7_time_mix(h_a, shift_prev, s0, p):
    bsz, t, _ = h_a.shape
    prev = jnp.concatenate([shift_prev[:, None].astype(F32), h_a[:, :-1]], axis=1)
    xs = h_a + (prev - h_a) * p['rwkv_mu']
    r = xs[..., :W_A]
    k = xs[..., W_A:2 * W_A]
    v = xs[..., 2 * W_A:3 * W_A]
    o0 = 3 * W_A
    xw = xs[..., o0:o0 + LORA_W]
    xa = xs[..., o0 + LORA_W:o0 + LORA_W + LORA_A]
    xg = xs[..., o0 + LORA_W + LORA_A:]
    log_w = -RWKV_DECAY_SCALE * jax.nn.sigmoid(p['rwkv_w0'] + jnp.tanh(xw) @ p['rwkv_w_lora'])
    a = jax.nn.sigmoid(p['rwkv_a0'] + xa @ p['rwkv_a_lora'])
    g = jax.nn.sigmoid(xg) @ p['rwkv_g_lora']
    heads = lambda z: z.reshape(bsz, t, H_A, HEAD_DIM)
    kk = heads(k * p['rwkv_k_k'])
    kk = kk * lax.rsqrt(jnp.maximum(jnp.sum(kk * kk, axis=-1, keepdims=True), 1e-12))
    k = k * (1.0 + (a - 1.0) * p['rwkv_k_a'])
    r_h, k_h, v_h, a_h = heads(r), heads(k), heads(v), heads(a)
    o, s_fin = _wkv7_scan(r_h, jnp.exp(heads(log_w)), k_h, v_h, kk, a_h, s0.astype(F32))
    o = _head_norm(o, p['rwkv_gn_g'], p['rwkv_gn_b'], RWKV_GN_EPS)
    o = o + jnp.sum(r_h * k_h * p['rwkv_r_k'], axis=-1, keepdims=True) * v_h
    return o.reshape(bsz, t, W_A) * g, s_fin


def _dilated_branch_prompt(q, k, v, win, dil):
    bsz, t, h, e = q.shape
    blk = win // dil
    seg = dil * blk
    t_pad = -(-t // seg) * seg
    length = t_pad // dil
    nb = length // blk

    def to_blocks(z):
        z = jnp.pad(z, ((0, 0), (0, t_pad - t), (0, 0), (0, 0)))
        z = z.reshape(bsz, length, dil, h, e).transpose(0, 2, 1, 3, 4)
        return z.reshape(bsz, dil, nb, blk, h, e)

    def with_prev(z):
        prev = jnp.pad(z, ((0, 0), (0, 0), (1, 0), (0, 0), (0, 0), (0, 0)))[:, :, :-1]
        return jnp.concatenate([prev, z], axis=3)

    qb = to_blocks(q)
    kc = with_prev(to_blocks(k))
    vc = with_prev(to_blocks(v))
    s = jnp.einsum('brnqhe,brnkhe->brnhqk', qb, kc) * (e ** -0.5)
    qi = jnp.arange(blk)[:, None]
    ki = jnp.arange(2 * blk)[None, :]
    j = blk + qi - ki
    ok = (j >= 0) & (j <= blk)
    first = (jnp.arange(nb)[:, None, None] == 0) & (ki < blk)[None]
    ok = ok[None] & ~first
    s = jnp.where(ok[:, None], s, NEG)
    m = jnp.max(s, axis=-1, keepdims=True)
    pr = jnp.exp(s - m)
    l = jnp.sum(pr, axis=-1)
    o = jnp.einsum('brnhqk,brnkhe->brnqhe', pr, vc) / jnp.swapaxes(l, -1, -2)[..., None]
    lse = jnp.swapaxes(m[..., 0] + jnp.log(l), -1, -2)

    def from_blocks(z):
        rest = z.shape[4:]
        z = z.reshape((bsz, dil, length) + rest)
        z = jnp.moveaxis(z, 1, 2).reshape((bsz, t_pad) + rest)
        return z[:, :t]

    return from_blocks(o), from_blocks(lse)


def _dilated_branch_sample(q, k_all, v_all, win, dil, w_buf):
    t, e = q.shape[1], q.shape[-1]
    blk = win // dil
    self_idx = w_buf + jnp.arange(t)
    idx = self_idx[:, None] - dil * jnp.arange(blk + 1)[None, :]
    ok = idx >= 0
    idxc = jnp.maximum(idx, 0)
    kg = k_all[:, idxc]
    vg = v_all[:, idxc]
    s = jnp.einsum('bthe,btjhe->bthj', q, kg) * (e ** -0.5)
    s = jnp.where(ok[:, None, :], s, NEG)
    m = jnp.max(s, axis=-1, keepdims=True)
    pr = jnp.exp(s - m)
    l = jnp.sum(pr, axis=-1)
    o = jnp.einsum('bthj,btjhe->bthe', pr, vg) / l[..., None]
    return o, m[..., 0] + jnp.log(l)


def _merge_by_denominator(outs, lses):
    wts = jax.nn.softmax(jnp.stack(lses, axis=0), axis=0)
    return jnp.einsum('gbth,gbthe->bthe', wts, jnp.stack(outs, axis=0))


def _dilated_prompt(q, k, v):
    outs, lses = [], []
    for win, dil in DILATED:
        o, l = _dilated_branch_prompt(q, k, v, win, dil)
        outs.append(o)
        lses.append(l)
    w_keep = min(WIN_MAX, q.shape[1])
    return _merge_by_denominator(outs, lses), k[:, -w_keep:], v[:, -w_keep:]


def _dilated_sample(q, k, v, buf_k, buf_v):
    w_buf = buf_k.shape[1]
    k_all = jnp.concatenate([buf_k.astype(F32), k], axis=1)
    v_all = jnp.concatenate([buf_v.astype(F32), v], axis=1)
    outs, lses = [], []
    for win, dil in DILATED:
        o, l = _dilated_branch_sample(q, k_all, v_all, win, dil, w_buf)
        outs.append(o)
        lses.append(l)
    return _merge_by_denominator(outs, lses), k_all[:, -w_buf:], v_all[:, -w_buf:]


def _retention(q, k, v, r0):
    bsz, t, h, e = q.shape
    ch = RET_CHUNK if t % RET_CHUNK == 0 else t
    nc = t // ch
    log_gamma = jnp.log(1.0 - 2.0 ** (-5.0 - jnp.arange(h, dtype=F32)))
    qc = q.reshape(bsz, nc, ch, h, e)
    kc = k.reshape(bsz, nc, ch, h, e)
    vc = v.reshape(bsz, nc, ch, h, e)
    i = jnp.arange(ch, dtype=F32)
    rel = i[:, None] - i[None, :]
    dmask = jnp.where(rel >= 0, jnp.exp(log_gamma[:, None, None] * jnp.maximum(rel, 0.0)), 0.0)
    att = jnp.einsum('bcihe,bcjhe->bchij', qc, kc) * dmask
    o_intra = jnp.einsum('bchij,bcjhf->bcihf', att, vc)
    kdec = jnp.exp(log_gamma[None, :] * (ch - 1.0 - i)[:, None])
    kv = jnp.einsum('bcjhe,bcjhf->bchef', kc * kdec[:, :, None], vc)
    chunk_decay = jnp.exp(log_gamma * ch)[None, :, None, None]

    def step(r, kv_c):
        return r * chunk_decay + kv_c, r

    r_fin, r_prev = lax.scan(step, r0.astype(F32), jnp.swapaxes(kv, 0, 1))
    r_prev = jnp.swapaxes(r_prev, 0, 1)
    qdec = jnp.exp(log_gamma[None, :] * (i + 1.0)[:, None])
    o_cross = jnp.einsum('bcihe,bchef->bcihf', qc * qdec[:, :, None], r_prev)
    return (o_intra + o_cross).reshape(bsz, t, h, e), r_fin


def _trunk_layer(x, shift_prev, wkv0, ret0, pos0, attn_fn, p):
    bsz, t, _ = x.shape
    xf = x.astype(F32)
    h = jnp.matmul(x, p['w_in']).astype(F32)
    h_a = h[..., :A_COLS]
    h_b = h[..., A_COLS:A_COLS + B_COLS]
    h_c = h[..., A_COLS + B_COLS:]
    pos = pos0 + jnp.arange(t, dtype=F32)

    o_a, wkv_new = _rwkv7_time_mix(h_a, shift_prev, wkv0, p)
    shift_new = h_a[:, -1]

    q_b, k_b, v_b = [z.reshape(bsz, t, H_B, HEAD_DIM) for z in jnp.split(h_b, 3, axis=-1)]
    inv_b = _rope_inv_freq()
    q_b = _apply_rotary(q_b, pos, inv_b)
    k_b = _apply_rotary(k_b, pos, inv_b)
    o_b, k_keep, v_keep = attn_fn(q_b, k_b, v_b)

    q_c, k_c, v_c, g_c = jnp.split(h_c, 4, axis=-1)
    inv_c = _ret_inv_freq()
    q_c = _apply_rotary(q_c.reshape(bsz, t, H_C, HEAD_DIM), pos, inv_c)
    k_c = _apply_rotary(k_c.reshape(bsz, t, H_C, HEAD_DIM), pos, inv_c) * (HEAD_DIM ** -0.5)
    o_c, ret_new = _retention(q_c, k_c, v_c.reshape(bsz, t, H_C, HEAD_DIM), ret0)
    o_c = _head_norm(o_c, p['ret_gn_g'], p['ret_gn_b'], LN_EPS).reshape(bsz, t, W_C) * jax.nn.silu(g_c)

    mix = jnp.concatenate([o_a, o_b.reshape(bsz, t, W_B), o_c], axis=-1) @ p['w_out']
    x1 = _layer_norm(DEEPNORM_ALPHA * xf + mix, p['ln1_g'], p['ln1_b'])
    ffn = (jax.nn.silu(x1 @ p['w_ffn_gate']) * (x1 @ p['w_ffn_up'])) @ p['w_ffn_down']
    x2 = _layer_norm(DEEPNORM_ALPHA * x1 + ffn, p['ln2_g'], p['ln2_b'])
    return x2.astype(x.dtype), (shift_new, wkv_new, k_keep, v_keep, ret_new)


def setup_inputs(seed: int = 0) -> dict:
    key = jax.random.key(seed)
    ks = jax.random.split(key, 32)
    w_buf = min(WIN_MAX, PAST_LEN)

    def nrm(k, shape, s):
        return s * jax.random.normal(k, shape, F32)

    return {
        'x_prompt': nrm(ks[0], (BATCH, SEQ, D_MODEL), 1.0),
        'x_sample': nrm(ks[1], (DEC_BATCH, DEC_SEQ, D_MODEL), 1.0),
        'state_rwkv_shift': nrm(ks[2], (DEPTH, DEC_BATCH, A_COLS), 1.0),
        'state_rwkv_wkv': nrm(ks[3], (DEPTH, DEC_BATCH, H_A, HEAD_DIM, HEAD_DIM), 0.5),
        'cache_win_k': nrm(ks[4], (DEPTH, DEC_BATCH, w_buf, H_B, HEAD_DIM), 1.0),
        'cache_win_v': nrm(ks[5], (DEPTH, DEC_BATCH, w_buf, H_B, HEAD_DIM), 1.0),
        'state_ret': nrm(ks[6], (DEPTH, DEC_BATCH, H_C, HEAD_DIM, HEAD_DIM), 2.0),
        'w_in': nrm(ks[7], (DEPTH, D_MODEL, IN_COLS), D_MODEL ** -0.5),
        'rwkv_mu': jax.random.uniform(ks[8], (DEPTH, A_COLS), F32),
        'rwkv_w0': nrm(ks[9], (DEPTH, W_A), 1.0),
        'rwkv_w_lora': nrm(ks[10], (DEPTH, LORA_W, W_A), 0.1),
        'rwkv_a0': nrm(ks[11], (DEPTH, W_A), 0.5),
        'rwkv_a_lora': nrm(ks[12], (DEPTH, LORA_A, W_A), 0.1),
        'rwkv_g_lora': nrm(ks[13], (DEPTH, LORA_G, W_A), LORA_G ** -0.5),
        'rwkv_k_k': 0.85 + nrm(ks[14], (DEPTH, W_A), 0.05),
        'rwkv_k_a': 1.0 + nrm(ks[15], (DEPTH, W_A), 0.05),
        'rwkv_r_k': nrm(ks[16], (DEPTH, H_A, HEAD_DIM), 0.1),
        'rwkv_gn_g': 1.0 + nrm(ks[17], (DEPTH, W_A), 0.02),
        'rwkv_gn_b': nrm(ks[18], (DEPTH, W_A), 0.02),
        'ret_gn_g': 1.0 + nrm(ks[19], (DEPTH, W_C), 0.02),
        'ret_gn_b': nrm(ks[20], (DEPTH, W_C), 0.02),
        'w_out': nrm(ks[21], (DEPTH, MIX_WIDTH, D_MODEL), MIX_WIDTH ** -0.5 * DEEPNORM_BETA),
        'ln1_g': 1.0 + nrm(ks[22], (DEPTH, D_MODEL), 0.02),
        'ln1_b': nrm(ks[23], (DEPTH, D_MODEL), 0.02),
        'w_ffn_gate': nrm(ks[24], (DEPTH, D_MODEL, D_FF), D_MODEL ** -0.5),
        'w_ffn_up': nrm(ks[25], (DEPTH, D_MODEL, D_FF), D_MODEL ** -0.5),
        'w_ffn_down': nrm(ks[26], (DEPTH, D_FF, D_MODEL), D_FF ** -0.5 * DEEPNORM_BETA),
        'ln2_g': 1.0 + nrm(ks[27], (DEPTH, D_MODEL), 0.02),
        'ln2_b': nrm(ks[28], (DEPTH, D_MODEL), 0.02),
    }


def reference(x_prompt, x_sample, state_rwkv_shift, state_rwkv_wkv, cache_win_k, cache_win_v, state_ret,
              w_in, rwkv_mu, rwkv_w0, rwkv_w_lora, rwkv_a0, rwkv_a_lora, rwkv_g_lora, rwkv_k_k, rwkv_k_a,
              rwkv_r_k, rwkv_gn_g, rwkv_gn_b, ret_gn_g, ret_gn_b, w_out, ln1_g, ln1_b,
              w_ffn_gate, w_ffn_up, w_ffn_down, ln2_g, ln2_b):
    xp, xs = x_prompt, x_sample
    bp = x_prompt.shape[0]
    p_states, s_states = [], []
    for l in range(DEPTH):
        p = {
            'w_in': w_in[l], 'rwkv_mu': rwkv_mu[l], 'rwkv_w0': rwkv_w0[l], 'rwkv_w_lora': rwkv_w_lora[l],
            'rwkv_a0': rwkv_a0[l], 'rwkv_a_lora': rwkv_a_lora[l], 'rwkv_g_lora': rwkv_g_lora[l],
            'rwkv_k_k': rwkv_k_k[l], 'rwkv_k_a': rwkv_k_a[l], 'rwkv_r_k': rwkv_r_k[l],
            'rwkv_gn_g': rwkv_gn_g[l], 'rwkv_gn_b': rwkv_gn_b[l], 'ret_gn_g': ret_gn_g[l], 'ret_gn_b': ret_gn_b[l],
            'w_out': w_out[l], 'ln1_g': ln1_g[l], 'ln1_b': ln1_b[l], 'w_ffn_gate': w_ffn_gate[l],
            'w_ffn_up': w_ffn_up[l], 'w_ffn_down': w_ffn_down[l], 'ln2_g': ln2_g[l], 'ln2_b': ln2_b[l],
        }
        xp, sp = _trunk_layer(
            xp,
            jnp.zeros((bp, A_COLS), F32),
            jnp.zeros((bp, H_A, HEAD_DIM, HEAD_DIM), F32),
            jnp.zeros((bp, H_C, HEAD_DIM, HEAD_DIM), F32),
            0.0, _dilated_prompt, p)
        xs, ss = _trunk_layer(
            xs, state_rwkv_shift[l], state_rwkv_wkv[l], state_ret[l], float(PAST_LEN),
            functools.partial(_dilated_sample, buf_k=cache_win_k[l], buf_v=cache_win_v[l]), p)
        p_states.append(sp)
        s_states.append(ss)
    p_shift = jnp.stack([s[0] for s in p_states])
    p_wkv = jnp.stack([s[1] for s in p_states])
    p_win_k = jnp.stack([s[2] for s in p_states])
    p_win_v = jnp.stack([s[3] for s in p_states])
    p_ret = jnp.stack([s[4] for s in p_states])
    s_shift = jnp.stack([s[0] for s in s_states])
    s_wkv = jnp.stack([s[1] for s in s_states])
    s_win_k = jnp.stack([s[2] for s in s_states])
    s_win_v = jnp.stack([s[3] for s in s_states])
    s_ret = jnp.stack([s[4] for s in s_states])
    return (xp, xs, p_shift, p_wkv, p_win_k, p_win_v, p_ret, s_shift, s_wkv, s_win_k, s_win_v, s_ret)
```

```cpp
#include <hip/hip_runtime.h>
#include <cstdio>
#include <cstdint>
namespace pg8 {
#define PG8_LAS __attribute__((address_space(3)))
typedef unsigned short bf16_t;
typedef short bf16x8 __attribute__((ext_vector_type(8)));
typedef float f32x4 __attribute__((ext_vector_type(4)));
typedef unsigned u32x4 __attribute__((ext_vector_type(4)));
constexpr int BM = 256, BK = 64, HALF = 128, HTB = HALF * BK * 2  , STAGE_BYTES = 8 * HTB, NXCD = 8, WGM = 8;

__host__ __device__ __forceinline__ int lds_byte(int r, int c) { const int st = (r >> 4) * 2 + (c >> 5), rr = r & 15, cc = c & 31, ob = rr * 64 + cc * 2; return st * 1024 + (ob ^ (((ob >> 9) & 1) << 5)); }
__host__ __device__ __forceinline__ void stage_rc(int b, int& R, int& C) { const int st = b / 1024, sb = b % 1024, swz = sb ^ (((sb >> 9) & 1) << 5); R = (st >> 1) * 16 + swz / 64; C = (st & 1) * 32 + (swz % 64) / 2; }
__host__ __device__ __forceinline__ int perm32(int rho) { const int n = rho >> 4, i = rho & 15; return 8 * (i >> 2) + 4 * n + (i & 3); }

struct Unit { int pm, pn; };
struct Gemm { const bf16_t* A; const bf16_t* Bt; int M, N, K; };

struct StaticOrder {
    int nM, nN, nwg, G, c;
    __host__ __device__ void init(int M, int N, int G_, int c_) { nM = M / BM; nN = N / BM; nwg = nM * nN; G = G_; c = c_; }
    __host__ __device__ bool next(int i, Unit& u) const {
        const long L = (long)i * G + c; if (L >= nwg) return false;
        int wgid = (int)L; { const int q = nwg / NXCD, r = nwg % NXCD, xcd = wgid % NXCD, off = wgid / NXCD; wgid = (xcd < r ? xcd * (q + 1) : r * (q + 1) + (xcd - r) * q) + off; }
        const int nig = WGM * nN, gid = wgid / nig, fm = gid * WGM, gsz = (nM - fm) < WGM ? (nM - fm) : WGM;
        u.pm = fm + ((wgid % nig) % gsz); u.pn = (wgid % nig) / gsz; return true;
    }
    __device__ __forceinline__ void a_ready(const Unit&) const {}
    __device__ __forceinline__ void done(const Unit&) const {}
};

__device__ __forceinline__ unsigned cvt_pk_bf16(float lo, float hi) { unsigned r; asm volatile("v_cvt_pk_bf16_f32 %0, %1, %2" : "=v"(r) : "v"(lo), "v"(hi)); return r; }
typedef float f32x2 __attribute__((ext_vector_type(2)));

struct EpiH {
    static constexpr bool PERM = true, AFTER_DRAIN = false;
    bf16_t* O; int ldc;
    __device__ __forceinline__ void operator()(const f32x4 (&acc)[2][2][4][2], const Unit& u, int wr, int wc, int fr, int fq) const {
        const int row0 = u.pm * BM + wr * 64 + fr, col0 = u.pn * BM + wc * 32 + 8 * fq;
#pragma unroll
        for (int ai = 0; ai < 2; ++ai)
#pragma unroll
            for (int m = 0; m < 4; ++m) { bf16_t* rowp = O + (size_t)(row0 + ai * HALF + m * 16) * ldc + col0;
#pragma unroll
                for (int bj = 0; bj < 2; ++bj) { const f32x4 v0 = acc[ai][bj][m][0], v1 = acc[ai][bj][m][1];
                    u32x4 w; w.x = cvt_pk_bf16(v0[0], v0[1]); w.y = cvt_pk_bf16(v0[2], v0[3]); w.z = cvt_pk_bf16(v1[0], v1[1]); w.w = cvt_pk_bf16(v1[2], v1[3]);
                    *(u32x4*)(rowp + bj * HALF) = w; } }
    }
};
__device__ __forceinline__ float silu_f(float x) { return x * __builtin_amdgcn_rcpf(1.0f + __builtin_amdgcn_exp2f(-1.4426950408889634f * x)); }
struct EpiSwiglu {
    static constexpr bool PERM = true, AFTER_DRAIN = false;
    bf16_t* O; int ldc;
    __device__ __forceinline__ void operator()(const f32x4 (&acc)[2][2][4][2], const Unit& u, int wr, int wc, int fr, int fq) const {
        const int row0 = u.pm * BM + wr * 64 + fr, col0 = u.pn * HALF + wc * 32 + 8 * fq;
#pragma unroll
        for (int ai = 0; ai < 2; ++ai)
#pragma unroll
            for (int m = 0; m < 4; ++m) { bf16_t* rowp = O + (size_t)(row0 + ai * HALF + m * 16) * ldc + col0;
                const f32x4 g0 = acc[ai][0][m][0], g1 = acc[ai][0][m][1], u0 = acc[ai][1][m][0], u1 = acc[ai][1][m][1];
                u32x4 w; w.x = cvt_pk_bf16(silu_f(g0[0]) * u0[0], silu_f(g0[1]) * u0[1]); w.y = cvt_pk_bf16(silu_f(g0[2]) * u0[2], silu_f(g0[3]) * u0[3]);
                w.z = cvt_pk_bf16(silu_f(g1[0]) * u1[0], silu_f(g1[1]) * u1[1]); w.w = cvt_pk_bf16(silu_f(g1[2]) * u1[2], silu_f(g1[3]) * u1[3]);
                *(u32x4*)rowp = w; }
    }
};
struct EpiResF32 {
    static constexpr bool PERM = false, AFTER_DRAIN = false;
    const float* baseP; const float* baseS; float* V; float alpha; int mp, mv;
    __device__ __forceinline__ void operator()(const f32x4 (&acc)[2][2][4][2], const Unit& u, int wr, int wc, int fr, int fq) const {
        const int row0 = u.pm * BM + wr * 64 + fr, col0 = u.pn * BM + wc * 32 + 4 * fq;
#pragma unroll
        for (int ai = 0; ai < 2; ++ai)
#pragma unroll
            for (int m = 0; m < 4; ++m) { const int row = row0 + ai * HALF + m * 16;
                if (row < mv) { const float* bp = (row < mp ? baseP + (size_t)row * 1024 : baseS + (size_t)(row - mp) * 1024) + col0; float* vp = V + (size_t)row * 1024 + col0;
#pragma unroll
                    for (int bj = 0; bj < 2; ++bj)
#pragma unroll
                        for (int n = 0; n < 2; ++n) { const f32x4 b = *(const f32x4*)(bp + bj * HALF + n * 16); *(f32x4*)(vp + bj * HALF + n * 16) = b * alpha + acc[ai][bj][m][n]; } } }
    }
};
template <class Epi, class Sched, bool ALIGN_EPI = false, bool SP2 = false>
__device__ __forceinline__ void gemm_phase(PG8_LAS unsigned char* lds, const Gemm g, const Sched& S, const Epi& E) {
    int tid_ = threadIdx.x; asm volatile("" : "+v"(tid_));
    const int tid = tid_, wid = __builtin_amdgcn_readfirstlane(tid >> 6), lane = tid & 63, wr = wid >> 2, wc = wid & 3, fr = lane & 15, fq = lane >> 4;
    const int K = g.K, nt = K / BK;
    unsigned voffA[2], voffB[2];
#pragma unroll
    for (int i = 0; i < 2; ++i) { int R, C; stage_rc(tid * 16 + i * 8192, R, C); const int Rb = Epi::PERM ? ((R & ~31) + perm32(R & 31)) : R;
        voffA[i] = (unsigned)(R * K + C) * 2u; voffB[i] = (unsigned)(Rb * K + C) * 2u; }
    const size_t kstep = (size_t)(BK * 2);
    const size_t hstep = (size_t)HALF * K * 2;
    const size_t tstep = 2 * hstep;
    const unsigned ldsw = (unsigned)wid * 1024u;
    const int aoff = lds_byte(wr * 64 + fr, fq * 8), boff = lds_byte(wc * 32 + fr, fq * 8);
#define PG8_SA(b, h) (((b) * 2 + (h)) * HTB)
#define PG8_SB(b, h) ((4 + (b) * 2 + (h)) * HTB)
#define PG8_STAGE(bufoff, gbase, voff) do { _Pragma("unroll") for (int _i = 0; _i < 2; ++_i) \
        __builtin_amdgcn_global_load_lds((const unsigned*)((const char*)(gbase) + (voff)[_i]), (PG8_LAS unsigned*)(lds + (bufoff) + ldsw + _i * 8192), 16, 0, 0); } while (0)
#define PG8_LDA(dst, b, h) do { _Pragma("unroll") for (int m = 0; m < 4; ++m) _Pragma("unroll") for (int k = 0; k < 2; ++k) dst[m][k] = *(const PG8_LAS bf16x8*)(lds + PG8_SA(b, h) + aoff + m * 2048 + k * 1024); } while (0)
#define PG8_LDB(dst, b, h) do { _Pragma("unroll") for (int n = 0; n < 2; ++n) _Pragma("unroll") for (int k = 0; k < 2; ++k) dst[n][k] = *(const PG8_LAS bf16x8*)(lds + PG8_SB(b, h) + boff + n * 2048 + k * 1024); } while (0)
#define PG8_MMA(ai, bj, At, Bt) do { __builtin_amdgcn_s_setprio(1); _Pragma("unroll") for (int m = 0; m < 4; ++m) _Pragma("unroll") for (int n = 0; n < 2; ++n) _Pragma("unroll") for (int k = 0; k < 2; ++k) \
        acc[ai][bj][m][n] = __builtin_amdgcn_mfma_f32_16x16x32_bf16(Bt[n][k], At[m][k], acc[ai][bj][m][n], 0, 0, 0); __builtin_amdgcn_s_setprio(0); } while (0)
#define PG8_WAIT_V(n) asm volatile("s_waitcnt vmcnt(" #n ")" ::: "memory")
#define PG8_WAIT_L(n) asm volatile("s_waitcnt lgkmcnt(" #n ")" ::: "memory")
#define PG8_BAR __builtin_amdgcn_s_barrier()
#define PG8_SCHED __builtin_amdgcn_sched_barrier(0)
    Unit cur, nxt; int ui = 0;
    if (!S.next(0, cur)) return;
    f32x4 acc[2][2][4][2];
#pragma unroll
    for (int a = 0; a < 2; ++a)
#pragma unroll
        for (int b = 0; b < 2; ++b)
#pragma unroll
            for (int m = 0; m < 4; ++m)
#pragma unroll
                for (int n = 0; n < 2; ++n) acc[a][b][m][n] = (f32x4){0.f, 0.f, 0.f, 0.f};
    bf16x8 At[4][2], B0[2][2], B1[2][2];
    const char* cA = (const char*)g.A + (size_t)cur.pm * tstep; const char* cB = (const char*)g.Bt + (size_t)cur.pn * tstep;
    S.a_ready(cur);
    if constexpr (SP2) {
        PG8_STAGE(PG8_SB(0, 0), cB, voffB); PG8_STAGE(PG8_SB(0, 1), cB + hstep, voffB); PG8_STAGE(PG8_SA(0, 0), cA, voffA); PG8_STAGE(PG8_SA(0, 1), cA + hstep, voffA);
        if (wr == 1) PG8_BAR;
        PG8_WAIT_V(2); PG8_BAR;
        PG8_STAGE(PG8_SB(1, 0), cB + kstep, voffB); PG8_STAGE(PG8_SA(1, 0), cA + kstep, voffA); PG8_STAGE(PG8_SB(1, 1), cB + hstep + kstep, voffB);
        PG8_WAIT_V(6); PG8_BAR;
    } else {
        PG8_STAGE(PG8_SB(0, 0), cB, voffB); PG8_STAGE(PG8_SA(0, 0), cA, voffA); PG8_STAGE(PG8_SB(0, 1), cB + hstep, voffB); PG8_STAGE(PG8_SA(0, 1), cA + hstep, voffA);
        if (wr == 1) PG8_BAR;
        PG8_WAIT_V(4); PG8_BAR;
        PG8_STAGE(PG8_SB(1, 0), cB + kstep, voffB); PG8_STAGE(PG8_SA(1, 0), cA + kstep, voffA); PG8_STAGE(PG8_SB(1, 1), cB + hstep + kstep, voffB);
        PG8_WAIT_V(6); PG8_BAR;
    }
    for (;;) {
        const bool has_next = S.next(ui + 1, nxt);
        const char* nA = has_next ? (const char*)g.A + (size_t)nxt.pm * tstep : cA; const char* nB = has_next ? (const char*)g.Bt + (size_t)nxt.pn * tstep : cB;
        for (int t = 0; t < nt; t += 2) {
            const bool last = (t == nt - 2);
            const char* a1 = cA + (size_t)(t + 1) * kstep;
            const char* a2 = last ? nA : cA + (size_t)(t + 2) * kstep; const char* b2 = last ? nB : cB + (size_t)(t + 2) * kstep;
            const char* a3 = a2 + kstep; const char* b3 = b2 + kstep;
            if (last && has_next) S.a_ready(nxt);
            if constexpr (SP2) {
            PG8_LDB(B0, 0, 0); PG8_LDB(B1, 0, 1); PG8_SCHED; PG8_LDA(At, 0, 0); PG8_STAGE(PG8_SA(1, 1), a1 + hstep, voffA);
            PG8_WAIT_V(8); PG8_WAIT_L(0); PG8_BAR; PG8_MMA(0, 0, At, B0); PG8_MMA(0, 1, At, B1); PG8_BAR; PG8_SCHED;
            PG8_LDA(At, 0, 1); PG8_STAGE(PG8_SB(0, 0), b2, voffB); PG8_STAGE(PG8_SB(0, 1), b2 + hstep, voffB); PG8_STAGE(PG8_SA(0, 0), a2, voffA);
            PG8_WAIT_V(8); PG8_WAIT_L(0); PG8_BAR; PG8_MMA(1, 0, At, B0); PG8_MMA(1, 1, At, B1); PG8_BAR; PG8_SCHED;
            PG8_LDB(B0, 1, 0); PG8_LDB(B1, 1, 1); PG8_SCHED; PG8_LDA(At, 1, 0); PG8_STAGE(PG8_SA(0, 1), a2 + hstep, voffA);
            PG8_WAIT_V(8); PG8_WAIT_L(0); PG8_BAR; PG8_MMA(0, 0, At, B0); PG8_MMA(0, 1, At, B1); PG8_BAR; PG8_SCHED;
            PG8_LDA(At, 1, 1); PG8_STAGE(PG8_SB(1, 0), b3, voffB); PG8_STAGE(PG8_SB(1, 1), b3 + hstep, voffB); PG8_STAGE(PG8_SA(1, 0), a3, voffA);
            PG8_WAIT_V(8); PG8_WAIT_L(0); PG8_BAR; PG8_MMA(1, 0, At, B0); PG8_MMA(1, 1, At, B1); PG8_BAR; PG8_SCHED;
            } else {
            PG8_LDB(B0, 0, 0); PG8_SCHED; PG8_LDA(At, 0, 0); PG8_STAGE(PG8_SA(1, 1), a1 + hstep, voffA);
            PG8_WAIT_L(8); PG8_BAR; PG8_WAIT_L(0); PG8_MMA(0, 0, At, B0); PG8_BAR; PG8_SCHED;
            PG8_LDB(B1, 0, 1); PG8_STAGE(PG8_SB(0, 0), b2, voffB);
            PG8_BAR; PG8_WAIT_L(0); PG8_MMA(0, 1, At, B1); PG8_BAR;
            PG8_LDA(At, 0, 1); PG8_STAGE(PG8_SA(0, 0), a2, voffA);
            PG8_BAR; PG8_WAIT_L(0); PG8_MMA(1, 0, At, B0); PG8_BAR; PG8_SCHED;
            PG8_STAGE(PG8_SB(0, 1), b2 + hstep, voffB);
            PG8_WAIT_V(6); PG8_BAR; PG8_MMA(1, 1, At, B1); PG8_BAR;
            PG8_LDB(B0, 1, 0); PG8_SCHED; PG8_LDA(At, 1, 0); PG8_STAGE(PG8_SA(0, 1), a2 + hstep, voffA);
            PG8_WAIT_L(8); PG8_BAR; PG8_WAIT_L(0); PG8_MMA(0, 0, At, B0); PG8_BAR; PG8_SCHED;
            PG8_LDB(B1, 1, 1); PG8_STAGE(PG8_SB(1, 0), b3, voffB);
            PG8_BAR; PG8_WAIT_L(0); PG8_MMA(0, 1, At, B1); PG8_BAR;
            PG8_LDA(At, 1, 1); PG8_STAGE(PG8_SA(1, 0), a3, voffA);
            PG8_BAR; PG8_WAIT_L(0); PG8_MMA(1, 0, At, B0); PG8_BAR; PG8_SCHED;
            PG8_STAGE(PG8_SB(1, 1), b3 + hstep, voffB);
            PG8_WAIT_V(6); PG8_BAR; PG8_MMA(1, 1, At, B1); PG8_BAR;
            }
        }
        if constexpr (ALIGN_EPI) { if (wr == 0) PG8_BAR; }
        if constexpr (!Epi::AFTER_DRAIN) { E(acc, cur, wr, wc, fr, fq); S.done(cur); }
        if (!has_next) break;
#pragma unroll
        for (int a = 0; a < 2; ++a)
#pragma unroll
            for (int b = 0; b < 2; ++b)
#pragma unroll
                for (int m = 0; m < 4; ++m)
#pragma unroll
                    for (int n = 0; n < 2; ++n) acc[a][b][m][n] = (f32x4){0.f, 0.f, 0.f, 0.f};
        cur = nxt; cA = nA; cB = nB; ++ui;
        if constexpr (ALIGN_EPI) { if (wr == 1) PG8_BAR; }
    }
    PG8_WAIT_V(0);
    if constexpr (!ALIGN_EPI) { if (wr == 0) PG8_BAR; }
    PG8_BAR;
    if constexpr (Epi::AFTER_DRAIN) { E.fused(acc, cur, wr, wc, fr, fq, lds, wid, lane); S.done(cur); }
#undef PG8_SA
#undef PG8_SB
#undef PG8_STAGE
#undef PG8_LDA
#undef PG8_LDB
#undef PG8_MMA
#undef PG8_WAIT_V
#undef PG8_WAIT_L
#undef PG8_BAR
#undef PG8_SCHED
}
}
#define GAS __attribute__((address_space(1)))
#define LAS __attribute__((address_space(3)))
typedef unsigned short bf16;
typedef unsigned v4u __attribute__((ext_vector_type(4)));
typedef float f32x4 __attribute__((ext_vector_type(4)));
typedef short bf16x8 __attribute__((ext_vector_type(8)));
typedef GAS unsigned gu32;
typedef GAS unsigned long long gu64;
#define RLX_AGENT __ATOMIC_RELAXED, __HIP_MEMORY_SCOPE_AGENT
#define LDS_WAIT() asm volatile("s_waitcnt lgkmcnt(0)" ::: "memory")
#define VM_WAIT() asm volatile("s_waitcnt vmcnt(0)" ::: "memory")
__device__ __forceinline__ unsigned long long rt() { return __builtin_amdgcn_s_memrealtime(); }
__device__ __forceinline__ unsigned f2bf(float f) { unsigned u = __builtin_bit_cast(unsigned, f); return (u + 0x7fffu + ((u >> 16) & 1u)) >> 16; }
__device__ __forceinline__ unsigned pk2(float lo, float hi) { return f2bf(lo) | (f2bf(hi) << 16); }
#define XB_TMO      128
#define XB_XCNT(j)  (256  + 64 * (j))
#define XB_XSUB(j)  (1280 + 64 * (j))
#define XB_XGEN(j)  (2304 + 64 * (j))
#define XB_TOP      3328
#define XB_TOPGEN   3392
#define XCD_BAR_WORDS 3456
#define XB_SPIN_CAP (1u << 18)

__device__ __forceinline__ unsigned xb_ld(unsigned* p)              { return __hip_atomic_load(p, __ATOMIC_RELAXED, __HIP_MEMORY_SCOPE_AGENT); }
__device__ __forceinline__ unsigned xb_add(unsigned* p, unsigned v) { return __hip_atomic_fetch_add(p, v, __ATOMIC_RELAXED, __HIP_MEMORY_SCOPE_AGENT); }
__device__ __forceinline__ unsigned xb_xcc_id() { return (unsigned)__builtin_amdgcn_s_getreg((3 << 11) | 20) & 0xFu; }
#define XB_SPIN(cond, bar) do { unsigned _sp = 0; while (cond) { __builtin_amdgcn_s_sleep(1); \
    if ((++_sp & 255u) == 0u) { if (xb_ld(&(bar)[XB_TMO])) break; if (_sp > XB_SPIN_CAP) { atomicAdd(&(bar)[XB_TMO], 1u); break; } } } } while (0)

struct XcdBarrier {
    unsigned* bar; unsigned x;
    volatile LAS unsigned* st;
};

__device__ __forceinline__ XcdBarrier xcd_barrier_post(unsigned* bar, volatile LAS unsigned* st) {
    XcdBarrier b; b.bar = bar; b.x = xb_xcc_id(); b.st = st;
    if (threadIdx.x == 0) (void)xb_add(&bar[XB_XCNT(b.x)], 1u);
    return b;
}
__device__ __forceinline__ void xcd_barrier_complete(unsigned* bar, unsigned x, unsigned& nloc, unsigned& nx) {
    const unsigned G = gridDim.x * gridDim.y * gridDim.z;
    unsigned sum, cnt, mine, sp = 0u;
    for (;;) {
        sum = 0u; cnt = 0u; mine = 0u;
#pragma unroll
        for (unsigned j = 0; j < 16; ++j) { const unsigned c = xb_ld(&bar[XB_XCNT(j)]); sum += c; cnt += (c > 0u) ? 1u : 0u; mine = (j == x) ? c : mine; }
        if (sum == G) break;
        __builtin_amdgcn_s_sleep(1);
        if ((++sp & 255u) == 0u) { if (xb_ld(&bar[XB_TMO])) break; if (sp > XB_SPIN_CAP) { atomicAdd(&bar[XB_TMO], 1u); break; } }
    }
    nloc = mine > 0u ? mine : 1u; nx = cnt > 0u ? cnt : 1u;
}

__device__ __forceinline__ void xcd_barrier(const XcdBarrier& b) {
    asm volatile("s_waitcnt vmcnt(0)" ::: "memory");
    __syncthreads();
    if (threadIdx.x == 0) {
        unsigned* bar = b.bar;
        __builtin_amdgcn_s_waitcnt(0);
        unsigned nloc = b.st[0], nx = b.st[1];
        if (nloc == 0u) { xcd_barrier_complete(bar, b.x, nloc, nx); b.st[0] = nloc; b.st[1] = nx; }
        const unsigned old = xb_add(&bar[XB_XSUB(b.x)], 1u);
        const unsigned gen = old / nloc;
        if (old + 1u == (gen + 1u) * nloc) {
            __builtin_amdgcn_fence(__ATOMIC_RELEASE, "agent");
            asm volatile("s_waitcnt vmcnt(0)" ::: "memory");
            const unsigned og = xb_add(&bar[XB_TOP], 1u);
            const unsigned tg = og / nx;
            if (og + 1u == (tg + 1u) * nx) xb_add(&bar[XB_TOPGEN], 1u);
            else XB_SPIN(xb_ld(&bar[XB_TOPGEN]) == tg, bar);
            __builtin_amdgcn_fence(__ATOMIC_ACQUIRE, "agent");
            xb_add(&bar[XB_XGEN(b.x)], 1u);
            asm volatile("s_waitcnt vmcnt(0)" ::: "memory");
        } else {
            XB_SPIN(xb_ld(&bar[XB_XGEN(b.x)]) == gen, bar);
            __builtin_amdgcn_fence(__ATOMIC_ACQUIRE, "agent");
            asm volatile("s_waitcnt vmcnt(0)" ::: "memory");
        }
    }
    __syncthreads();
}

constexpr int DM = 1024, SEQ = 4096, NBP = 4, MP = NBP * SEQ, NBS = 32, TS = 4, MS = NBS * TS, MV = MP + MS, MT = 65 * 256;
constexpr int IN_COLS = 3584, A_COLS = 1408, WA = 384, DFF = 2816, NGU = 2 * DFF, WBUF = 2048;
constexpr int COL_QB = 1408, COL_KB = 1792, COL_VB = 2176, COL_QC = 2560, COL_KC = 2816, COL_VC = 3072, COL_GC = 3328;
constexpr float DN_ALPHA = 1.4142135623730951f;
constexpr float LN_EPS = 1e-5f, GN_EPS_A = 64e-5f, DECAY_SCALE = 0.6065306597126334f;
constexpr int NPOS = SEQ + TS;
constexpr size_t O_YP = 0, O_YS = O_YP + (size_t)MP * DM, O_PSHIFT = O_YS + (size_t)MS * DM, O_PWKV = O_PSHIFT + 2 * NBP * A_COLS, O_PWINK = O_PWKV + 2 * NBP * 6 * 4096,
                 O_PWINV = O_PWINK + (size_t)2 * NBP * WBUF * 384, O_PRET = O_PWINV + (size_t)2 * NBP * WBUF * 384, O_SSHIFT = O_PRET + 2 * NBP * 4 * 4096,
                 O_SWKV = O_SSHIFT + 2 * NBS * A_COLS, O_SWINK = O_SWKV + 2 * NBS * 6 * 4096, O_SWINV = O_SWINK + (size_t)2 * NBS * WBUF * 384,
                 O_SRET = O_SWINV + (size_t)2 * NBS * WBUF * 384, O_END = O_SRET + 2 * NBS * 4 * 4096;
static_assert(O_END == 133204992, "output size");
constexpr size_t MiB = 1u << 20;
constexpr size_t WS_CTL = 0, CTL_ZERO_BYTES = 1 * MiB, WS_TAB = 1 * MiB, WS_W = 4 * MiB, LW = 26 * MiB;
constexpr size_t W_IN = 0, W_OUT = W_IN + (size_t)IN_COLS * DM * 2, W_GU = W_OUT + (size_t)DM * DM * 2, W_D = W_GU + (size_t)NGU * DM * 2, W_LEND = W_D + (size_t)DM * DFF * 2;
static_assert(W_LEND <= LW, "weights");
constexpr size_t WS_XB = 56 * MiB, WS_XF = 89 * MiB, WS_X1F = 154 * MiB, WS_X1B = 219 * MiB, WS_MIX = 252 * MiB, WS_G = 285 * MiB, WS_T0 = 310 * MiB;
constexpr size_t WS_H = WS_T0, WS_SC = 424 * MiB, WS_OA = 571 * MiB, WS_OB = 596 * MiB, WS_LSE = 670 * MiB, WS_OC = 672 * MiB, WS_RK = 689 * MiB, WS_END = 690 * MiB;
constexpr size_t WS_V = WS_T0, WS_HFF = 375 * MiB;
static_assert(WS_H + (size_t)MT * IN_COLS * 2 <= WS_SC && WS_SC + (size_t)MT * 2304 * 4 <= WS_OA && WS_OB + (size_t)3 * MT * 384 * 4 <= WS_LSE && WS_OC + (size_t)MT * 256 * 4 <= WS_RK, "ws map");
static_assert(WS_V + (size_t)MT * DM * 4 <= WS_HFF && WS_HFF + (size_t)MT * DFF * 2 <= WS_END && WS_XF + (size_t)MT * DM * 4 <= WS_X1F && WS_G + (size_t)MT * 384 * 4 <= WS_T0, "ws map 2");
constexpr int TAB_COSB = 0, TAB_SINB = NPOS * 8, TAB_COSC = NPOS * 16, TAB_SINC = NPOS * 48, TAB_END = NPOS * 80;
constexpr int CW_BAR = 4096;
constexpr int RING_BYTES = 131072, LDSCTL_OFF = RING_BYTES, MISC_OFF = LDSCTL_OFF + 320, INTAB_OFF = LDSCTL_OFF + 1024, LDS_BYTES = 147456;
constexpr int NWAVES = 8, NTHR = 512;
constexpr int NST = 9, NPHASE = 1 + 2 * NST;

struct Frame {
    LAS unsigned char* lds; volatile LAS unsigned* MISC; gu32* ctl;
    int tid, lane, wave, G, bid;
    float* out; unsigned char* ws;
};
__device__ __forceinline__ const float* inp(const Frame& F, int k) {
    const LAS unsigned* t = (const LAS unsigned*)(F.lds + INTAB_OFF) + 2 * k;
    const unsigned lo = __builtin_amdgcn_readfirstlane(t[0]), hi = __builtin_amdgcn_readfirstlane(t[1]);
    return (const float*)(((unsigned long long)hi << 32) | lo);
}
__device__ __forceinline__ float bf2f(bf16 v) { return __uint_as_float((unsigned)v << 16); }
__device__ __forceinline__ float wave_sum(float v) {
#pragma unroll
    for (int o = 1; o < 64; o <<= 1) v += __shfl_xor(v, o);
    return v;
}
__device__ __forceinline__ float wave_max(float v) {
#pragma unroll
    for (int o = 1; o < 64; o <<= 1) v = fmaxf(v, __shfl_xor(v, o));
    return v;
}
__device__ __forceinline__ float dpp_f(float x, const int ctrl_sel) {
    const int xi = __float_as_int(x); int r;
    if (ctrl_sel == 0) r = __builtin_amdgcn_update_dpp(xi, xi, 0xB1, 0xF, 0xF, false);
    else if (ctrl_sel == 1) r = __builtin_amdgcn_update_dpp(xi, xi, 0x4E, 0xF, 0xF, false);
    else if (ctrl_sel == 2) r = __builtin_amdgcn_update_dpp(xi, xi, 0x141, 0xF, 0xF, false);
    else r = __builtin_amdgcn_update_dpp(xi, xi, 0x140, 0xF, 0xF, false);
    return __int_as_float(r);
}
__device__ __forceinline__ float red16(float x) { x += dpp_f(x, 0); x += dpp_f(x, 1); x += dpp_f(x, 2); x += dpp_f(x, 3); return x; }
__device__ __forceinline__ float sigmoid_f(float x) { return 1.0f / (1.0f + __expf(-x)); }

__device__ __forceinline__ void p0_transpose_item(const float* W, int K, int N, bf16* WT, int k0, int n0, int drow0, LAS float* scr, int lane) {
#pragma unroll 8
    for (int i = 0; i < 32; ++i) { const int kk = 2 * i + (lane >> 5); scr[kk * 33 + (lane & 31)] = W[(size_t)(k0 + kk) * N + n0 + (lane & 31)]; }
    LDS_WAIT(); asm volatile("" ::: "memory");
    const int c = lane & 7;
#pragma unroll
    for (int j = 0; j < 4; ++j) { const int n = (lane >> 3) + 8 * j; const LAS float* s = scr + (8 * c) * 33 + n;
        v4u o; o.x = pk2(s[0 * 33], s[1 * 33]); o.y = pk2(s[2 * 33], s[3 * 33]); o.z = pk2(s[4 * 33], s[5 * 33]); o.w = pk2(s[6 * 33], s[7 * 33]);
        *(GAS v4u*)(WT + (size_t)(drow0 + n) * K + k0 + 8 * c) = o; }
    LDS_WAIT(); asm volatile("" ::: "memory");
}
__device__ __forceinline__ void p0_prologue(Frame& F) {
    LAS float* scr = (LAS float*)(F.lds + F.wave * 16384);
    const int gw = F.bid * NWAVES + F.wave, NGW = F.G * NWAVES;
    constexpr int I_IN = 16 * (IN_COLS / 32), I_OUT = 16 * (DM / 32), I_G = 16 * (DFF / 32), I_D = (DFF / 64) * (DM / 32), I_L = I_IN + I_OUT + 2 * I_G + I_D;
    for (int it = gw; it < 2 * I_L; it += NGW) {
        const int l = it / I_L; int r = it % I_L; bf16* wb = (bf16*)(F.ws + WS_W + (size_t)l * LW);
        if (r < I_IN) { const int nblk = IN_COLS / 32, kb = r / nblk, nb = r % nblk; p0_transpose_item(inp(F, 7) + (size_t)l * DM * IN_COLS, DM, IN_COLS, (bf16*)((char*)wb + W_IN), 64 * kb, 32 * nb, 32 * nb, scr, F.lane); continue; } r -= I_IN;
        if (r < I_OUT) { const int nblk = DM / 32, kb = r / nblk, nb = r % nblk; p0_transpose_item(inp(F, 21) + (size_t)l * DM * DM, DM, DM, (bf16*)((char*)wb + W_OUT), 64 * kb, 32 * nb, 32 * nb, scr, F.lane); continue; } r -= I_OUT;
        if (r < 2 * I_G) { const int up = r >= I_G; if (up) r -= I_G; const int nblk = DFF / 32, kb = r / nblk, nb = r % nblk, n0 = 32 * nb;
            p0_transpose_item((up ? inp(F, 25) : inp(F, 24)) + (size_t)l * DM * DFF, DM, DFF, (bf16*)((char*)wb + W_GU), 64 * kb, n0, (n0 >> 7) * 256 + (n0 & 127) + (up ? 128 : 0), scr, F.lane); continue; } r -= 2 * I_G;
        { const int nblk = DM / 32, kb = r / nblk, nb = r % nblk; p0_transpose_item(inp(F, 26) + (size_t)l * DFF * DM, DFF, DM, (bf16*)((char*)wb + W_D), 64 * kb, 32 * nb, 32 * nb, scr, F.lane); }
    }
    bf16* XB = (bf16*)(F.ws + WS_XB); bf16* MIX = (bf16*)(F.ws + WS_MIX); bf16* X1B = (bf16*)(F.ws + WS_X1B); bf16* HFF = (bf16*)(F.ws + WS_HFF);
    for (int m = gw; m < MT; m += NGW) {
        GAS unsigned long long* o8 = (GAS unsigned long long*)(XB + (size_t)m * DM) + F.lane;
        if (m < MV) { const float* src = m < MP ? inp(F, 0) + (size_t)m * DM : inp(F, 1) + (size_t)(m - MP) * DM; const GAS f32x4* xr = (const GAS f32x4*)src + F.lane;
#pragma unroll
            for (int j = 0; j < 4; ++j) { const f32x4 v = xr[64 * j]; o8[64 * j] = (unsigned long long)pk2(v.x, v.y) | ((unsigned long long)pk2(v.z, v.w) << 32); }
        } else {
#pragma unroll
            for (int j = 0; j < 4; ++j) { o8[64 * j] = 0ull; ((GAS unsigned long long*)(MIX + (size_t)m * DM) + F.lane)[64 * j] = 0ull; ((GAS unsigned long long*)(X1B + (size_t)m * DM) + F.lane)[64 * j] = 0ull; }
            for (int j = F.lane; j < DFF / 4; j += 64) ((GAS unsigned long long*)(HFF + (size_t)m * DFF))[j] = 0ull;
        }
    }
    float* tab = (float*)(F.ws + WS_TAB);
    for (int e = F.bid * NTHR + F.tid; e < NPOS * 40; e += F.G * NTHR) {
        const int idx = e / 40, j = e % 40; const float pos = (float)(idx < SEQ ? idx : 8192 + (idx - SEQ));
        if (j < 8) { const float inv = powf(500000.0f, -(float)(2 * j) / 16.0f); const float ang = pos * inv; tab[TAB_COSB + idx * 8 + j] = cosf(ang); tab[TAB_SINB + idx * 8 + j] = sinf(ang); }
        else { const int jj = j - 8; const float inv = 1.0f / powf(10000.0f, (float)jj / 31.0f); const float ang = pos * inv; tab[TAB_COSC + idx * 32 + jj] = cosf(ang); tab[TAB_SINC + idx * 32 + jj] = sinf(ang); }
    }
}

__device__ __forceinline__ void prep_phase(Frame& F, int l) {
    bf16* H = (bf16*)(F.ws + WS_H); float* SC = (float*)(F.ws + WS_SC); float* Gt = (float*)(F.ws + WS_G); float* RK = (float*)(F.ws + WS_RK);
    const float* tab = (const float*)(F.ws + WS_TAB);
    const float* shift = inp(F, 2) + (size_t)l * NBS * A_COLS;
    const float* mu = inp(F, 8) + l * A_COLS; const float* w0 = inp(F, 9) + l * WA; const float* wl = inp(F, 10) + (size_t)l * 64 * WA; const float* a0 = inp(F, 11) + l * WA;
    const float* al = inp(F, 12) + (size_t)l * 64 * WA; const float* gl = inp(F, 13) + (size_t)l * 128 * WA; const float* kkw = inp(F, 14) + l * WA; const float* kaw = inp(F, 15) + l * WA; const float* rkw = inp(F, 16) + l * WA;
    LAS float* xl = (LAS float*)F.lds;
    const int tid = F.tid;
    for (int item = F.bid; item < MV / 16; item += F.G) {
        const int row0 = item * 16; const bool isS = row0 >= MP;
        float xr[16], xk[16], xv[16];
        if (tid < WA) {
#pragma unroll
            for (int part = 0; part < 3; ++part) {
                const int col = part * WA + tid; const float muc = mu[col]; float cur[16];
#pragma unroll
                for (int t = 0; t < 16; ++t) cur[t] = bf2f(H[(size_t)(row0 + t) * IN_COLS + col]);
#pragma unroll
                for (int t = 0; t < 16; ++t) {
                    float p;
                    if (!isS) p = (t == 0) ? (((row0 & (SEQ - 1)) == 0) ? 0.f : bf2f(H[(size_t)(row0 - 1) * IN_COLS + col])) : cur[t - 1];
                    else p = ((t & 3) == 0) ? shift[(size_t)(((row0 - MP) >> 2) + (t >> 2)) * A_COLS + col] : cur[t - 1];
                    const float x = cur[t] + (p - cur[t]) * muc;
                    if (part == 0) xr[t] = x; else if (part == 1) xk[t] = x; else xv[t] = x;
                }
            }
        } else {
            const int i = tid - WA;
#pragma unroll
            for (int part = 0; part < 2; ++part) {
                const int col = 1152 + part * 128 + i; const float muc = mu[col]; float cur[16];
#pragma unroll
                for (int t = 0; t < 16; ++t) cur[t] = bf2f(H[(size_t)(row0 + t) * IN_COLS + col]);
#pragma unroll
                for (int t = 0; t < 16; ++t) {
                    float p;
                    if (!isS) p = (t == 0) ? (((row0 & (SEQ - 1)) == 0) ? 0.f : bf2f(H[(size_t)(row0 - 1) * IN_COLS + col])) : cur[t - 1];
                    else p = ((t & 3) == 0) ? shift[(size_t)(((row0 - MP) >> 2) + (t >> 2)) * A_COLS + col] : cur[t - 1];
                    float x = cur[t] + (p - cur[t]) * muc;
                    if (part == 0) { if (i < 64) x = tanhf(x); } else x = sigmoid_f(x);
                    xl[(part * 128 + i) * 16 + t] = x;
                }
            }
        }
        __syncthreads();
        if (tid < WA) {
            const int c = tid, h = c >> 6, ln = c & 63;
            float dw[16], da[16], dg[16];
#pragma unroll
            for (int t = 0; t < 16; ++t) { dw[t] = 0.f; da[t] = 0.f; dg[t] = 0.f; }
#pragma unroll 2
            for (int i = 0; i < 64; ++i) {
                const float wv = wl[i * WA + c], av = al[i * WA + c];
                const LAS f32x4* xw4 = (const LAS f32x4*)(xl + i * 16); const LAS f32x4* xa4 = (const LAS f32x4*)(xl + (64 + i) * 16);
#pragma unroll
                for (int q = 0; q < 4; ++q) { const f32x4 a = xw4[q], b = xa4[q];
#pragma unroll
                    for (int e = 0; e < 4; ++e) { dw[4 * q + e] += a[e] * wv; da[4 * q + e] += b[e] * av; } }
            }
#pragma unroll 2
            for (int i = 0; i < 128; ++i) {
                const float gv = gl[i * WA + c]; const LAS f32x4* xg4 = (const LAS f32x4*)(xl + (128 + i) * 16);
#pragma unroll
                for (int q = 0; q < 4; ++q) { const f32x4 a = xg4[q];
#pragma unroll
                    for (int e = 0; e < 4; ++e) dg[4 * q + e] += a[e] * gv; }
            }
            const float w0c = w0[c], a0c = a0[c], kkc = kkw[c], kac = kaw[c], rkc = rkw[c];
#pragma unroll
            for (int t = 0; t < 16; ++t) {
                const int row = row0 + t;
                const float a = sigmoid_f(a0c + da[t]);
                const float wdec = __expf(-DECAY_SCALE * sigmoid_f(w0c + dw[t]));
                float kk = xk[t] * kkc; const float ss = wave_sum(kk * kk); kk *= rsqrtf(fmaxf(ss, 1e-12f));
                const float k2 = xk[t] * (1.0f + (a - 1.0f) * kac);
                const float bb = kk * a;
                const float rk = wave_sum(xr[t] * k2 * rkc);
                float* sc = SC + ((size_t)row * 6 + h) * 384 + ln;
                sc[0] = xr[t]; sc[64] = wdec; sc[128] = k2; sc[192] = xv[t]; sc[256] = kk; sc[320] = bb;
                Gt[(size_t)row * WA + c] = dg[t];
                if (ln == 0) RK[row * 6 + h] = rk;
            }
        }
        float* owk = F.out + (isS ? O_SWINK : O_PWINK); float* owv = F.out + (isS ? O_SWINV : O_PWINV);
        for (int p = tid; p < 16 * 352; p += NTHR) {
            const int r = p / 352, rem = p % 352, row = row0 + r;
            const int posidx = isS ? SEQ + ((row - MP) & 3) : (row & (SEQ - 1));
            int col1, col2; float cs, sn, scale = 1.f; int vec, i;
            if (rem < 96) { vec = rem >> 3; i = rem & 7; col1 = COL_QB + vec * 64 + i; col2 = col1 + 8; cs = tab[TAB_COSB + posidx * 8 + i]; sn = tab[TAB_SINB + posidx * 8 + i]; }
            else { const int rem2 = rem - 96; vec = rem2 >> 5; i = rem2 & 31; col1 = COL_QC + vec * 64 + i; col2 = col1 + 32; cs = tab[TAB_COSC + posidx * 32 + i]; sn = tab[TAB_SINC + posidx * 32 + i]; scale = vec >= 4 ? 0.125f : 1.f; }
            bf16* hp = H + (size_t)row * IN_COLS;
            const float x1 = bf2f(hp[col1]), x2 = bf2f(hp[col2]);
            const float o1 = (x1 * cs - x2 * sn) * scale, o2 = (x2 * cs + x1 * sn) * scale;
            hp[col1] = (bf16)f2bf(o1); hp[col2] = (bf16)f2bf(o2);
            if (rem < 96 && vec >= 6) {
                const int hh = vec - 6; long base = -1;
                if (!isS) { const int t = row & (SEQ - 1), b = row >> 12; if (t >= SEQ - WBUF) base = ((((long)l * NBP + b) * WBUF + (t - (SEQ - WBUF))) * 6 + hh) * 64; }
                else { const int t = (row - MP) & 3, b = (row - MP) >> 2; base = ((((long)l * NBS + b) * WBUF + (WBUF - TS + t)) * 6 + hh) * 64; }
                if (base >= 0) { owk[base + i] = o1; owk[base + i + 8] = o2; }
            }
        }
        for (int q = tid; q < 16 * 672; q += NTHR) {
            const int r = q / 672, e = q % 672, row = row0 + r;
            long rb = -1;
            if (!isS) { const int t = row & (SEQ - 1), b = row >> 12; if (t >= SEQ - WBUF) rb = (((long)l * NBP + b) * WBUF + (t - (SEQ - WBUF))) * 384; }
            else { const int t = (row - MP) & 3, b = (row - MP) >> 2; rb = (((long)l * NBS + b) * WBUF + (WBUF - TS + t)) * 384; }
            if (rb >= 0) {
                if (e < 288) { const int hh = e / 48, d = 16 + e % 48; owk[rb + hh * 64 + d] = bf2f(H[(size_t)row * IN_COLS + COL_KB + hh * 64 + d]); }
                else { const int e2 = e - 288; owv[rb + e2] = bf2f(H[(size_t)row * IN_COLS + COL_VB + e2]); }
            }
        }
        if (!isS) { if (((row0 + 15) & (SEQ - 1)) == SEQ - 1) { const int b = row0 >> 12; for (int c = tid; c < A_COLS; c += NTHR) F.out[O_PSHIFT + ((size_t)l * NBP + b) * A_COLS + c] = bf2f(H[(size_t)(row0 + 15) * IN_COLS + c]); } }
        else { for (int q = tid; q < 4 * A_COLS; q += NTHR) { const int bb = q / A_COLS, c = q % A_COLS, b = ((row0 - MP) >> 2) + bb; F.out[O_SSHIFT + ((size_t)l * NBS + b) * A_COLS + c] = bf2f(H[(size_t)(row0 + 4 * bb + 3) * IN_COLS + c]); } }
        __syncthreads();
    }
}

__device__ __forceinline__ f32x4 mfma16(bf16x8 a, bf16x8 b, f32x4 c) { return __builtin_amdgcn_mfma_f32_16x16x32_bf16(a, b, c, 0, 0, 0); }

__device__ __forceinline__ void scan_item(Frame& F, const float* SC, float* OA, int rowbase, int T, int h, int half, const float* S0, float* Sout) {
    constexpr int CH = 32;
    LAS float* buf = (LAS float*)F.lds;
    LAS float* vbuf = buf + 2 * CH * 320;
    int tid = F.tid; asm volatile("" : "+v"(tid));
    const int lane = tid & 63, w = F.wave, rg = lane >> 4, j = lane & 15;
    const int vrow = half * 32 + w * 4 + rg;
    float S[4];
    if (S0) { const f32x4 s = *(const f32x4*)(S0 + vrow * 64 + 4 * j); S[0] = s[0]; S[1] = s[1]; S[2] = s[2]; S[3] = s[3]; } else { S[0] = S[1] = S[2] = S[3] = 0.f; }
    const int nch = (T + CH - 1) / CH;
    f32x4 st[5]; float sv[2];
    int sstep[5], soff[5], ldso[5];
#pragma unroll
    for (int i = 0; i < 5; ++i) { const int idx = tid + NTHR * i, step = idx / 80, rem = idx % 80, v5 = rem >> 4, q = rem & 15; const int vid = v5 < 3 ? v5 : v5 + 1;
        sstep[i] = step; soff[i] = vid * 64 + q * 4; ldso[i] = step * 320 + v5 * 64 + q * 4; }
    const int vstep0 = tid >> 5, vr = tid & 31;
#define SCAN_ISSUE(c) do { _Pragma("unroll") for (int i = 0; i < 5; ++i) { const int t = (c) * CH + sstep[i]; st[i] = t < T ? *(const f32x4*)(SC + ((size_t)(rowbase + t) * 6 + h) * 384 + soff[i]) : (f32x4){0.f, 0.f, 0.f, 0.f}; } \
        _Pragma("unroll") for (int i = 0; i < 2; ++i) { const int t = (c) * CH + vstep0 + 16 * i; sv[i] = t < T ? SC[((size_t)(rowbase + t) * 6 + h) * 384 + 192 + half * 32 + vr] : 0.f; } } while (0)
#define SCAN_WRITE(bs) do { _Pragma("unroll") for (int i = 0; i < 5; ++i) *(LAS f32x4*)(buf + (bs) * CH * 320 + ldso[i]) = st[i]; \
        _Pragma("unroll") for (int i = 0; i < 2; ++i) vbuf[(bs) * CH * 32 + (vstep0 + 16 * i) * 32 + vr] = sv[i]; } while (0)
    SCAN_ISSUE(0); SCAN_WRITE(0);
    __syncthreads();
    for (int c = 0; c < nch; ++c) {
        const int bs = c & 1;
        if (c + 1 < nch) SCAN_ISSUE(c + 1);
        const int ns = (T - c * CH) < CH ? (T - c * CH) : CH;
        const LAS float* bp = buf + bs * CH * 320 + 4 * j; const LAS float* vp = vbuf + bs * CH * 32 + w * 4 + rg;
        for (int s = 0; s < ns; ++s) {
            const f32x4 r4 = *(const LAS f32x4*)(bp + s * 320), w4 = *(const LAS f32x4*)(bp + s * 320 + 64), k4 = *(const LAS f32x4*)(bp + s * 320 + 128),
                        kk4 = *(const LAS f32x4*)(bp + s * 320 + 192), b4 = *(const LAS f32x4*)(bp + s * 320 + 256);
            const float vv = vp[s * 32];
            float sa = (S[0] * kk4[0] + S[1] * kk4[1]) + (S[2] * kk4[2] + S[3] * kk4[3]);
            sa = red16(sa);
#pragma unroll
            for (int e = 0; e < 4; ++e) S[e] = S[e] * w4[e] + (vv * k4[e] - sa * b4[e]);
            float o = (S[0] * r4[0] + S[1] * r4[1]) + (S[2] * r4[2] + S[3] * r4[3]);
            o = red16(o);
            if (j == 0) OA[(size_t)(rowbase + c * CH + s) * WA + h * 64 + vrow] = o;
        }
        if (c + 1 < nch) SCAN_WRITE(bs ^ 1);
        __syncthreads();
    }
#undef SCAN_ISSUE
#undef SCAN_WRITE
    *(f32x4*)(Sout + vrow * 64 + 4 * j) = (f32x4){S[0], S[1], S[2], S[3]};
}

__device__ __forceinline__ void attn_unit(Frame& F, const bf16* H, float* OB, float* LSE, int unit) {
    const int cls = unit & 31, di = (unit >> 5) % 3, bh = unit / 96, h = bh % 6, b = bh / 6;
    const int d = di == 0 ? 1 : (di == 1 ? 4 : 16), nbk = 32 / d, r = cls / nbk, n = cls % nbk;
    LAS bf16* Kl = (LAS bf16*)F.lds;
    LAS bf16* VT = Kl + 256 * 72;
    int tid = F.tid; asm volatile("" : "+v"(tid));
    const int lane = tid & 63, w = F.wave, g = lane >> 4, lq = lane & 15;
#pragma unroll
    for (int i = 0; i < 4; ++i) {
        const int cid = tid + NTHR * i, ki = cid >> 3, ch = cid & 7, ci = (n - 1) * 128 + ki;
        v4u kv = (v4u){0u, 0u, 0u, 0u}, vv = kv;
        if (ci >= 0) { const size_t row = (size_t)b * SEQ + (size_t)ci * d + r; kv = *(const v4u*)(H + row * IN_COLS + COL_KB + h * 64 + ch * 8); vv = *(const v4u*)(H + row * IN_COLS + COL_VB + h * 64 + ch * 8); }
        *(LAS v4u*)(Kl + ki * 72 + ch * 8) = kv;
        LAS bf16* vt = VT + (ch * 8) * 264 + ki;
        vt[0 * 264] = (bf16)(vv.x & 0xffffu); vt[1 * 264] = (bf16)(vv.x >> 16); vt[2 * 264] = (bf16)(vv.y & 0xffffu); vt[3 * 264] = (bf16)(vv.y >> 16);
        vt[4 * 264] = (bf16)(vv.z & 0xffffu); vt[5 * 264] = (bf16)(vv.z >> 16); vt[6 * 264] = (bf16)(vv.w & 0xffffu); vt[7 * 264] = (bf16)(vv.w >> 16);
    }
    __syncthreads();
    const int qi = 16 * w + lq;
    const size_t qrow = (size_t)b * SEQ + (size_t)(n * 128 + qi) * d + r;
    bf16x8 qf[2];
    qf[0] = *(const bf16x8*)(H + qrow * IN_COLS + COL_QB + h * 64 + 8 * g); qf[1] = *(const bf16x8*)(H + qrow * IN_COLS + COL_QB + h * 64 + 32 + 8 * g);
    f32x4 s[10];
#pragma unroll
    for (int tt = 0; tt < 9; ++tt) {
        const int kt = w + tt; s[tt] = (f32x4){0.f, 0.f, 0.f, 0.f};
#pragma unroll
        for (int ks = 0; ks < 2; ++ks) { const bf16x8 a = *(const LAS bf16x8*)(Kl + (kt * 16 + lq) * 72 + 32 * ks + 8 * g); s[tt] = mfma16(a, qf[ks], s[tt]); }
    }
    s[9] = (f32x4){0.f, 0.f, 0.f, 0.f};
    float m = -1e30f;
#pragma unroll
    for (int tt = 0; tt < 9; ++tt)
#pragma unroll
        for (int e = 0; e < 4; ++e) { const int ki = (w + tt) * 16 + 4 * g + e; const bool ok = ki >= qi && ki <= qi + 128 && (n > 0 || ki >= 128);
            const float sv = ok ? s[tt][e] * 0.125f : -1e30f; s[tt][e] = sv; m = fmaxf(m, sv); }
    m = fmaxf(m, __shfl_xor(m, 16)); m = fmaxf(m, __shfl_xor(m, 32));
    float lsum = 0.f;
#pragma unroll
    for (int tt = 0; tt < 9; ++tt)
#pragma unroll
        for (int e = 0; e < 4; ++e) { const float p = s[tt][e] > -1e29f ? __expf(s[tt][e] - m) : 0.f; s[tt][e] = p; lsum += p; }
    lsum += __shfl_xor(lsum, 16); lsum += __shfl_xor(lsum, 32);
    f32x4 o[4];
#pragma unroll
    for (int dt = 0; dt < 4; ++dt) o[dt] = (f32x4){0.f, 0.f, 0.f, 0.f};
#pragma unroll
    for (int pp = 0; pp < 5; ++pp) {
        const int T0 = 2 * pp, T1 = 2 * pp + 1;
        union { unsigned u[4]; bf16x8 v; } pb;
        pb.u[0] = pk2(s[T0][0], s[T0][1]); pb.u[1] = pk2(s[T0][2], s[T0][3]); pb.u[2] = pk2(s[T1][0], s[T1][1]); pb.u[3] = pk2(s[T1][2], s[T1][3]);
        const int k0 = (w + T0) * 16 + 4 * g, k1 = (w + (T1 < 9 ? T1 : T0)) * 16 + 4 * g;
#pragma unroll
        for (int dt = 0; dt < 4; ++dt) {
            union { unsigned long long q[2]; bf16x8 v; } av;
            av.q[0] = *(const LAS unsigned long long*)(VT + (dt * 16 + lq) * 264 + k0); av.q[1] = *(const LAS unsigned long long*)(VT + (dt * 16 + lq) * 264 + k1);
            o[dt] = mfma16(av.v, pb.v, o[dt]);
        }
    }
    const float inv = 1.0f / lsum;
    float* op = OB + ((size_t)di * MT + qrow) * 384 + h * 64 + 4 * g;
#pragma unroll
    for (int dt = 0; dt < 4; ++dt) *(f32x4*)(op + dt * 16) = o[dt] * inv;
    if (g == 0) LSE[((size_t)di * MT + qrow) * 6 + h] = m + __logf(lsum);
    __syncthreads();
}

__device__ __forceinline__ void sattn_item(Frame& F, int l, const bf16* H, float* OB, float* LSE, int item) {
    int lane = F.lane; asm volatile("" : "+v"(lane));
    const int qx = item * 8 + F.wave;
    if (qx >= MS * 6) return;
    const int b = qx / 24, t = (qx / 6) & 3, h = qx % 6; const size_t row = MP + b * 4 + t;
    const float* ck = inp(F, 4) + ((size_t)l * NBS + b) * WBUF * 384 + h * 64 + lane; const float* cv = inp(F, 5) + ((size_t)l * NBS + b) * WBUF * 384 + h * 64 + lane;
    const bf16* hk = H + (size_t)(MP + b * 4) * IN_COLS + COL_KB + h * 64 + lane; const bf16* hv = H + (size_t)(MP + b * 4) * IN_COLS + COL_VB + h * 64 + lane;
    const float qv = bf2f(H[row * IN_COLS + COL_QB + h * 64 + lane]) * 0.125f;
    for (int di = 0; di < 3; ++di) {
        const int d = di == 0 ? 1 : (di == 1 ? 4 : 16);
        float sA = -1e30f, sB = -1e30f, sC = -1e30f;
        for (int jk = 0; jk <= 128; ++jk) {
            const int idx = WBUF + t - d * jk;
            const float kval = idx >= WBUF ? bf2f(hk[(size_t)(idx - WBUF) * IN_COLS]) : ck[(size_t)idx * 384];
            const float sc = wave_sum(qv * kval);
            if (jk < 64) { if (lane == jk) sA = sc; } else if (jk < 128) { if (lane == jk - 64) sB = sc; } else { if (lane == 0) sC = sc; }
        }
        const float m = wave_max(fmaxf(fmaxf(sA, sB), sC));
        const float pA = __expf(sA - m), pB = __expf(sB - m), pC = lane == 0 ? __expf(sC - m) : 0.f;
        const float lsum = wave_sum(pA + pB + pC);
        float o = 0.f;
        for (int jk = 0; jk <= 128; ++jk) {
            const int idx = WBUF + t - d * jk;
            const float vval = idx >= WBUF ? bf2f(hv[(size_t)(idx - WBUF) * IN_COLS]) : cv[(size_t)idx * 384];
            const float src = jk < 64 ? pA : (jk < 128 ? pB : pC);
            const float pj = __int_as_float(__builtin_amdgcn_readlane(__float_as_int(src), jk & 63));
            o += pj * vval;
        }
        OB[((size_t)di * MT + row) * 384 + h * 64 + lane] = o / lsum;
        if (lane == 0) LSE[((size_t)di * MT + row) * 6 + h] = m + __logf(lsum);
    }
}

__device__ __forceinline__ void ret_item(Frame& F, int l, const bf16* H, float* OC, int item) {
    const int b = item >> 2, h = item & 3;
    const float gam = 1.0f - exp2f(-5.0f - (float)h), lg2 = log2f(gam);
    LAS bf16* Kl = (LAS bf16*)F.lds;
    LAS bf16* KTd = Kl + 128 * 72;
    LAS bf16* VT = KTd + 64 * 136;
    LAS bf16* RT = VT + 64 * 136;
    int tid = F.tid; asm volatile("" : "+v"(tid));
    const int lane = tid & 63, w = F.wave, g = lane >> 4, lq = lane & 15;
    for (int i = tid; i < 64 * 72; i += NTHR) RT[i] = 0;
    f32x4 Rr[2]; Rr[0] = (f32x4){0.f, 0.f, 0.f, 0.f}; Rr[1] = Rr[0];
    const float gch = exp2f(128.0f * lg2);
    const int qi = 16 * w + lq;
    const float qdec = exp2f((float)(qi + 1) * lg2);
    __syncthreads();
    for (int c = 0; c < SEQ / 128; ++c) {
        const size_t rowc = (size_t)b * SEQ + c * 128;
#pragma unroll
        for (int i = 0; i < 2; ++i) {
            const int cid = tid + NTHR * i, key = cid >> 3, ch = cid & 7;
            const v4u kv = *(const v4u*)(H + (rowc + key) * IN_COLS + COL_KC + h * 64 + ch * 8), vv = *(const v4u*)(H + (rowc + key) * IN_COLS + COL_VC + h * 64 + ch * 8);
            *(LAS v4u*)(Kl + key * 72 + ch * 8) = kv;
            const float kd = exp2f((float)(127 - key) * lg2);
            const unsigned ku[4] = {kv.x, kv.y, kv.z, kv.w}, vu[4] = {vv.x, vv.y, vv.z, vv.w};
#pragma unroll
            for (int e = 0; e < 8; ++e) { const unsigned kb = (ku[e >> 1] >> ((e & 1) * 16)) & 0xffffu, vb = (vu[e >> 1] >> ((e & 1) * 16)) & 0xffffu;
                KTd[(ch * 8 + e) * 136 + key] = (bf16)f2bf(bf2f((bf16)kb) * kd); VT[(ch * 8 + e) * 136 + key] = (bf16)vb; }
        }
        __syncthreads();
        const size_t qrow = rowc + qi;
        bf16x8 qf[2];
        qf[0] = *(const bf16x8*)(H + qrow * IN_COLS + COL_QC + h * 64 + 8 * g); qf[1] = *(const bf16x8*)(H + qrow * IN_COLS + COL_QC + h * 64 + 32 + 8 * g);
        f32x4 s[8];
#pragma unroll
        for (int jt = 0; jt < 8; ++jt) {
            s[jt] = (f32x4){0.f, 0.f, 0.f, 0.f};
            if (jt <= w) {
#pragma unroll
                for (int ks = 0; ks < 2; ++ks) { const bf16x8 a = *(const LAS bf16x8*)(Kl + (jt * 16 + lq) * 72 + 32 * ks + 8 * g); s[jt] = mfma16(a, qf[ks], s[jt]); }
#pragma unroll
                for (int e = 0; e < 4; ++e) { const int kj = jt * 16 + 4 * g + e; s[jt][e] = kj <= qi ? s[jt][e] * exp2f((float)(qi - kj) * lg2) : 0.f; }
            }
        }
        f32x4 o[4], x[4];
#pragma unroll
        for (int ft = 0; ft < 4; ++ft) { o[ft] = (f32x4){0.f, 0.f, 0.f, 0.f}; x[ft] = o[ft]; }
#pragma unroll
        for (int pp = 0; pp < 4; ++pp) {
            if (2 * pp <= w) {
                union { unsigned u[4]; bf16x8 v; } pb;
                pb.u[0] = pk2(s[2 * pp][0], s[2 * pp][1]); pb.u[1] = pk2(s[2 * pp][2], s[2 * pp][3]); pb.u[2] = pk2(s[2 * pp + 1][0], s[2 * pp + 1][1]); pb.u[3] = pk2(s[2 * pp + 1][2], s[2 * pp + 1][3]);
                const int k0 = (2 * pp) * 16 + 4 * g, k1 = (2 * pp + 1) * 16 + 4 * g;
#pragma unroll
                for (int ft = 0; ft < 4; ++ft) {
                    union { unsigned long long q[2]; bf16x8 v; } av;
                    av.q[0] = *(const LAS unsigned long long*)(VT + (ft * 16 + lq) * 136 + k0); av.q[1] = *(const LAS unsigned long long*)(VT + (ft * 16 + lq) * 136 + k1);
                    o[ft] = mfma16(av.v, pb.v, o[ft]);
                }
            }
        }
#pragma unroll
        for (int ft = 0; ft < 4; ++ft)
#pragma unroll
            for (int ks = 0; ks < 2; ++ks) { const bf16x8 a = *(const LAS bf16x8*)(RT + (ft * 16 + lq) * 72 + 32 * ks + 8 * g); x[ft] = mfma16(a, qf[ks], x[ft]); }
        float* op = OC + qrow * 256 + h * 64 + 4 * g;
#pragma unroll
        for (int ft = 0; ft < 4; ++ft) *(f32x4*)(op + ft * 16) = o[ft] + x[ft] * qdec;
#pragma unroll
        for (int ti = 0; ti < 2; ++ti) {
            const int tl = 2 * w + ti, ft = tl >> 2, et = tl & 3;
            f32x4 acc = Rr[ti] * gch;
#pragma unroll
            for (int ks = 0; ks < 4; ++ks) {
                const bf16x8 a = *(const LAS bf16x8*)(VT + (ft * 16 + lq) * 136 + 32 * ks + 8 * g), bb = *(const LAS bf16x8*)(KTd + (et * 16 + lq) * 136 + 32 * ks + 8 * g);
                acc = mfma16(a, bb, acc);
            }
            Rr[ti] = acc;
        }
        __syncthreads();
#pragma unroll
        for (int ti = 0; ti < 2; ++ti) { const int tl = 2 * w + ti, ft = tl >> 2, et = tl & 3;
#pragma unroll
            for (int e = 0; e < 4; ++e) RT[(ft * 16 + 4 * g + e) * 72 + et * 16 + lq] = (bf16)f2bf(Rr[ti][e]); }
        __syncthreads();
    }
    float* po = F.out + O_PRET + (((size_t)l * NBP + b) * 4 + h) * 4096;
#pragma unroll
    for (int ti = 0; ti < 2; ++ti) { const int tl = 2 * w + ti, ft = tl >> 2, et = tl & 3; *(f32x4*)(po + (et * 16 + lq) * 64 + ft * 16 + 4 * g) = Rr[ti]; }
}

__device__ __forceinline__ void sret_item(Frame& F, int l, const bf16* H, float* OC, int item) {
    int tid = F.tid; asm volatile("" : "+v"(tid));
    const int b = item >> 2, h = item & 3, f = tid & 63, eg = tid >> 6;
    const float gam = 1.0f - exp2f(-5.0f - (float)h);
    const float* r0 = inp(F, 6) + (((size_t)l * NBS + b) * 4 + h) * 4096;
    LAS float* red = (LAS float*)F.lds;
    float S[8];
#pragma unroll
    for (int e = 0; e < 8; ++e) S[e] = r0[(eg * 8 + e) * 64 + f];
    for (int t = 0; t < TS; ++t) {
        const size_t row = MP + b * 4 + t; const bf16* hp = H + row * IN_COLS;
        const float vf = bf2f(hp[COL_VC + h * 64 + f]);
        float part = 0.f;
#pragma unroll
        for (int e = 0; e < 8; ++e) { const float ke = bf2f(hp[COL_KC + h * 64 + eg * 8 + e]), qe = bf2f(hp[COL_QC + h * 64 + eg * 8 + e]); S[e] = gam * S[e] + ke * vf; part += qe * S[e]; }
        red[eg * 64 + f] = part;
        __syncthreads();
        if (tid < 64) { float o = 0.f;
#pragma unroll
            for (int q = 0; q < 8; ++q) o += red[q * 64 + tid];
            OC[row * 256 + h * 64 + tid] = o; }
        __syncthreads();
    }
    float* so = F.out + O_SRET + (((size_t)l * NBS + b) * 4 + h) * 4096;
#pragma unroll
    for (int e = 0; e < 8; ++e) so[(eg * 8 + e) * 64 + f] = S[e];
}

__device__ __forceinline__ void copy_item(Frame& F, int l, int item) {
    const int which = item >> 8, b = (item >> 3) & 31, part = item & 7;
    constexpr int N4 = (WBUF - TS) * 384 / 4, P4 = N4 / 8;
    static_assert(N4 % 8 == 0, "copy split");
    const f32x4* src = (const f32x4*)((which ? inp(F, 5) : inp(F, 4)) + (((size_t)l * NBS + b) * WBUF + TS) * 384) + (size_t)part * P4;
    f32x4* dst = (f32x4*)(F.out + (which ? O_SWINV : O_SWINK) + ((size_t)l * NBS + b) * WBUF * 384) + (size_t)part * P4;
    int tid = F.tid; asm volatile("" : "+v"(tid));
    for (int i = tid; i < P4; i += NTHR) __builtin_nontemporal_store(__builtin_nontemporal_load(src + i), dst + i);
}

__device__ __forceinline__ void mixers_phase(Frame& F, int l) {
    const bf16* H = (const bf16*)(F.ws + WS_H); const float* SC = (const float*)(F.ws + WS_SC); float* OA = (float*)(F.ws + WS_OA);
    float* OB = (float*)(F.ws + WS_OB); float* LSE = (float*)(F.ws + WS_LSE); float* OC = (float*)(F.ws + WS_OC);
    const int bid = F.bid;
#ifndef MXM
#define MXM 0xff
#endif
    if (bid < 48) {  if (MXM & 1) {
        const int bh = bid >> 1, half = bid & 1, b = bh / 6, h = bh % 6;
        scan_item(F, SC, OA, b * SEQ, SEQ, h, half, nullptr, F.out + O_PWKV + (((size_t)l * NBP + b) * 6 + h) * 4096); }
    } else if (bid < 64) {
        if (MXM & 2) ret_item(F, l, H, OC, bid - 48);
    } else {
        constexpr int N_SSCAN = NBS * 6 * 2, N_SATT = (MS * 6) / 8, N_SRET = NBS * 4, N_ATT = NBP * 6 * 3 * 32, N_COPY = 512;
        constexpr int N_ALL = N_SSCAN + N_SATT + N_SRET + N_ATT + N_COPY;
        for (int it = bid - 64; it < N_ALL; it += F.G - 64) {
            int r = it;
            if (r < N_SSCAN) { if (MXM & 4) { const int bh = r >> 1, half = r & 1, b = bh / 6, h = bh % 6;
                scan_item(F, SC, OA, MP + b * TS, TS, h, half, inp(F, 3) + (((size_t)l * NBS + b) * 6 + h) * 4096, F.out + O_SWKV + (((size_t)l * NBS + b) * 6 + h) * 4096); __syncthreads(); } continue; } r -= N_SSCAN;
            if (r < N_SATT) { if (MXM & 8) sattn_item(F, l, H, OB, LSE, r); continue; } r -= N_SATT;
            if (r < N_SRET) { if (MXM & 16) sret_item(F, l, H, OC, r); continue; } r -= N_SRET;
            if (r < N_ATT) { if (MXM & 32) attn_unit(F, H, OB, LSE, r); continue; } r -= N_ATT;
            if (MXM & 64) copy_item(F, l, r);
        }
    }
}

__device__ __forceinline__ void post_phase(Frame& F, int l) {
    const bf16* H = (const bf16*)(F.ws + WS_H); const float* SC = (const float*)(F.ws + WS_SC); const float* OA = (const float*)(F.ws + WS_OA);
    const float* OB = (const float*)(F.ws + WS_OB); const float* LSE = (const float*)(F.ws + WS_LSE); const float* OC = (const float*)(F.ws + WS_OC);
    const float* Gt = (const float*)(F.ws + WS_G); const float* RK = (const float*)(F.ws + WS_RK); bf16* MIX = (bf16*)(F.ws + WS_MIX);
    const float* gna = inp(F, 17) + l * WA; const float* gnb = inp(F, 18) + l * WA; const float* rgg = inp(F, 19) + l * 256; const float* rgb = inp(F, 20) + l * 256;
    const int lane = F.lane;
    for (int row = F.bid * NWAVES + F.wave; row < MV; row += F.G * NWAVES) {
        bf16* mx = MIX + (size_t)row * DM;
#pragma unroll
        for (int h = 0; h < 6; ++h) {
            const int c = h * 64 + lane;
            const float o = OA[(size_t)row * WA + c];
            const float mean = wave_sum(o) * (1.f / 64.f); const float dlt = o - mean; const float var = wave_sum(dlt * dlt) * (1.f / 64.f);
            float y = dlt * rsqrtf(var + GN_EPS_A) * gna[c] + gnb[c];
            y += RK[row * 6 + h] * SC[((size_t)row * 6 + h) * 384 + 192 + lane];
            mx[c] = (bf16)f2bf(y * Gt[(size_t)row * WA + c]);
        }
#pragma unroll
        for (int h = 0; h < 6; ++h) {
            const int c = h * 64 + lane;
            const float l0 = LSE[((size_t)0 * MT + row) * 6 + h], l1 = LSE[((size_t)1 * MT + row) * 6 + h], l2 = LSE[((size_t)2 * MT + row) * 6 + h];
            const float m = fmaxf(fmaxf(l0, l1), l2); const float e0 = __expf(l0 - m), e1 = __expf(l1 - m), e2 = __expf(l2 - m); const float inv = 1.0f / (e0 + e1 + e2);
            const float y = (e0 * OB[((size_t)0 * MT + row) * 384 + c] + e1 * OB[((size_t)1 * MT + row) * 384 + c] + e2 * OB[((size_t)2 * MT + row) * 384 + c]) * inv;
            mx[WA + c] = (bf16)f2bf(y);
        }
#pragma unroll
        for (int h = 0; h < 4; ++h) {
            const int c = h * 64 + lane;
            const float o = OC[(size_t)row * 256 + c];
            const float mean = wave_sum(o) * (1.f / 64.f); const float dlt = o - mean; const float var = wave_sum(dlt * dlt) * (1.f / 64.f);
            const float y = dlt * rsqrtf(var + LN_EPS) * rgg[c] + rgb[c];
            const float gc = bf2f(H[(size_t)row * IN_COLS + COL_GC + c]);
            mx[2 * WA + c] = (bf16)f2bf(y * gc * sigmoid_f(gc));
        }
    }
}

__device__ __forceinline__ void ln_phase(Frame& F, const float* V, const float* gw, const float* bw, float* outP, float* outS, bf16* ob) {
    const int lane = F.lane;
    for (int row = F.bid * NWAVES + F.wave; row < MV; row += F.G * NWAVES) {
        const GAS f32x4* xr = (const GAS f32x4*)(V + (size_t)row * DM) + lane;
        f32x4 v[4]; float s = 0.f;
#pragma unroll
        for (int j = 0; j < 4; ++j) { v[j] = xr[64 * j]; s += (v[j].x + v[j].y) + (v[j].z + v[j].w); }
        const float mean = wave_sum(s) * (1.f / DM); float s2 = 0.f;
#pragma unroll
        for (int j = 0; j < 4; ++j) { v[j] = v[j] - mean; s2 += (v[j].x * v[j].x + v[j].y * v[j].y) + (v[j].z * v[j].z + v[j].w * v[j].w); }
        const float rstd = rsqrtf(wave_sum(s2) * (1.f / DM) + LN_EPS);
        float* orow = row < MP ? outP + (size_t)row * DM : outS + (size_t)(row - MP) * DM;
#pragma unroll
        for (int j = 0; j < 4; ++j) {
            const f32x4 gg = ((const f32x4*)gw)[lane + 64 * j], bb = ((const f32x4*)bw)[lane + 64 * j];
            const f32x4 y = v[j] * rstd * gg + bb;
            ((GAS f32x4*)orow)[lane + 64 * j] = y;
            if (ob) ((GAS unsigned long long*)(ob + (size_t)row * DM))[lane + 64 * j] = (unsigned long long)pk2(y.x, y.y) | ((unsigned long long)pk2(y.z, y.w) << 32);
        }
    }
}

struct Args { const float* in[29]; float* out; unsigned char* ws; int ph_lo, ph_hi; };
static_assert(sizeof(Args) == 29 * 8 + 8 + 8 + 8, "Args has no padding");
__global__ void __launch_bounds__(NTHR, 2) mk_fwd(Args args) {
    extern __shared__ __attribute__((aligned(16))) unsigned char lds[];
    Frame F;
    F.lds = (LAS unsigned char*)lds; F.MISC = (volatile LAS unsigned*)(F.lds + MISC_OFF);
    F.tid = threadIdx.x; F.lane = F.tid & 63; F.wave = __builtin_amdgcn_readfirstlane(F.tid >> 6); F.G = gridDim.x; F.bid = blockIdx.x;
    F.out = args.out; F.ws = args.ws; F.ctl = (gu32*)(args.ws + WS_CTL);
    for (int u = F.tid; u < (LDS_BYTES - LDSCTL_OFF) / 4; u += NTHR) ((LAS unsigned*)(F.lds + LDSCTL_OFF))[u] = 0u;
    __syncthreads();
    if (F.tid < 29) ((LAS unsigned long long*)(F.lds + INTAB_OFF))[F.tid] = (unsigned long long)args.in[F.tid];
    __syncthreads();
    const bool multi = args.ph_hi - args.ph_lo > 1;
    XcdBarrier bar; bar.bar = (unsigned*)(F.ctl + CW_BAR); bar.x = 0; bar.st = nullptr;
    if (multi) bar = xcd_barrier_post((unsigned*)(F.ctl + CW_BAR), F.MISC + 8);
    for (int ph = args.ph_lo; ph < args.ph_hi; ++ph) {
        { unsigned char* wsl = args.ws; float* outl = args.out; asm volatile("" : "+s"(wsl), "+s"(outl)); F.ws = wsl; F.out = outl;
          int tl = threadIdx.x; asm volatile("" : "+v"(tl)); F.tid = tl; F.lane = tl & 63; F.wave = __builtin_amdgcn_readfirstlane(tl >> 6); }
#ifndef PHM
#define PHM 0x3ff
#endif
        if (ph == 0) { if (PHM & 1) p0_prologue(F); }
        else {
            const int l = (ph - 1) / NST, st = (ph - 1) % NST;
            unsigned char* wb = F.ws + WS_W + (size_t)l * LW;
            if (st == 0 && (PHM & 2)) {
                pg8::Gemm g{(const bf16*)(F.ws + WS_XB), (const bf16*)(wb + W_IN), MT, IN_COLS, DM}; pg8::StaticOrder S; S.init(MT, IN_COLS, F.G, F.bid);
                pg8::EpiH E{(bf16*)(F.ws + WS_H), IN_COLS};
                pg8::gemm_phase<pg8::EpiH, pg8::StaticOrder, true, true>(F.lds, g, S, E);
            } else if (st == 1) { if (PHM & 4) prep_phase(F, l); }
            else if (st == 2) { if (PHM & 8) mixers_phase(F, l); }
            else if (st == 3) { if (PHM & 16) post_phase(F, l); }
            else if (st == 4) { if (PHM & 32) {
                pg8::Gemm g{(const bf16*)(F.ws + WS_MIX), (const bf16*)(wb + W_OUT), MT, DM, DM}; pg8::StaticOrder S; S.init(MT, DM, F.G, F.bid);
                const float* bP = l == 0 ? inp(F, 0) : (const float*)(F.ws + WS_XF); const float* bS = l == 0 ? inp(F, 1) : (const float*)(F.ws + WS_XF) + (size_t)MP * DM;
                pg8::EpiResF32 E{bP, bS, (float*)(F.ws + WS_V), DN_ALPHA, MP, MV};
                pg8::gemm_phase<pg8::EpiResF32, pg8::StaticOrder, true, true>(F.lds, g, S, E); }
            } else if (st == 5) ln_phase(F, (const float*)(F.ws + WS_V), inp(F, 22) + l * DM, inp(F, 23) + l * DM, (float*)(F.ws + WS_X1F), (float*)(F.ws + WS_X1F) + (size_t)MP * DM, (bf16*)(F.ws + WS_X1B));
            else if (st == 6) { if (PHM & 64) {
                pg8::Gemm g{(const bf16*)(F.ws + WS_X1B), (const bf16*)(wb + W_GU), MT, NGU, DM}; pg8::StaticOrder S; S.init(MT, NGU, F.G, F.bid);
                pg8::EpiSwiglu E{(bf16*)(F.ws + WS_HFF), DFF};
                pg8::gemm_phase<pg8::EpiSwiglu, pg8::StaticOrder, true, true>(F.lds, g, S, E); }
            } else if (st == 7) { if (PHM & 128) {
                pg8::Gemm g{(const bf16*)(F.ws + WS_HFF), (const bf16*)(wb + W_D), MT, DM, DFF}; pg8::StaticOrder S; S.init(MT, DM, F.G, F.bid);
                pg8::EpiResF32 E{(const float*)(F.ws + WS_X1F), (const float*)(F.ws + WS_X1F) + (size_t)MP * DM, (float*)(F.ws + WS_V), DN_ALPHA, MP, MV};
                pg8::gemm_phase<pg8::EpiResF32, pg8::StaticOrder, true, true>(F.lds, g, S, E); }
            } else {
                if (l == 0) ln_phase(F, (const float*)(F.ws + WS_V), inp(F, 27) + l * DM, inp(F, 28) + l * DM, (float*)(F.ws + WS_XF), (float*)(F.ws + WS_XF) + (size_t)MP * DM, (bf16*)(F.ws + WS_XB));
                else ln_phase(F, (const float*)(F.ws + WS_V), inp(F, 27) + l * DM, inp(F, 28) + l * DM, F.out + O_YP, F.out + O_YS, nullptr);
            }
        }
        if (ph + 1 < args.ph_hi) { XcdBarrier b2 = bar; unsigned* bb = bar.bar; unsigned xx = bar.x; asm volatile("" : "+s"(bb), "+s"(xx)); b2.bar = bb; b2.x = xx; xcd_barrier(b2); }
    }
}

#ifndef MK_SPLIT
#define MK_SPLIT 1
#endif
extern "C" void kernel_launch(void* const* d_in, const int* in_sizes, int n_in, void* d_out, int out_size, void* d_ws, size_t ws_size, hipStream_t stream) {
    static int grid = 0;
    if (grid == 0) {
        if (n_in != 29 || out_size != (int)O_END || ws_size < WS_END) { fprintf(stderr, "kernel_launch: unexpected shapes (n_in %d out %d ws %zu)\n", n_in, out_size, ws_size); grid = -1; return; }
        int dev = 0, cus = 0, per_cu = 0;
        if (hipGetDevice(&dev) != hipSuccess || hipDeviceGetAttribute(&cus, hipDeviceAttributeMultiprocessorCount, dev) != hipSuccess) { grid = -1; return; }
        if (hipFuncSetAttribute((const void*)mk_fwd, hipFuncAttributeMaxDynamicSharedMemorySize, LDS_BYTES) != hipSuccess) { fprintf(stderr, "kernel_launch: hipFuncSetAttribute failed\n"); grid = -1; return; }
        if (hipOccupancyMaxActiveBlocksPerMultiprocessor(&per_cu, (const void*)mk_fwd, NTHR, LDS_BYTES) != hipSuccess || per_cu < 1) { fprintf(stderr, "kernel_launch: occupancy query says %d blocks per CU\n", per_cu); (void)hipGetLastError(); grid = -1; return; }
        grid = cus;
        if (grid != 256) { fprintf(stderr, "kernel_launch: built for 256 CUs, device has %d\n", cus); grid = -1; return; }
    }
    if (grid < 0) return;
    (void)hipMemsetAsync((char*)d_ws + WS_CTL, 0, CTL_ZERO_BYTES, stream);
    Args a{};
    for (int i = 0; i < 29; ++i) a.in[i] = (const float*)d_in[i];
    a.out = (float*)d_out; a.ws = (unsigned char*)d_ws;
#if MK_SPLIT
    for (int ph = 0; ph < NPHASE; ++ph) { a.ph_lo = ph; a.ph_hi = ph + 1; hipLaunchKernelGGL(mk_fwd, dim3(grid), dim3(NTHR), LDS_BYTES, stream, a); }
#else
    a.ph_lo = 0; a.ph_hi = NPHASE; hipLaunchKernelGGL(mk_fwd, dim3(grid), dim3(NTHR), LDS_BYTES, stream, a);
#endif
}
```

```cpp
#include <hip/hip_runtime.h>
#include <cstdio>
#include <cstdint>
namespace pg8 {
#define PG8_LAS __attribute__((address_space(3)))
typedef unsigned short bf16_t;
typedef short bf16x8 __attribute__((ext_vector_type(8)));
typedef float f32x4 __attribute__((ext_vector_type(4)));
typedef unsigned u32x4 __attribute__((ext_vector_type(4)));
constexpr int BM = 256, BK = 64, HALF = 128, HTB = HALF * BK * 2  , STAGE_BYTES = 8 * HTB, NXCD = 8, WGM = 8;

__host__ __device__ __forceinline__ int lds_byte(int r, int c) { const int st = (r >> 4) * 2 + (c >> 5), rr = r & 15, cc = c & 31, ob = rr * 64 + cc * 2; return st * 1024 + (ob ^ (((ob >> 9) & 1) << 5)); }
__host__ __device__ __forceinline__ void stage_rc(int b, int& R, int& C) { const int st = b / 1024, sb = b % 1024, swz = sb ^ (((sb >> 9) & 1) << 5); R = (st >> 1) * 16 + swz / 64; C = (st & 1) * 32 + (swz % 64) / 2; }
__host__ __device__ __forceinline__ int perm32(int rho) { const int n = rho >> 4, i = rho & 15; return 8 * (i >> 2) + 4 * n + (i & 3); }

struct Unit { int pm, pn; };
struct Gemm { const bf16_t* A; const bf16_t* Bt; int M, N, K; };

struct StaticOrder {
    int nM, nN, nwg, G, c;
    __host__ __device__ void init(int M, int N, int G_, int c_) { nM = M / BM; nN = N / BM; nwg = nM * nN; G = G_; c = c_; }
    __host__ __device__ bool next(int i, Unit& u) const {
        const long L = (long)i * G + c; if (L >= nwg) return false;
        int wgid = (int)L; { const int q = nwg / NXCD, r = nwg % NXCD, xcd = wgid % NXCD, off = wgid / NXCD; wgid = (xcd < r ? xcd * (q + 1) : r * (q + 1) + (xcd - r) * q) + off; }
        const int nig = WGM * nN, gid = wgid / nig, fm = gid * WGM, gsz = (nM - fm) < WGM ? (nM - fm) : WGM;
        u.pm = fm + ((wgid % nig) % gsz); u.pn = (wgid % nig) / gsz; return true;
    }
    __device__ __forceinline__ void a_ready(const Unit&) const {}
    __device__ __forceinline__ void done(const Unit&) const {}
};

__device__ __forceinline__ unsigned cvt_pk_bf16(float lo, float hi) { unsigned r; asm volatile("v_cvt_pk_bf16_f32 %0, %1, %2" : "=v"(r) : "v"(lo), "v"(hi)); return r; }
typedef float f32x2 __attribute__((ext_vector_type(2)));

struct EpiH {
    static constexpr bool PERM = true, AFTER_DRAIN = false;
    bf16_t* O; int ldc;
    __device__ __forceinline__ void operator()(const f32x4 (&acc)[2][2][4][2], const Unit& u, int wr, int wc, int fr, int fq) const {
        const int row0 = u.pm * BM + wr * 64 + fr, col0 = u.pn * BM + wc * 32 + 8 * fq;
#pragma unroll
        for (int ai = 0; ai < 2; ++ai)
#pragma unroll
            for (int m = 0; m < 4; ++m) { bf16_t* rowp = O + (size_t)(row0 + ai * HALF + m * 16) * ldc + col0;
#pragma unroll
                for (int bj = 0; bj < 2; ++bj) { const f32x4 v0 = acc[ai][bj][m][0], v1 = acc[ai][bj][m][1];
                    u32x4 w; w.x = cvt_pk_bf16(v0[0], v0[1]); w.y = cvt_pk_bf16(v0[2], v0[3]); w.z = cvt_pk_bf16(v1[0], v1[1]); w.w = cvt_pk_bf16(v1[2], v1[3]);
                    *(u32x4*)(rowp + bj * HALF) = w; } }
    }
};
__device__ __forceinline__ float silu_f(float x) { return x * __builtin_amdgcn_rcpf(1.0f + __builtin_amdgcn_exp2f(-1.4426950408889634f * x)); }
struct EpiSwiglu {
    static constexpr bool PERM = true, AFTER_DRAIN = false;
    bf16_t* O; int ldc;
    __device__ __forceinline__ void operator()(const f32x4 (&acc)[2][2][4][2], const Unit& u, int wr, int wc, int fr, int fq) const {
        const int row0 = u.pm * BM + wr * 64 + fr, col0 = u.pn * HALF + wc * 32 + 8 * fq;
#pragma unroll
        for (int ai = 0; ai < 2; ++ai)
#pragma unroll
            for (int m = 0; m < 4; ++m) { bf16_t* rowp = O + (size_t)(row0 + ai * HALF + m * 16) * ldc + col0;
                const f32x4 g0 = acc[ai][0][m][0], g1 = acc[ai][0][m][1], u0 = acc[ai][1][m][0], u1 = acc[ai][1][m][1];
                u32x4 w; w.x = cvt_pk_bf16(silu_f(g0[0]) * u0[0], silu_f(g0[1]) * u0[1]); w.y = cvt_pk_bf16(silu_f(g0[2]) * u0[2], silu_f(g0[3]) * u0[3]);
                w.z = cvt_pk_bf16(silu_f(g1[0]) * u1[0], silu_f(g1[1]) * u1[1]); w.w = cvt_pk_bf16(silu_f(g1[2]) * u1[2], silu_f(g1[3]) * u1[3]);
                *(u32x4*)rowp = w; }
    }
};
struct EpiResF32 {
    static constexpr bool PERM = false, AFTER_DRAIN = false;
    const float* baseP; const float* baseS; float* V; float alpha; int mp, mv;
    __device__ __forceinline__ void operator()(const f32x4 (&acc)[2][2][4][2], const Unit& u, int wr, int wc, int fr, int fq) const {
        const int row0 = u.pm * BM + wr * 64 + fr, col0 = u.pn * BM + wc * 32 + 4 * fq;
#pragma unroll
        for (int ai = 0; ai < 2; ++ai)
#pragma unroll
            for (int m = 0; m < 4; ++m) { const int row = row0 + ai * HALF + m * 16;
                if (row < mv) { const float* bp = (row < mp ? baseP + (size_t)row * 1024 : baseS + (size_t)(row - mp) * 1024) + col0; float* vp = V + (size_t)row * 1024 + col0;
#pragma unroll
                    for (int bj = 0; bj < 2; ++bj)
#pragma unroll
                        for (int n = 0; n < 2; ++n) { const f32x4 b = *(const f32x4*)(bp + bj * HALF + n * 16); *(f32x4*)(vp + bj * HALF + n * 16) = b * alpha + acc[ai][bj][m][n]; } } }
    }
};
template <class Epi, class Sched, bool ALIGN_EPI = false, bool SP2 = false>
__device__ __forceinline__ void gemm_phase(PG8_LAS unsigned char* lds, const Gemm g, const Sched& S, const Epi& E) {
    int tid_ = threadIdx.x; asm volatile("" : "+v"(tid_));
    const int tid = tid_, wid = __builtin_amdgcn_readfirstlane(tid >> 6), lane = tid & 63, wr = wid >> 2, wc = wid & 3, fr = lane & 15, fq = lane >> 4;
    const int K = g.K, nt = K / BK;
    unsigned voffA[2], voffB[2];
#pragma unroll
    for (int i = 0; i < 2; ++i) { int R, C; stage_rc(tid * 16 + i * 8192, R, C); const int Rb = Epi::PERM ? ((R & ~31) + perm32(R & 31)) : R;
        voffA[i] = (unsigned)(R * K + C) * 2u; voffB[i] = (unsigned)(Rb * K + C) * 2u; }
    const size_t kstep = (size_t)(BK * 2);
    const size_t hstep = (size_t)HALF * K * 2;
    const size_t tstep = 2 * hstep;
    const unsigned ldsw = (unsigned)wid * 1024u;
    const int aoff = lds_byte(wr * 64 + fr, fq * 8), boff = lds_byte(wc * 32 + fr, fq * 8);
#define PG8_SA(b, h) (((b) * 2 + (h)) * HTB)
#define PG8_SB(b, h) ((4 + (b) * 2 + (h)) * HTB)
#define PG8_STAGE(bufoff, gbase, voff) do { _Pragma("unroll") for (int _i = 0; _i < 2; ++_i) \
        __builtin_amdgcn_global_load_lds((const unsigned*)((const char*)(gbase) + (voff)[_i]), (PG8_LAS unsigned*)(lds + (bufoff) + ldsw + _i * 8192), 16, 0, 0); } while (0)
#define PG8_LDA(dst, b, h) do { _Pragma("unroll") for (int m = 0; m < 4; ++m) _Pragma("unroll") for (int k = 0; k < 2; ++k) dst[m][k] = *(const PG8_LAS bf16x8*)(lds + PG8_SA(b, h) + aoff + m * 2048 + k * 1024); } while (0)
#define PG8_LDB(dst, b, h) do { _Pragma("unroll") for (int n = 0; n < 2; ++n) _Pragma("unroll") for (int k = 0; k < 2; ++k) dst[n][k] = *(const PG8_LAS bf16x8*)(lds + PG8_SB(b, h) + boff + n * 2048 + k * 1024); } while (0)
#define PG8_MMA(ai, bj, At, Bt) do { __builtin_amdgcn_s_setprio(1); _Pragma("unroll") for (int m = 0; m < 4; ++m) _Pragma("unroll") for (int n = 0; n < 2; ++n) _Pragma("unroll") for (int k = 0; k < 2; ++k) \
        acc[ai][bj][m][n] = __builtin_amdgcn_mfma_f32_16x16x32_bf16(Bt[n][k], At[m][k], acc[ai][bj][m][n], 0, 0, 0); __builtin_amdgcn_s_setprio(0); } while (0)
#define PG8_WAIT_V(n) asm volatile("s_waitcnt vmcnt(" #n ")" ::: "memory")
#define PG8_WAIT_L(n) asm volatile("s_waitcnt lgkmcnt(" #n ")" ::: "memory")
#define PG8_BAR __builtin_amdgcn_s_barrier()
#define PG8_SCHED __builtin_amdgcn_sched_barrier(0)
    Unit cur, nxt; int ui = 0;
    if (!S.next(0, cur)) return;
    f32x4 acc[2][2][4][2];
#pragma unroll
    for (int a = 0; a < 2; ++a)
#pragma unroll
        for (int b = 0; b < 2; ++b)
#pragma unroll
            for (int m = 0; m < 4; ++m)
#pragma unroll
                for (int n = 0; n < 2; ++n) acc[a][b][m][n] = (f32x4){0.f, 0.f, 0.f, 0.f};
    bf16x8 At[4][2], B0[2][2], B1[2][2];
    const char* cA = (const char*)g.A + (size_t)cur.pm * tstep; const char* cB = (const char*)g.Bt + (size_t)cur.pn * tstep;
    S.a_ready(cur);
    if constexpr (SP2) {
        PG8_STAGE(PG8_SB(0, 0), cB, voffB); PG8_STAGE(PG8_SB(0, 1), cB + hstep, voffB); PG8_STAGE(PG8_SA(0, 0), cA, voffA); PG8_STAGE(PG8_SA(0, 1), cA + hstep, voffA);
        if (wr == 1) PG8_BAR;
        PG8_WAIT_V(2); PG8_BAR;
        PG8_STAGE(PG8_SB(1, 0), cB + kstep, voffB); PG8_STAGE(PG8_SA(1, 0), cA + kstep, voffA); PG8_STAGE(PG8_SB(1, 1), cB + hstep + kstep, voffB);
        PG8_WAIT_V(6); PG8_BAR;
    } else {
        PG8_STAGE(PG8_SB(0, 0), cB, voffB); PG8_STAGE(PG8_SA(0, 0), cA, voffA); PG8_STAGE(PG8_SB(0, 1), cB + hstep, voffB); PG8_STAGE(PG8_SA(0, 1), cA + hstep, voffA);
        if (wr == 1) PG8_BAR;
        PG8_WAIT_V(4); PG8_BAR;
        PG8_STAGE(PG8_SB(1, 0), cB + kstep, voffB); PG8_STAGE(PG8_SA(1, 0), cA + kstep, voffA); PG8_STAGE(PG8_SB(1, 1), cB + hstep + kstep, voffB);
        PG8_WAIT_V(6); PG8_BAR;
    }
    for (;;) {
        const bool has_next = S.next(ui + 1, nxt);
        const char* nA = has_next ? (const char*)g.A + (size_t)nxt.pm * tstep : cA; const char* nB = has_next ? (const char*)g.Bt + (size_t)nxt.pn * tstep : cB;
        for (int t = 0; t < nt; t += 2) {
            const bool last = (t == nt - 2);
            const char* a1 = cA + (size_t)(t + 1) * kstep;
            const char* a2 = last ? nA : cA + (size_t)(t + 2) * kstep; const char* b2 = last ? nB : cB + (size_t)(t + 2) * kstep;
            const char* a3 = a2 + kstep; const char* b3 = b2 + kstep;
            if (last && has_next) S.a_ready(nxt);
            if constexpr (SP2) {
            PG8_LDB(B0, 0, 0); PG8_LDB(B1, 0, 1); PG8_SCHED; PG8_LDA(At, 0, 0); PG8_STAGE(PG8_SA(1, 1), a1 + hstep, voffA);
            PG8_WAIT_V(8); PG8_WAIT_L(0); PG8_BAR; PG8_MMA(0, 0, At, B0); PG8_MMA(0, 1, At, B1); PG8_BAR; PG8_SCHED;
            PG8_LDA(At, 0, 1); PG8_STAGE(PG8_SB(0, 0), b2, voffB); PG8_STAGE(PG8_SB(0, 1), b2 + hstep, voffB); PG8_STAGE(PG8_SA(0, 0), a2, voffA);
            PG8_WAIT_V(8); PG8_WAIT_L(0); PG8_BAR; PG8_MMA(1, 0, At, B0); PG8_MMA(1, 1, At, B1); PG8_BAR; PG8_SCHED;
            PG8_LDB(B0, 1, 0); PG8_LDB(B1, 1, 1); PG8_SCHED; PG8_LDA(At, 1, 0); PG8_STAGE(PG8_SA(0, 1), a2 + hstep, voffA);
            PG8_WAIT_V(8); PG8_WAIT_L(0); PG8_BAR; PG8_MMA(0, 0, At, B0); PG8_MMA(0, 1, At, B1); PG8_BAR; PG8_SCHED;
            PG8_LDA(At, 1, 1); PG8_STAGE(PG8_SB(1, 0), b3, voffB); PG8_STAGE(PG8_SB(1, 1), b3 + hstep, voffB); PG8_STAGE(PG8_SA(1, 0), a3, voffA);
            PG8_WAIT_V(8); PG8_WAIT_L(0); PG8_BAR; PG8_MMA(1, 0, At, B0); PG8_MMA(1, 1, At, B1); PG8_BAR; PG8_SCHED;
            } else {
            PG8_LDB(B0, 0, 0); PG8_SCHED; PG8_LDA(At, 0, 0); PG8_STAGE(PG8_SA(1, 1), a1 + hstep, voffA);
            PG8_WAIT_L(8); PG8_BAR; PG8_WAIT_L(0); PG8_MMA(0, 0, At, B0); PG8_BAR; PG8_SCHED;
            PG8_LDB(B1, 0, 1); PG8_STAGE(PG8_SB(0, 0), b2, voffB);
            PG8_BAR; PG8_WAIT_L(0); PG8_MMA(0, 1, At, B1); PG8_BAR;
            PG8_LDA(At, 0, 1); PG8_STAGE(PG8_SA(0, 0), a2, voffA);
            PG8_BAR; PG8_WAIT_L(0); PG8_MMA(1, 0, At, B0); PG8_BAR; PG8_SCHED;
            PG8_STAGE(PG8_SB(0, 1), b2 + hstep, voffB);
            PG8_WAIT_V(6); PG8_BAR; PG8_MMA(1, 1, At, B1); PG8_BAR;
            PG8_LDB(B0, 1, 0); PG8_SCHED; PG8_LDA(At, 1, 0); PG8_STAGE(PG8_SA(0, 1), a2 + hstep, voffA);
            PG8_WAIT_L(8); PG8_BAR; PG8_WAIT_L(0); PG8_MMA(0, 0, At, B0); PG8_BAR; PG8_SCHED;
            PG8_LDB(B1, 1, 1); PG8_STAGE(PG8_SB(1, 0), b3, voffB);
            PG8_BAR; PG8_WAIT_L(0); PG8_MMA(0, 1, At, B1); PG8_BAR;
            PG8_LDA(At, 1, 1); PG8_STAGE(PG8_SA(1, 0), a3, voffA);
            PG8_BAR; PG8_WAIT_L(0); PG8_MMA(1, 0, At, B0); PG8_BAR; PG8_SCHED;
            PG8_STAGE(PG8_SB(1, 1), b3 + hstep, voffB);
            PG8_WAIT_V(6); PG8_BAR; PG8_MMA(1, 1, At, B1); PG8_BAR;
            }
        }
        if constexpr (ALIGN_EPI) { if (wr == 0) PG8_BAR; }
        if constexpr (!Epi::AFTER_DRAIN) { E(acc, cur, wr, wc, fr, fq); S.done(cur); }
        if (!has_next) break;
#pragma unroll
        for (int a = 0; a < 2; ++a)
#pragma unroll
            for (int b = 0; b < 2; ++b)
#pragma unroll
                for (int m = 0; m < 4; ++m)
#pragma unroll
                    for (int n = 0; n < 2; ++n) acc[a][b][m][n] = (f32x4){0.f, 0.f, 0.f, 0.f};
        cur = nxt; cA = nA; cB = nB; ++ui;
        if constexpr (ALIGN_EPI) { if (wr == 1) PG8_BAR; }
    }
    PG8_WAIT_V(0);
    if constexpr (!ALIGN_EPI) { if (wr == 0) PG8_BAR; }
    PG8_BAR;
    if constexpr (Epi::AFTER_DRAIN) { E.fused(acc, cur, wr, wc, fr, fq, lds, wid, lane); S.done(cur); }
#undef PG8_SA
#undef PG8_SB
#undef PG8_STAGE
#undef PG8_LDA
#undef PG8_LDB
#undef PG8_MMA
#undef PG8_WAIT_V
#undef PG8_WAIT_L
#undef PG8_BAR
#undef PG8_SCHED
}
}
#define GAS __attribute__((address_space(1)))
#define LAS __attribute__((address_space(3)))
typedef unsigned short bf16;
typedef unsigned v4u __attribute__((ext_vector_type(4)));
typedef float f32x4 __attribute__((ext_vector_type(4)));
typedef short bf16x8 __attribute__((ext_vector_type(8)));
typedef GAS unsigned gu32;
typedef GAS unsigned long long gu64;
#define RLX_AGENT __ATOMIC_RELAXED, __HIP_MEMORY_SCOPE_AGENT
#define LDS_WAIT() asm volatile("s_waitcnt lgkmcnt(0)" ::: "memory")
#define VM_WAIT() asm volatile("s_waitcnt vmcnt(0)" ::: "memory")
__device__ __forceinline__ unsigned long long rt() { return __builtin_amdgcn_s_memrealtime(); }

typedef float f32x2_t __attribute__((ext_vector_type(2))); typedef __bf16 bf16x2_t __attribute__((ext_vector_type(2)));
__device__ __forceinline__ unsigned pk2(float lo, float hi) { f32x2_t v = {lo, hi}; bf16x2_t b = __builtin_convertvector(v, bf16x2_t); return __builtin_bit_cast(unsigned, b); }
__device__ __forceinline__ unsigned f2bf(float f) { return pk2(f, f) & 0xffffu; }
#define XB_TMO      128
#define XB_XCNT(j)  (256  + 64 * (j))
#define XB_XSUB(j)  (1280 + 64 * (j))
#define XB_XGEN(j)  (2304 + 64 * (j))
#define XB_TOP      3328
#define XB_TOPGEN   3392
#define XCD_BAR_WORDS 3456
#define XB_SPIN_CAP (1u << 18)

__device__ __forceinline__ unsigned xb_ld(unsigned* p)              { return __hip_atomic_load(p, __ATOMIC_RELAXED, __HIP_MEMORY_SCOPE_AGENT); }
__device__ __forceinline__ unsigned xb_add(unsigned* p, unsigned v) { return __hip_atomic_fetch_add(p, v, __ATOMIC_RELAXED, __HIP_MEMORY_SCOPE_AGENT); }
__device__ __forceinline__ unsigned xb_xcc_id() { return (unsigned)__builtin_amdgcn_s_getreg((3 << 11) | 20) & 0xFu; }
#define XB_SPIN(cond, bar) do { unsigned _sp = 0; while (cond) { __builtin_amdgcn_s_sleep(1); \
    if ((++_sp & 255u) == 0u) { if (xb_ld(&(bar)[XB_TMO])) break; if (_sp > XB_SPIN_CAP) { atomicAdd(&(bar)[XB_TMO], 1u); break; } } } } while (0)

struct XcdBarrier {
    unsigned* bar; unsigned x;
    volatile LAS unsigned* st;
};

__device__ __forceinline__ XcdBarrier xcd_barrier_post(unsigned* bar, volatile LAS unsigned* st) {
    XcdBarrier b; b.bar = bar; b.x = xb_xcc_id(); b.st = st;
    if (threadIdx.x == 0) (void)xb_add(&bar[XB_XCNT(b.x)], 1u);
    return b;
}
__device__ __forceinline__ void xcd_barrier_complete(unsigned* bar, unsigned x, unsigned& nloc, unsigned& nx) {
    const unsigned G = gridDim.x * gridDim.y * gridDim.z;
    unsigned sum, cnt, mine, sp = 0u;
    for (;;) {
        sum = 0u; cnt = 0u; mine = 0u;
#pragma unroll
        for (unsigned j = 0; j < 16; ++j) { const unsigned c = xb_ld(&bar[XB_XCNT(j)]); sum += c; cnt += (c > 0u) ? 1u : 0u; mine = (j == x) ? c : mine; }
        if (sum == G) break;
        __builtin_amdgcn_s_sleep(1);
        if ((++sp & 255u) == 0u) { if (xb_ld(&bar[XB_TMO])) break; if (sp > XB_SPIN_CAP) { atomicAdd(&bar[XB_TMO], 1u); break; } }
    }
    nloc = mine > 0u ? mine : 1u; nx = cnt > 0u ? cnt : 1u;
}

__device__ __forceinline__ void xcd_barrier(const XcdBarrier& b) {
    asm volatile("s_waitcnt vmcnt(0)" ::: "memory");
    __syncthreads();
    if (threadIdx.x == 0) {
        unsigned* bar = b.bar;
        __builtin_amdgcn_s_waitcnt(0);
        unsigned nloc = b.st[0], nx = b.st[1];
        if (nloc == 0u) { xcd_barrier_complete(bar, b.x, nloc, nx); b.st[0] = nloc; b.st[1] = nx; }
        const unsigned old = xb_add(&bar[XB_XSUB(b.x)], 1u);
        const unsigned gen = old / nloc;
        if (old + 1u == (gen + 1u) * nloc) {
            __builtin_amdgcn_fence(__ATOMIC_RELEASE, "agent");
            asm volatile("s_waitcnt vmcnt(0)" ::: "memory");
            const unsigned og = xb_add(&bar[XB_TOP], 1u);
            const unsigned tg = og / nx;
            if (og + 1u == (tg + 1u) * nx) xb_add(&bar[XB_TOPGEN], 1u);
            else XB_SPIN(xb_ld(&bar[XB_TOPGEN]) == tg, bar);
            __builtin_amdgcn_fence(__ATOMIC_ACQUIRE, "agent");
            xb_add(&bar[XB_XGEN(b.x)], 1u);
            asm volatile("s_waitcnt vmcnt(0)" ::: "memory");
        } else {
            XB_SPIN(xb_ld(&bar[XB_XGEN(b.x)]) == gen, bar);
            __builtin_amdgcn_fence(__ATOMIC_ACQUIRE, "agent");
            asm volatile("s_waitcnt vmcnt(0)" ::: "memory");
        }
    }
    __syncthreads();
}

constexpr int DM = 1024, SEQ = 4096, NBP = 4, MP = NBP * SEQ, NBS = 32, TS = 4, MS = NBS * TS, MV = MP + MS, MT = 65 * 256;
constexpr int IN_COLS = 3584, A_COLS = 1408, WA = 384, DFF = 2816, NGU = 2 * DFF, WBUF = 2048;
constexpr int COL_QB = 1408, COL_KB = 1792, COL_VB = 2176, COL_QC = 2560, COL_KC = 2816, COL_VC = 3072, COL_GC = 3328;
constexpr float DN_ALPHA = 1.4142135623730951f;
constexpr float LN_EPS = 1e-5f, GN_EPS_A = 64e-5f, DECAY_SCALE = 0.6065306597126334f;
constexpr int NPOS = SEQ + TS;
constexpr size_t O_YP = 0, O_YS = O_YP + (size_t)MP * DM, O_PSHIFT = O_YS + (size_t)MS * DM, O_PWKV = O_PSHIFT + 2 * NBP * A_COLS, O_PWINK = O_PWKV + 2 * NBP * 6 * 4096,
                 O_PWINV = O_PWINK + (size_t)2 * NBP * WBUF * 384, O_PRET = O_PWINV + (size_t)2 * NBP * WBUF * 384, O_SSHIFT = O_PRET + 2 * NBP * 4 * 4096,
                 O_SWKV = O_SSHIFT + 2 * NBS * A_COLS, O_SWINK = O_SWKV + 2 * NBS * 6 * 4096, O_SWINV = O_SWINK + (size_t)2 * NBS * WBUF * 384,
                 O_SRET = O_SWINV + (size_t)2 * NBS * WBUF * 384, O_END = O_SRET + 2 * NBS * 4 * 4096;
static_assert(O_END == 133204992, "output size");
constexpr size_t MiB = 1u << 20;
constexpr size_t WS_CTL = 0, CTL_ZERO_BYTES = 1 * MiB, WS_TAB = 1 * MiB, WS_W = 4 * MiB, LW = 26 * MiB;
constexpr size_t W_IN = 0, W_OUT = W_IN + (size_t)IN_COLS * DM * 2, W_GU = W_OUT + (size_t)DM * DM * 2, W_D = W_GU + (size_t)NGU * DM * 2, W_WL = W_D + (size_t)DM * DFF * 2,
                 W_AL = W_WL + (size_t)WA * 64 * 2, W_GL = W_AL + (size_t)WA * 64 * 2, W_LEND = W_GL + (size_t)WA * 128 * 2;
static_assert(W_LEND <= LW, "weights");
constexpr size_t WS_XB = 56 * MiB, WS_XF = 89 * MiB, WS_X1F = 154 * MiB, WS_X1B = 219 * MiB, WS_MIX = 252 * MiB, WS_G = 285 * MiB, WS_T0 = 310 * MiB;
constexpr size_t WS_H = WS_T0, WS_CK = 424 * MiB, WS_VX = 496 * MiB, WS_SC = 521 * MiB, WS_KV = 523 * MiB, WS_OC2 = 532 * MiB, WS_OA = 571 * MiB, WS_OB = 596 * MiB, WS_LSE = 670 * MiB, WS_OC = 672 * MiB, WS_RK = 689 * MiB, WS_END = 690 * MiB;
constexpr size_t WS_V = WS_T0, WS_HFF = 375 * MiB;
static_assert(WS_H + (size_t)MT * IN_COLS * 2 <= WS_CK && WS_CK + (size_t)1536 * 49152 <= WS_VX && WS_VX + (size_t)MT * 384 * 4 <= WS_SC && WS_SC + (size_t)MS * 2304 * 4 <= WS_OA && WS_OB + (size_t)3 * MT * 384 * 4 <= WS_LSE && WS_OC + (size_t)MT * 256 * 4 <= WS_RK, "ws map");
static_assert(WS_V + (size_t)MT * DM * 4 <= WS_HFF && WS_HFF + (size_t)MT * DFF * 2 <= WS_END && WS_XF + (size_t)MT * DM * 4 <= WS_X1F && WS_G + (size_t)MT * 384 * 4 <= WS_T0, "ws map 2");
constexpr int TAB_COSB = 0, TAB_SINB = NPOS * 8, TAB_COSC = NPOS * 16, TAB_SINC = NPOS * 48, TAB_END = NPOS * 80;
constexpr int CW_BAR = 4096, CW_Q = 8192;
constexpr int RING_BYTES = 147456, LDSCTL_OFF = RING_BYTES, MISC_OFF = LDSCTL_OFF + 320, INTAB_OFF = LDSCTL_OFF + 1024, LDS_BYTES = RING_BYTES + 2048;
constexpr int NWAVES = 8, NTHR = 512;
constexpr int NST = 9, NPHASE = 1 + 2 * NST;

struct Frame {
    LAS unsigned char* lds; volatile LAS unsigned* MISC; gu32* ctl;
    int tid, lane, wave, G, bid, rep;
    float* out; unsigned char* ws;
};
__device__ __forceinline__ const float* inp(const Frame& F, int k) {
    const LAS unsigned* t = (const LAS unsigned*)(F.lds + INTAB_OFF) + 2 * k;
    const unsigned lo = __builtin_amdgcn_readfirstlane(t[0]), hi = __builtin_amdgcn_readfirstlane(t[1]);
    return (const float*)(((unsigned long long)hi << 32) | lo);
}
__device__ __forceinline__ float bf2f(bf16 v) { return __uint_as_float((unsigned)v << 16); }
__device__ __forceinline__ float wave_sum(float v) {
#pragma unroll
    for (int o = 1; o < 64; o <<= 1) v += __shfl_xor(v, o);
    return v;
}
__device__ __forceinline__ float wave_max(float v) {
#pragma unroll
    for (int o = 1; o < 64; o <<= 1) v = fmaxf(v, __shfl_xor(v, o));
    return v;
}
__device__ __forceinline__ float dpp_f(float x, const int ctrl_sel) {
    const int xi = __float_as_int(x); int r;
    if (ctrl_sel == 0) r = __builtin_amdgcn_update_dpp(xi, xi, 0xB1, 0xF, 0xF, false);
    else if (ctrl_sel == 1) r = __builtin_amdgcn_update_dpp(xi, xi, 0x4E, 0xF, 0xF, false);
    else if (ctrl_sel == 2) r = __builtin_amdgcn_update_dpp(xi, xi, 0x141, 0xF, 0xF, false);
    else r = __builtin_amdgcn_update_dpp(xi, xi, 0x140, 0xF, 0xF, false);
    return __int_as_float(r);
}
__device__ __forceinline__ float red16(float x) { x += dpp_f(x, 0); x += dpp_f(x, 1); x += dpp_f(x, 2); x += dpp_f(x, 3); return x; }
__device__ __forceinline__ float sigmoid_f(float x) { return 1.0f / (1.0f + __expf(-x)); }

__host__ __device__ __forceinline__ int phys_col(int c) {
    if (c >= COL_QB && c < COL_VB) { int d = c & 63; if (d < 16) d = d < 8 ? 2 * d : 2 * (d - 8) + 1; return (c & ~63) + d; }
    if (c >= COL_QC && c < COL_VC) { int d = c & 63; d = d < 32 ? 2 * d : 2 * (d - 32) + 1; return (c & ~63) + d; }
    return c;
}
__host__ __device__ __forceinline__ int dimB(int p) { return p < 16 ? (p >> 1) + 8 * (p & 1) : p; }
__host__ __device__ __forceinline__ int dimC(int p) { return (p >> 1) + 32 * (p & 1); }
template <bool PERMUTE>
__device__ __forceinline__ void p0_transpose_item(const float* W, int K, int N, bf16* WT, int k0, int n0, int drow0, LAS float* scr, int lane) {
#pragma unroll 8
    for (int i = 0; i < 32; ++i) { const int kk = 2 * i + (lane >> 5); scr[kk * 33 + (lane & 31)] = W[(size_t)(k0 + kk) * N + n0 + (lane & 31)]; }
    LDS_WAIT(); asm volatile("" ::: "memory");
    const int c = lane & 7;
#pragma unroll
    for (int j = 0; j < 4; ++j) { const int n = (lane >> 3) + 8 * j; const LAS float* s = scr + (8 * c) * 33 + n;
        v4u o; o.x = pk2(s[0 * 33], s[1 * 33]); o.y = pk2(s[2 * 33], s[3 * 33]); o.z = pk2(s[4 * 33], s[5 * 33]); o.w = pk2(s[6 * 33], s[7 * 33]);
        *(GAS v4u*)(WT + (size_t)(PERMUTE ? phys_col(n0 + n) : drow0 + n) * K + k0 + 8 * c) = o; }
    LDS_WAIT(); asm volatile("" ::: "memory");
}
__device__ __forceinline__ void p0_prologue(Frame& F) {
    LAS float* scr = (LAS float*)(F.lds + F.wave * 16384);
    const int gw = F.bid * NWAVES + F.wave, NGW = F.G * NWAVES;
    constexpr int I_IN = 16 * (IN_COLS / 32), I_OUT = 16 * (DM / 32), I_G = 16 * (DFF / 32), I_D = (DFF / 64) * (DM / 32), I_L = I_IN + I_OUT + 2 * I_G + I_D;
    for (int it = gw; it < 2 * I_L; it += NGW) {
        const int l = it / I_L; int r = it % I_L; bf16* wb = (bf16*)(F.ws + WS_W + (size_t)l * LW);
        if (r < I_IN) { const int nblk = IN_COLS / 32, kb = r / nblk, nb = r % nblk; p0_transpose_item<true>(inp(F, 7) + (size_t)l * DM * IN_COLS, DM, IN_COLS, (bf16*)((char*)wb + W_IN), 64 * kb, 32 * nb, 32 * nb, scr, F.lane); continue; } r -= I_IN;
        if (r < I_OUT) { const int nblk = DM / 32, kb = r / nblk, nb = r % nblk; p0_transpose_item<false>(inp(F, 21) + (size_t)l * DM * DM, DM, DM, (bf16*)((char*)wb + W_OUT), 64 * kb, 32 * nb, 32 * nb, scr, F.lane); continue; } r -= I_OUT;
        if (r < 2 * I_G) { const int up = r >= I_G; if (up) r -= I_G; const int nblk = DFF / 32, kb = r / nblk, nb = r % nblk, n0 = 32 * nb;
            p0_transpose_item<false>((up ? inp(F, 25) : inp(F, 24)) + (size_t)l * DM * DFF, DM, DFF, (bf16*)((char*)wb + W_GU), 64 * kb, n0, (n0 >> 7) * 256 + (n0 & 127) + (up ? 128 : 0), scr, F.lane); continue; } r -= 2 * I_G;
        { const int nblk = DM / 32, kb = r / nblk, nb = r % nblk; p0_transpose_item<false>(inp(F, 26) + (size_t)l * DFF * DM, DFF, DM, (bf16*)((char*)wb + W_D), 64 * kb, 32 * nb, 32 * nb, scr, F.lane); }
    }
    bf16* XB = (bf16*)(F.ws + WS_XB); bf16* MIX = (bf16*)(F.ws + WS_MIX); bf16* X1B = (bf16*)(F.ws + WS_X1B); bf16* HFF = (bf16*)(F.ws + WS_HFF);
    for (int m = gw; m < MT; m += NGW) {
        GAS unsigned long long* o8 = (GAS unsigned long long*)(XB + (size_t)m * DM) + F.lane;
        if (m < MV) { const float* src = m < MP ? inp(F, 0) + (size_t)m * DM : inp(F, 1) + (size_t)(m - MP) * DM; const GAS f32x4* xr = (const GAS f32x4*)src + F.lane;
#pragma unroll
            for (int j = 0; j < 4; ++j) { const f32x4 v = xr[64 * j]; o8[64 * j] = (unsigned long long)pk2(v.x, v.y) | ((unsigned long long)pk2(v.z, v.w) << 32); }
        } else {
#pragma unroll
            for (int j = 0; j < 4; ++j) { o8[64 * j] = 0ull; ((GAS unsigned long long*)(MIX + (size_t)m * DM) + F.lane)[64 * j] = 0ull; ((GAS unsigned long long*)(X1B + (size_t)m * DM) + F.lane)[64 * j] = 0ull; }
            for (int j = F.lane; j < DFF / 4; j += 64) ((GAS unsigned long long*)(HFF + (size_t)m * DFF))[j] = 0ull;
        }
    }
    for (int e = F.bid * NTHR + F.tid; e < 2 * WA * 256; e += F.G * NTHR) {
        const int l = e / (WA * 256), r = e % (WA * 256), n = r >> 8, k = r & 255; unsigned char* wb = F.ws + WS_W + (size_t)l * LW;
        if (k < 64) ((bf16*)(wb + W_WL))[n * 64 + k] = (bf16)f2bf(inp(F, 10)[((size_t)l * 64 + k) * WA + n]);
        else if (k < 128) ((bf16*)(wb + W_AL))[n * 64 + (k - 64)] = (bf16)f2bf(inp(F, 12)[((size_t)l * 64 + (k - 64)) * WA + n]);
        else ((bf16*)(wb + W_GL))[n * 128 + (k - 128)] = (bf16)f2bf(inp(F, 13)[((size_t)l * 128 + (k - 128)) * WA + n]);
    }
    float* tab = (float*)(F.ws + WS_TAB);
    for (int e = F.bid * NTHR + F.tid; e < NPOS * 40; e += F.G * NTHR) {
        const int idx = e / 40, j = e % 40; const float pos = (float)(idx < SEQ ? idx : 8192 + (idx - SEQ));
        if (j < 8) { const float inv = powf(500000.0f, -(float)(2 * j) / 16.0f); const float ang = pos * inv; tab[TAB_COSB + idx * 8 + j] = cosf(ang); tab[TAB_SINB + idx * 8 + j] = sinf(ang); }
        else { const int jj = j - 8; const float inv = 1.0f / powf(10000.0f, (float)jj / 31.0f); const float ang = pos * inv; tab[TAB_COSC + idx * 32 + jj] = cosf(ang); tab[TAB_SINC + idx * 32 + jj] = sinf(ang); }
    }
}


namespace pg8 {
struct EpiHRot {
    static constexpr bool PERM = true, AFTER_DRAIN = false;
    bf16_t* O; int ldc; const float* tab;
    __device__ __forceinline__ void operator()(const f32x4 (&acc)[2][2][4][2], const Unit& u, int wr, int wc, int fr, int fq) const {
        const int row0 = u.pm * BM + wr * 64 + fr;
#pragma unroll
        for (int bj = 0; bj < 2; ++bj) {
            const int cb = u.pn * BM + bj * HALF + wc * 32;
            const int mode = (cb >= COL_QB && cb < COL_VB && (cb & 63) == 0) ? 1 : ((cb >= COL_QC && cb < COL_VC) ? 2 : 0);
            const float scale = (cb >= COL_KC && cb < COL_VC) ? 0.125f : 1.0f;
            const bool rot = mode == 2 || (mode == 1 && fq < 2);
            const int toff = mode == 1 ? 4 * fq : 16 * ((cb >> 5) & 1) + 4 * fq;
#pragma unroll
            for (int ai = 0; ai < 2; ++ai)
#pragma unroll
                for (int m = 0; m < 4; ++m) {
                    const int row = row0 + ai * HALF + m * 16;
                    f32x4 v0 = acc[ai][bj][m][0], v1 = acc[ai][bj][m][1];
                    if (mode != 0) {
                        if (rot) {
                            const int posidx = row < MP ? (row & (SEQ - 1)) : (row < MV ? SEQ + ((row - MP) & 3) : 0);
                            const f32x4 cs = *(const f32x4*)(tab + (mode == 1 ? TAB_COSB + posidx * 8 : TAB_COSC + posidx * 32) + toff);
                            const f32x4 sn = *(const f32x4*)(tab + (mode == 1 ? TAB_SINB + posidx * 8 : TAB_SINC + posidx * 32) + toff);
                            const f32x4 a = v0, b = v1;
                            v0[0] = a[0] * cs[0] - a[1] * sn[0]; v0[1] = a[1] * cs[0] + a[0] * sn[0]; v0[2] = a[2] * cs[1] - a[3] * sn[1]; v0[3] = a[3] * cs[1] + a[2] * sn[1];
                            v1[0] = b[0] * cs[2] - b[1] * sn[2]; v1[1] = b[1] * cs[2] + b[0] * sn[2]; v1[2] = b[2] * cs[3] - b[3] * sn[3]; v1[3] = b[3] * cs[3] + b[2] * sn[3];
                        }
                        v0 = v0 * scale; v1 = v1 * scale;
                    }
                    u32x4 w; w.x = cvt_pk_bf16(v0[0], v0[1]); w.y = cvt_pk_bf16(v0[2], v0[3]); w.z = cvt_pk_bf16(v1[0], v1[1]); w.w = cvt_pk_bf16(v1[2], v1[3]);
                    *(u32x4*)(O + (size_t)row * ldc + cb + 8 * fq) = w;
                }
        }
    }
};
}

__device__ __forceinline__ f32x4 mfma16(bf16x8 a, bf16x8 b, f32x4 c) { return __builtin_amdgcn_mfma_f32_16x16x32_bf16(a, b, c, 0, 0, 0); }

__device__ __forceinline__ void scan_item(Frame& F, const float* SC, float* OA, int scrow0, int rowbase, int T, int h, int half, const float* S0, float* Sout) {
    constexpr int CH = 32;
    LAS float* buf = (LAS float*)F.lds;
    LAS float* vbuf = buf + 2 * CH * 320;
    int tid = F.tid; asm volatile("" : "+v"(tid));
    const int lane = tid & 63, w = F.wave, rg = lane >> 4, j = lane & 15;
    const int vrow = half * 32 + w * 4 + rg;
    float S[4];
    if (S0) { const f32x4 s = *(const f32x4*)(S0 + vrow * 64 + 4 * j); S[0] = s[0]; S[1] = s[1]; S[2] = s[2]; S[3] = s[3]; } else { S[0] = S[1] = S[2] = S[3] = 0.f; }
    const int nch = (T + CH - 1) / CH;
    f32x4 st[5]; float sv[2];
    int sstep[5], soff[5], ldso[5];
#pragma unroll
    for (int i = 0; i < 5; ++i) { const int idx = tid + NTHR * i, step = idx / 80, rem = idx % 80, v5 = rem >> 4, q = rem & 15; const int vid = v5 < 3 ? v5 : v5 + 1;
        sstep[i] = step; soff[i] = vid * 64 + q * 4; ldso[i] = step * 320 + v5 * 64 + q * 4; }
    const int vstep0 = tid >> 5, vr = tid & 31;
#define SCAN_ISSUE(c) do { _Pragma("unroll") for (int i = 0; i < 5; ++i) { const int t = (c) * CH + sstep[i]; st[i] = t < T ? *(const f32x4*)(SC + ((size_t)(scrow0 + t) * 6 + h) * 384 + soff[i]) : (f32x4){0.f, 0.f, 0.f, 0.f}; } \
        _Pragma("unroll") for (int i = 0; i < 2; ++i) { const int t = (c) * CH + vstep0 + 16 * i; sv[i] = t < T ? SC[((size_t)(scrow0 + t) * 6 + h) * 384 + 192 + half * 32 + vr] : 0.f; } } while (0)
#define SCAN_WRITE(bs) do { _Pragma("unroll") for (int i = 0; i < 5; ++i) *(LAS f32x4*)(buf + (bs) * CH * 320 + ldso[i]) = st[i]; \
        _Pragma("unroll") for (int i = 0; i < 2; ++i) vbuf[(bs) * CH * 32 + (vstep0 + 16 * i) * 32 + vr] = sv[i]; } while (0)
    SCAN_ISSUE(0); SCAN_WRITE(0);
    __syncthreads();
    for (int c = 0; c < nch; ++c) {
        const int bs = c & 1;
        if (c + 1 < nch) SCAN_ISSUE(c + 1);
        const int ns = (T - c * CH) < CH ? (T - c * CH) : CH;
        const LAS float* bp = buf + bs * CH * 320 + 4 * j; const LAS float* vp = vbuf + bs * CH * 32 + w * 4 + rg;
        for (int s = 0; s < ns; ++s) {
            const f32x4 r4 = *(const LAS f32x4*)(bp + s * 320), w4 = *(const LAS f32x4*)(bp + s * 320 + 64), k4 = *(const LAS f32x4*)(bp + s * 320 + 128),
                        kk4 = *(const LAS f32x4*)(bp + s * 320 + 192), b4 = *(const LAS f32x4*)(bp + s * 320 + 256);
            const float vv = vp[s * 32];
            float sa = (S[0] * kk4[0] + S[1] * kk4[1]) + (S[2] * kk4[2] + S[3] * kk4[3]);
            sa = red16(sa);
#pragma unroll
            for (int e = 0; e < 4; ++e) S[e] = S[e] * w4[e] + (vv * k4[e] - sa * b4[e]);
            float o = (S[0] * r4[0] + S[1] * r4[1]) + (S[2] * r4[2] + S[3] * r4[3]);
            o = red16(o);
            if (j == 0) OA[(size_t)(rowbase + c * CH + s) * WA + h * 64 + vrow] = o;
        }
        if (c + 1 < nch) SCAN_WRITE(bs ^ 1);
        __syncthreads();
    }
#undef SCAN_ISSUE
#undef SCAN_WRITE
    *(f32x4*)(Sout + vrow * 64 + 4 * j) = (f32x4){S[0], S[1], S[2], S[3]};
}

__device__ __forceinline__ void attn_unit(Frame& F, const bf16* H, float* OB, float* LSE, int unit) {
    const int cls = unit & 31, di = (unit >> 5) % 3, bh = unit / 96, h = bh % 6, b = bh / 6;
    const int d = di == 0 ? 1 : (di == 1 ? 4 : 16), nbk = 32 / d, r = cls / nbk, n = cls % nbk;
    LAS bf16* Kl = (LAS bf16*)F.lds;
    LAS bf16* VT = Kl + 256 * 72;
    int tid = F.tid; asm volatile("" : "+v"(tid));
    const int lane = tid & 63, w = F.wave, g = lane >> 4, lq = lane & 15;
#pragma unroll
    for (int i = 0; i < 4; ++i) {
        const int cid = tid + NTHR * i, ki = cid >> 3, ch = cid & 7, ci = (n - 1) * 128 + ki;
        v4u kv = (v4u){0u, 0u, 0u, 0u}, vv = kv;
        if (ci >= 0) { const size_t row = (size_t)b * SEQ + (size_t)ci * d + r; kv = *(const v4u*)(H + row * IN_COLS + COL_KB + h * 64 + ch * 8); vv = *(const v4u*)(H + row * IN_COLS + COL_VB + h * 64 + ch * 8); }
        *(LAS v4u*)(Kl + ki * 72 + ch * 8) = kv;
        LAS bf16* vt = VT + (ch * 8) * 264 + ki;
        vt[0 * 264] = (bf16)(vv.x & 0xffffu); vt[1 * 264] = (bf16)(vv.x >> 16); vt[2 * 264] = (bf16)(vv.y & 0xffffu); vt[3 * 264] = (bf16)(vv.y >> 16);
        vt[4 * 264] = (bf16)(vv.z & 0xffffu); vt[5 * 264] = (bf16)(vv.z >> 16); vt[6 * 264] = (bf16)(vv.w & 0xffffu); vt[7 * 264] = (bf16)(vv.w >> 16);
    }
    __syncthreads();
    const int qi = 16 * w + lq;
    const size_t qrow = (size_t)b * SEQ + (size_t)(n * 128 + qi) * d + r;
    bf16x8 qf[2];
    qf[0] = *(const bf16x8*)(H + qrow * IN_COLS + COL_QB + h * 64 + 8 * g); qf[1] = *(const bf16x8*)(H + qrow * IN_COLS + COL_QB + h * 64 + 32 + 8 * g);
    f32x4 s[10];
#pragma unroll
    for (int tt = 0; tt < 9; ++tt) {
        const int kt = w + tt; s[tt] = (f32x4){0.f, 0.f, 0.f, 0.f};
#pragma unroll
        for (int ks = 0; ks < 2; ++ks) { const bf16x8 a = *(const LAS bf16x8*)(Kl + (kt * 16 + lq) * 72 + 32 * ks + 8 * g); s[tt] = mfma16(a, qf[ks], s[tt]); }
    }
    s[9] = (f32x4){0.f, 0.f, 0.f, 0.f};
    float m = -1e30f;
#pragma unroll
    for (int tt = 0; tt < 9; ++tt)
#pragma unroll
        for (int e = 0; e < 4; ++e) { const int ki = (w + tt) * 16 + 4 * g + e; const bool ok = ki >= qi && ki <= qi + 128 && (n > 0 || ki >= 128);
            const float sv = ok ? s[tt][e] * 0.125f : -1e30f; s[tt][e] = sv; m = fmaxf(m, sv); }
    m = fmaxf(m, __shfl_xor(m, 16)); m = fmaxf(m, __shfl_xor(m, 32));
    float lsum = 0.f;
#pragma unroll
    for (int tt = 0; tt < 9; ++tt)
#pragma unroll
        for (int e = 0; e < 4; ++e) { const float p = s[tt][e] > -1e29f ? __expf(s[tt][e] - m) : 0.f; s[tt][e] = p; lsum += p; }
    lsum += __shfl_xor(lsum, 16); lsum += __shfl_xor(lsum, 32);
    f32x4 o[4];
#pragma unroll
    for (int dt = 0; dt < 4; ++dt) o[dt] = (f32x4){0.f, 0.f, 0.f, 0.f};
#pragma unroll
    for (int pp = 0; pp < 5; ++pp) {
        const int T0 = 2 * pp, T1 = 2 * pp + 1;
        union { unsigned u[4]; bf16x8 v; } pb;
        pb.u[0] = pk2(s[T0][0], s[T0][1]); pb.u[1] = pk2(s[T0][2], s[T0][3]); pb.u[2] = pk2(s[T1][0], s[T1][1]); pb.u[3] = pk2(s[T1][2], s[T1][3]);
        const int k0 = (w + T0) * 16 + 4 * g, k1 = (w + (T1 < 9 ? T1 : T0)) * 16 + 4 * g;
#pragma unroll
        for (int dt = 0; dt < 4; ++dt) {
            union { unsigned long long q[2]; bf16x8 v; } av;
            av.q[0] = *(const LAS unsigned long long*)(VT + (dt * 16 + lq) * 264 + k0); av.q[1] = *(const LAS unsigned long long*)(VT + (dt * 16 + lq) * 264 + k1);
            o[dt] = mfma16(av.v, pb.v, o[dt]);
        }
    }
    const float inv = 1.0f / lsum;
    float* op = OB + ((size_t)di * MT + qrow) * 384 + h * 64 + 4 * g;
#pragma unroll
    for (int dt = 0; dt < 4; ++dt) *(f32x4*)(op + dt * 16) = o[dt] * inv;
    if (g == 0) LSE[((size_t)di * MT + qrow) * 6 + h] = m + __logf(lsum);
    __syncthreads();
}

__device__ __forceinline__ void copy_item(Frame& F, int l, int item) {
    const int which = item >> 8, b = (item >> 3) & 31, part = item & 7;
    constexpr int N4 = (WBUF - TS) * 384 / 4, P4 = N4 / 8;
    static_assert(N4 % 8 == 0, "copy split");
    const f32x4* src = (const f32x4*)((which ? inp(F, 5) : inp(F, 4)) + (((size_t)l * NBS + b) * WBUF + TS) * 384) + (size_t)part * P4;
    f32x4* dst = (f32x4*)(F.out + (which ? O_SWINV : O_SWINK) + ((size_t)l * NBS + b) * WBUF * 384) + (size_t)part * P4;
    int tid = F.tid; asm volatile("" : "+v"(tid));
    for (int base = tid; base < P4; base += NTHR * 8) {
        f32x4 v[8];
#pragma unroll
        for (int k = 0; k < 8; ++k) { const int i = base + NTHR * k; v[k] = __builtin_nontemporal_load(src + (i < P4 ? i : tid)); }
#pragma unroll
        for (int k = 0; k < 8; ++k) { const int i = base + NTHR * k; if (i < P4) __builtin_nontemporal_store(v[k], dst + i); }
    }
}


constexpr int CK_BYTES = 49152;
constexpr int CK_M = 0, CK_Q = 8192, CK_N = 16384, CK_O = 32768;
constexpr int MS_ = 72;
constexpr int L_XL = 0, L_KKD = 33792, L_RD = L_KKD + 9216, L_KDI = L_RD + 9216, L_BDI = L_KDI + 9216, L_KDET = L_BDI + 9216, L_BDET = L_KDET + 9216, L_VT = L_BDET + 9216,
              L_AUB = L_VT + 9216, L_AUK = L_AUB + 9216, L_AOK = L_AUK + 9216, L_AOB = L_AOK + 9216, L_DG = L_AOB + 9216, L_DI = L_DG + 4 * 16 * 17 * 4, L_TT = L_DI + 4 * 16 * 24 * 2,
              L_LC = L_TT + 1024, L_SS = L_LC + 256, L_END5 = L_SS + 1024;
constexpr int L_UT = L_KDI, L_KT = L_BDI;
constexpr int L_MQ = L_AUB;
static_assert(L_XL + 64 * 264 * 2 <= L_KKD && L_END5 <= RING_BYTES && (L_DI % 16) == 0 && (L_DG % 16) == 0, "rwkv item LDS map");
#define LBAR() asm volatile("s_waitcnt lgkmcnt(0)\n\ts_barrier" ::: "memory")

typedef unsigned u32x2 __attribute__((ext_vector_type(2)));
__device__ __forceinline__ float dpp_shr(float x, const int n) {
    const int xi = __float_as_int(x); int r;
    if (n == 1) r = __builtin_amdgcn_update_dpp(0, xi, 0x111, 0xF, 0xF, true);
    else if (n == 2) r = __builtin_amdgcn_update_dpp(0, xi, 0x112, 0xF, 0xF, true);
    else if (n == 4) r = __builtin_amdgcn_update_dpp(0, xi, 0x114, 0xF, 0xF, true);
    else r = __builtin_amdgcn_update_dpp(0, xi, 0x118, 0xF, 0xF, true);
    return __int_as_float(r);
}
__device__ __forceinline__ float bfw(unsigned w, int e) { return __uint_as_float((e & 1) ? (w & 0xffff0000u) : (w << 16)); }
__device__ __forceinline__ float fsig(float x) { return __builtin_amdgcn_rcpf(1.0f + __builtin_amdgcn_exp2f(-1.4426950408889634f * x)); }
__device__ __forceinline__ float ftanh(float x) { return 1.0f - 2.0f * __builtin_amdgcn_rcpf(1.0f + __builtin_amdgcn_exp2f(2.8853900817779268f * x)); }
__device__ __forceinline__ float fexp(float x) { return __builtin_amdgcn_exp2f(1.4426950408889634f * x); }

__device__ __forceinline__ void rwkv_item(Frame& F, int l, int tile) {
    int tid = F.tid; asm volatile("" : "+v"(tid));
    const int w = F.wave;
    const bool isS = tile >= 256;
    const int R0 = isS ? MP + (tile - 256) * 64 : tile * 64;
    const bf16* H = (const bf16*)(F.ws + WS_H);
    const unsigned char* wb = F.ws + WS_W + (size_t)l * LW;
    const float* mu = inp(F, 8) + l * A_COLS;
    LAS unsigned char* lds = F.lds;
    {
        const int tok = tid >> 3, cg = tid & 7, row = R0 + tok, col0 = 1152 + cg * 32;
        const bf16* hc = H + (size_t)row * IN_COLS + col0;
        bool zero_prev = false; const float* sp = nullptr;
        if (!isS) zero_prev = (row & (SEQ - 1)) == 0; else if (((row - MP) & 3) == 0) sp = inp(F, 2) + ((size_t)l * NBS + ((row - MP) >> 2)) * A_COLS + col0;
        v4u cu[4], pu[4];
#pragma unroll
        for (int q = 0; q < 4; ++q) { cu[q] = *(const v4u*)(hc + q * 8); pu[q] = (v4u){0u, 0u, 0u, 0u}; if (!zero_prev && !sp) pu[q] = *(const v4u*)(hc - IN_COLS + q * 8); }
#pragma unroll
        for (int q = 0; q < 4; ++q) {
            const unsigned cw[4] = {cu[q].x, cu[q].y, cu[q].z, cu[q].w}, pw[4] = {pu[q].x, pu[q].y, pu[q].z, pu[q].w};
            const f32x4 m0 = *(const f32x4*)(mu + col0 + q * 8), m1 = *(const f32x4*)(mu + col0 + q * 8 + 4);
            float xo[8];
#pragma unroll
            for (int e = 0; e < 8; ++e) {
                const float c = bfw(cw[e >> 1], e & 1); float p = bfw(pw[e >> 1], e & 1);
                if (sp) p = sp[q * 8 + e];
                float x = c + (p - c) * (e < 4 ? m0[e & 3] : m1[e & 3]);
                if (cg < 2) x = ftanh(x); else if (cg >= 4) x = fsig(x);
                xo[e] = x;
            }
            v4u o; o.x = pk2(xo[0], xo[1]); o.y = pk2(xo[2], xo[3]); o.z = pk2(xo[4], xo[5]); o.w = pk2(xo[6], xo[7]);
            *(LAS v4u*)(lds + L_XL + (tok * 264 + cg * 32 + q * 8) * 2) = o;
        }
    }
    LBAR();
    const int mt = w & 3, cth = w >> 2;
    const bf16* WlT = (const bf16*)(wb + W_WL); const bf16* AlT = (const bf16*)(wb + W_AL); const bf16* GlT = (const bf16*)(wb + W_GL);
    const float* w0 = inp(F, 9) + l * WA; const float* a0 = inp(F, 11) + l * WA; const float* kkw = inp(F, 14) + l * WA; const float* kaw = inp(F, 15) + l * WA; const float* rkw = inp(F, 16) + l * WA;
  for (int h = 0; h < 6; ++h) {
    int tidh = tid; asm volatile("" : "+v"(tidh));
    const int lane = tidh & 63, g = lane >> 4, lq = lane & 15, tk = mt * 16 + lq, row = R0 + tk;
    bool zero_prev = false; const float* sp = nullptr;
    if (!isS) zero_prev = (row & (SEQ - 1)) == 0; else if (((row - MP) & 3) == 0) sp = inp(F, 2) + ((size_t)l * NBS + ((row - MP) >> 2)) * A_COLS;
    float lwv[8], L[8], xr[8], k2[8], kk[8], bb[8];
    {
        f32x4 dw[2], da[2], dg[2];
#pragma unroll
        for (int cl = 0; cl < 2; ++cl) { const int ct = 2 * cth + cl; dw[cl] = (f32x4){0.f, 0.f, 0.f, 0.f}; da[cl] = dw[cl]; dg[cl] = dw[cl];
#pragma unroll
            for (int ks = 0; ks < 2; ++ks) {
                const bf16x8 a1 = *(const bf16x8*)(WlT + (size_t)(h * 64 + ct * 16 + lq) * 64 + 32 * ks + 8 * g), a2 = *(const bf16x8*)(AlT + (size_t)(h * 64 + ct * 16 + lq) * 64 + 32 * ks + 8 * g);
                const bf16x8 b1 = *(const LAS bf16x8*)(lds + L_XL + (tk * 264 + 32 * ks + 8 * g) * 2), b2 = *(const LAS bf16x8*)(lds + L_XL + (tk * 264 + 64 + 32 * ks + 8 * g) * 2);
                dw[cl] = mfma16(a1, b1, dw[cl]); da[cl] = mfma16(a2, b2, da[cl]); }
#pragma unroll
            for (int ks = 0; ks < 4; ++ks) { const bf16x8 a = *(const bf16x8*)(GlT + (size_t)(h * 64 + ct * 16 + lq) * 128 + 32 * ks + 8 * g);
                const bf16x8 b = *(const LAS bf16x8*)(lds + L_XL + (tk * 264 + 128 + 32 * ks + 8 * g) * 2); dg[cl] = mfma16(a, b, dg[cl]); } }
        float* gp = (float*)(F.ws + WS_G) + (size_t)row * WA + h * 64 + cth * 32 + 4 * g;
#pragma unroll
        for (int cl = 0; cl < 2; ++cl) *(f32x4*)(gp + cl * 16) = dg[cl];
        float ssum = 0.f, rksum = 0.f; float xv[8];
#pragma unroll
        for (int cl = 0; cl < 2; ++cl) {
            const int c16 = (2 * cth + cl) * 16 + 4 * g, ch = h * 64 + c16;
            float xs[3][4];
#pragma unroll
            for (int part = 0; part < 3; ++part) {
                const bf16* hp = H + (size_t)row * IN_COLS + part * WA + ch;
                const u32x2 cu = *(const u32x2*)hp; u32x2 pu = (u32x2){0u, 0u};
                if (!zero_prev && !sp) pu = *(const u32x2*)(hp - IN_COLS);
                const f32x4 m4 = *(const f32x4*)(mu + part * WA + ch);
                const unsigned cw[2] = {cu.x, cu.y}, pw[2] = {pu.x, pu.y};
#pragma unroll
                for (int e = 0; e < 4; ++e) {
                    const float c = bfw(cw[e >> 1], e & 1); float p = bfw(pw[e >> 1], e & 1);
                    if (sp) p = sp[part * WA + ch + e];
                    xs[part][e] = c + (p - c) * m4[e];
                }
            }
            const f32x4 w04 = *(const f32x4*)(w0 + ch), a04 = *(const f32x4*)(a0 + ch), kk4 = *(const f32x4*)(kkw + ch), ka4 = *(const f32x4*)(kaw + ch), rk4 = *(const f32x4*)(rkw + ch);
#pragma unroll
            for (int e = 0; e < 4; ++e) {
                const int i = cl * 4 + e;
                const float a = fsig(a04[e] + da[cl][e]);
                lwv[i] = -DECAY_SCALE * fsig(w04[e] + dw[cl][e]);
                xr[i] = xs[0][e]; xv[i] = xs[2][e];
                const float kq = xs[1][e] * kk4[e]; kk[i] = kq; ssum += kq * kq;
                k2[i] = xs[1][e] * (1.0f + (a - 1.0f) * ka4[e]);
                bb[i] = a;
                rksum += xr[i] * k2[i] * rk4[e];
                if (!isS) *(LAS bf16*)(lds + L_VT + ((c16 + e) * MS_ + tk) * 2) = (bf16)f2bf(xv[i]);
            }
        }
        ssum += __shfl_xor(ssum, 16); ssum += __shfl_xor(ssum, 32); rksum += __shfl_xor(rksum, 16); rksum += __shfl_xor(rksum, 32);
        if (g == 0) { *(LAS float*)(lds + L_SS + (tk * 4 + cth * 2) * 4) = ssum; *(LAS float*)(lds + L_SS + (tk * 4 + cth * 2 + 1) * 4) = rksum; }
        float* vx = (float*)(F.ws + WS_VX) + (size_t)row * WA + h * 64 + cth * 32 + 4 * g;
#pragma unroll
        for (int cl = 0; cl < 2; ++cl) *(f32x4*)(vx + cl * 16) = (f32x4){xv[cl * 4], xv[cl * 4 + 1], xv[cl * 4 + 2], xv[cl * 4 + 3]};
        if (isS) {
            float* sc = (float*)(F.ws + WS_SC) + ((size_t)(row - MP) * 6 + h) * 384 + cth * 32 + 4 * g;
#pragma unroll
            for (int cl = 0; cl < 2; ++cl) *(f32x4*)(sc + 192 + cl * 16) = (f32x4){xv[cl * 4], xv[cl * 4 + 1], xv[cl * 4 + 2], xv[cl * 4 + 3]};
        } else {
#pragma unroll
            for (int i = 0; i < 8; ++i) { float s = lwv[i];
                s += dpp_shr(s, 1); s += dpp_shr(s, 2); s += dpp_shr(s, 4); s += dpp_shr(s, 8); L[i] = s;
                if (lq == 15) *(LAS float*)(lds + L_TT + (mt * 64 + (2 * cth + (i >> 2)) * 16 + 4 * g + (i & 3)) * 4) = s; }
        }
    }
    LBAR();
    {
        const LAS float* ss = (const LAS float*)(lds + L_SS) + tk * 4;
        const float kn = rsqrtf(fmaxf(ss[0] + ss[2], 1e-12f));
#pragma unroll
        for (int i = 0; i < 8; ++i) { kk[i] *= kn; bb[i] *= kk[i]; }
        if (cth == 0 && g == 0) ((float*)(F.ws + WS_RK))[row * 6 + h] = ss[1] + ss[3];
    }
    if (isS) {
        float* sc = (float*)(F.ws + WS_SC) + ((size_t)(row - MP) * 6 + h) * 384 + cth * 32 + 4 * g;
#pragma unroll
        for (int cl = 0; cl < 2; ++cl) { const int i = cl * 4;
            *(f32x4*)(sc + cl * 16) = (f32x4){xr[i], xr[i + 1], xr[i + 2], xr[i + 3]};
            *(f32x4*)(sc + 64 + cl * 16) = (f32x4){fexp(lwv[i]), fexp(lwv[i + 1]), fexp(lwv[i + 2]), fexp(lwv[i + 3])};
            *(f32x4*)(sc + 128 + cl * 16) = (f32x4){k2[i], k2[i + 1], k2[i + 2], k2[i + 3]};
            *(f32x4*)(sc + 256 + cl * 16) = (f32x4){kk[i], kk[i + 1], kk[i + 2], kk[i + 3]};
            *(f32x4*)(sc + 320 + cl * 16) = (f32x4){bb[i], bb[i + 1], bb[i + 2], bb[i + 3]}; }
        LBAR();
        continue;
    }
#pragma unroll
    for (int cl = 0; cl < 2; ++cl) {
        float v_kkd[4], v_rd[4], v_kdi[4], v_bdi[4];
#pragma unroll
        for (int e = 0; e < 4; ++e) {
            const int i = cl * 4 + e, c16 = (2 * cth + cl) * 16 + 4 * g + e;
            const LAS float* tt = (const LAS float*)(lds + L_TT) + c16;
            const float t0 = tt[0], t1 = tt[64], t2 = tt[128], t3 = tt[192];
            const float off = (mt > 0 ? t0 : 0.f) + (mt > 1 ? t1 : 0.f) + (mt > 2 ? t2 : 0.f), LC = (t0 + t1) + (t2 + t3);
            const float Lt = L[i] + off, Lp = Lt - lwv[i];
            const float eL = fexp(Lt), eLp = fexp(Lp), eN = fexp(-Lt), eC = fexp(LC - Lt);
            v_kkd[e] = kk[i] * eLp; v_rd[e] = xr[i] * eL; v_kdi[e] = k2[i] * eN; v_bdi[e] = bb[i] * eN;
            *(LAS bf16*)(lds + L_KDET + (c16 * MS_ + tk) * 2) = (bf16)f2bf(k2[i] * eC);
            *(LAS bf16*)(lds + L_BDET + (c16 * MS_ + tk) * 2) = (bf16)f2bf(bb[i] * eC);
            if (mt == 0 && lq == 0) *(LAS float*)(lds + L_LC + c16 * 4) = fexp(LC);
        }
        const int o2 = (tk * MS_ + (2 * cth + cl) * 16 + 4 * g) * 2;
        *(LAS u32x2*)(lds + L_KKD + o2) = (u32x2){pk2(v_kkd[0], v_kkd[1]), pk2(v_kkd[2], v_kkd[3])};
        *(LAS u32x2*)(lds + L_RD + o2) = (u32x2){pk2(v_rd[0], v_rd[1]), pk2(v_rd[2], v_rd[3])};
        *(LAS u32x2*)(lds + L_KDI + o2) = (u32x2){pk2(v_kdi[0], v_kdi[1]), pk2(v_kdi[2], v_kdi[3])};
        *(LAS u32x2*)(lds + L_BDI + o2) = (u32x2){pk2(v_bdi[0], v_bdi[1]), pk2(v_bdi[2], v_bdi[3])};
    }
    LBAR();
    {
        const int p = w >> 1;
        const int xoff = p < 2 ? L_KKD : L_RD, yoff = (p == 0 || p == 3) ? L_BDI : L_KDI, doff = p == 0 ? L_AUB : (p == 1 ? L_AUK : (p == 2 ? L_AOK : L_AOB));
#pragma unroll
        for (int ti = 0; ti < 2; ++ti) {
            const int tt = 2 * (w & 1) + ti;
            const bf16x8 a0 = *(const LAS bf16x8*)(lds + xoff + ((tt * 16 + lq) * MS_ + 8 * g) * 2), a1 = *(const LAS bf16x8*)(lds + xoff + ((tt * 16 + lq) * MS_ + 32 + 8 * g) * 2);
#pragma unroll
            for (int st = 0; st < 4; ++st) {
                f32x4 acc = (f32x4){0.f, 0.f, 0.f, 0.f};
                if (st <= tt) {
                    const bf16x8 b0 = *(const LAS bf16x8*)(lds + yoff + ((st * 16 + lq) * MS_ + 8 * g) * 2), b1 = *(const LAS bf16x8*)(lds + yoff + ((st * 16 + lq) * MS_ + 32 + 8 * g) * 2);
                    acc = mfma16(a0, b0, acc); acc = mfma16(a1, b1, acc);
                }
                const int s = st * 16 + lq;
#pragma unroll
                for (int e = 0; e < 4; ++e) {
                    const int t = tt * 16 + 4 * g + e;
                    const float val = (p < 2 ? s < t : s <= t) ? acc[e] : 0.f;
                    *(LAS bf16*)(lds + doff + (t * MS_ + s) * 2) = (bf16)f2bf(val);
                    if (p == 0 && st == tt) *(LAS float*)(lds + L_DG + ((tt * 16 + 4 * g + e) * 17 + lq) * 4) = val;
                }
            }
        }
    }
    LBAR();
    f32x4 X[4];
    if (w < 4) {
#pragma unroll
        for (int tt = 0; tt < 4; ++tt) { X[tt] = (f32x4){0.f, 0.f, 0.f, 0.f};
#pragma unroll
            for (int ks = 0; ks < 2; ++ks) X[tt] = mfma16(*(const LAS bf16x8*)(lds + L_AUK + ((tt * 16 + lq) * MS_ + 32 * ks + 8 * g) * 2), *(const LAS bf16x8*)(lds + L_VT + ((w * 16 + lq) * MS_ + 32 * ks + 8 * g) * 2), X[tt]); }
    } else {
#pragma unroll
        for (int tt = 0; tt < 4; ++tt)
#pragma unroll
            for (int e = 0; e < 4; ++e) X[tt][e] = bf2f(*(const LAS bf16*)(lds + L_KKD + ((tt * 16 + 4 * g + e) * MS_ + (w - 4) * 16 + lq) * 2));
        if (w == 7) {
            const LAS float* dg = (const LAS float*)(lds + L_DG) + g * 16 * 17;
            float Y[16];
#pragma unroll
            for (int t = 0; t < 16; ++t) { float acc = (t == lq) ? 1.0f : 0.0f;
#pragma unroll
                for (int s = 0; s < t; ++s) acc -= dg[t * 17 + s] * Y[s];
                Y[t] = acc; }
#pragma unroll
            for (int t = 0; t < 16; ++t) *(LAS bf16*)(lds + L_DI + ((g * 16 + t) * 24 + lq) * 2) = (bf16)f2bf(Y[t]);
        }
    }
    LBAR();
    {
        union { unsigned u[4]; bf16x8 v; } xb[2];
        xb[0].u[0] = xb[0].u[1] = xb[0].u[2] = xb[0].u[3] = 0u; xb[1].u[0] = xb[1].u[1] = xb[1].u[2] = xb[1].u[3] = 0u;
#pragma unroll
        for (int I = 0; I < 4; ++I) {
            f32x4 acc = X[I];
            if (I > 0) {
                union { unsigned long long q[2]; bf16x8 v; } av; f32x4 up = (f32x4){0.f, 0.f, 0.f, 0.f};
                av.q[0] = *(const LAS unsigned long long*)(lds + L_AUB + ((I * 16 + lq) * MS_ + 4 * g) * 2); av.q[1] = *(const LAS unsigned long long*)(lds + L_AUB + ((I * 16 + lq) * MS_ + 16 + 4 * g) * 2);
                up = mfma16(av.v, xb[0].v, up);
                if (I > 2) { av.q[0] = *(const LAS unsigned long long*)(lds + L_AUB + ((I * 16 + lq) * MS_ + 32 + 4 * g) * 2); av.q[1] = 0ull; up = mfma16(av.v, xb[1].v, up); }
                acc = acc - up;
            }
            union { unsigned u[4]; bf16x8 v; } rb; rb.u[0] = pk2(acc[0], acc[1]); rb.u[1] = pk2(acc[2], acc[3]); rb.u[2] = 0u; rb.u[3] = 0u;
            union { unsigned long long q[2]; bf16x8 v; } dv; dv.q[0] = *(const LAS unsigned long long*)(lds + L_DI + ((I * 16 + lq) * 24 + 4 * g) * 2); dv.q[1] = 0ull;
            const f32x4 xi = mfma16(dv.v, rb.v, (f32x4){0.f, 0.f, 0.f, 0.f});
            X[I] = xi;
            if (I == 0) { xb[0].u[0] = pk2(xi[0], xi[1]); xb[0].u[1] = pk2(xi[2], xi[3]); }
            else if (I == 1) { xb[0].u[2] = pk2(xi[0], xi[1]); xb[0].u[3] = pk2(xi[2], xi[3]); }
            else if (I == 2) { xb[1].u[0] = pk2(xi[0], xi[1]); xb[1].u[1] = pk2(xi[2], xi[3]); }
            *(LAS u32x2*)(lds + (w < 4 ? L_UT + (w * 16 + lq) * MS_ * 2 : L_KT + ((w - 4) * 16 + lq) * MS_ * 2) + (I * 16 + 4 * g) * 2) = (u32x2){pk2(xi[0], xi[1]), pk2(xi[2], xi[3])};
        }
    }
    LBAR();
    unsigned char* ck = F.ws + WS_CK + (size_t)((((tile >> 6) * 6 + h) << 6) + (tile & 63)) * CK_BYTES;
    {
        const int which = w >> 1;
#pragma unroll
        for (int ri = 0; ri < 2; ++ri) {
            const int rt = 2 * (w & 1) + ri;
#pragma unroll
            for (int nt = 0; nt < 4; ++nt) {
                f32x4 acc = (f32x4){0.f, 0.f, 0.f, 0.f}, acc2 = acc;
                if (which == 0 || which == 2) {
                    const int aoff = which == 0 ? L_BDET : L_AOB;
#pragma unroll
                    for (int ks = 0; ks < 2; ++ks) acc = mfma16(*(const LAS bf16x8*)(lds + aoff + ((rt * 16 + lq) * MS_ + 32 * ks + 8 * g) * 2), *(const LAS bf16x8*)(lds + L_KT + ((nt * 16 + lq) * MS_ + 32 * ks + 8 * g) * 2), acc);
                    LAS bf16* dstp = (LAS bf16*)(lds + L_MQ + (which == 0 ? 0 : 8192)) + ((rt * 2 + (nt >> 1)) * 64 + (lq >> 2) * 16) * 8 + (nt & 1) * 4 + (lq & 3);
#pragma unroll
                    for (int e = 0; e < 4; ++e) {
                        const int rr = rt * 16 + 4 * g + e, cc = nt * 16 + lq;
                        float val;
                        if (which == 0) val = (rr == cc ? *(const LAS float*)(lds + L_LC + rr * 4) : 0.f) - acc[e];
                        else val = bf2f(*(const LAS bf16*)(lds + L_RD + (rr * MS_ + cc) * 2)) - acc[e];
                        dstp[(4 * g + e) * 8] = (bf16)f2bf(val);
                    }
                } else {
                    const int a1 = which == 1 ? L_KDET : L_AOK, a2 = which == 1 ? L_BDET : L_AOB;
#pragma unroll
                    for (int ks = 0; ks < 2; ++ks) {
                        acc = mfma16(*(const LAS bf16x8*)(lds + a1 + ((rt * 16 + lq) * MS_ + 32 * ks + 8 * g) * 2), *(const LAS bf16x8*)(lds + L_VT + ((nt * 16 + lq) * MS_ + 32 * ks + 8 * g) * 2), acc);
                        acc2 = mfma16(*(const LAS bf16x8*)(lds + a2 + ((rt * 16 + lq) * MS_ + 32 * ks + 8 * g) * 2), *(const LAS bf16x8*)(lds + L_UT + ((nt * 16 + lq) * MS_ + 32 * ks + 8 * g) * 2), acc2);
                    }
                    *(f32x4*)(ck + (which == 1 ? CK_N : CK_O) + (size_t)((nt * 4 + rt) * 64 + lane) * 16) = acc - acc2;
                }
            }
        }
    }
    LBAR();
#pragma unroll
    for (int i = 0; i < 2; ++i) { const int o16 = (tidh + NTHR * i) * 16; *(v4u*)(ck + CK_M + o16) = *(const LAS v4u*)(lds + L_MQ + o16); }
    LBAR();
  }
}

#define CHAIN_LOAD_MN(MF, NF, cp_) do { const unsigned char* cq_ = (cp_); \
    _Pragma("unroll") for (int i = 0; i < 8; ++i) MF[i] = *(const bf16x8*)(cq_ + CK_M + (size_t)(i * 64 + lane) * 16); \
    _Pragma("unroll") for (int i = 0; i < 4; ++i) NF[i] = *(const f32x4*)(cq_ + CK_N + (size_t)((ft * 4 + i) * 64 + lane) * 16); } while (0)
#define CHAIN_STEP(MF, NF, MFN, NFN, c_) do { \
    bf16x8 qf[8]; f32x4 of[4]; const unsigned char* cq_ = ck + (size_t)(c_) * CK_BYTES; \
    _Pragma("unroll") for (int i = 0; i < 8; ++i) qf[i] = *(const bf16x8*)(cq_ + CK_Q + (size_t)(i * 64 + lane) * 16); \
    _Pragma("unroll") for (int i = 0; i < 4; ++i) of[i] = *(const f32x4*)(cq_ + CK_O + (size_t)((ft * 4 + i) * 64 + lane) * 16); \
    CHAIN_LOAD_MN(MFN, NFN, ck + (size_t)((c_) + 1 < 64 ? (c_) + 1 : 63) * CK_BYTES); \
    union { unsigned u[4]; bf16x8 v; } zb[2]; \
    _Pragma("unroll") for (int ks = 0; ks < 2; ++ks) { zb[ks].u[0] = pk2(Z[2 * ks][0], Z[2 * ks][1]); zb[ks].u[1] = pk2(Z[2 * ks][2], Z[2 * ks][3]); zb[ks].u[2] = pk2(Z[2 * ks + 1][0], Z[2 * ks + 1][1]); zb[ks].u[3] = pk2(Z[2 * ks + 1][2], Z[2 * ks + 1][3]); } \
    _Pragma("unroll") for (int mt = 0; mt < 4; ++mt) { f32x4 z = NF[mt]; z = mfma16(MF[mt * 2], zb[0].v, z); z = mfma16(MF[mt * 2 + 1], zb[1].v, z); Z[mt] = z; } \
    float* op = OA + (size_t)(b * SEQ + (c_) * 64) * WA + h * 64 + ft * 16 + lq; \
    _Pragma("unroll") for (int tt = 0; tt < 4; ++tt) { f32x4 o = of[tt]; o = mfma16(qf[tt * 2], zb[0].v, o); o = mfma16(qf[tt * 2 + 1], zb[1].v, o); \
        _Pragma("unroll") for (int e = 0; e < 4; ++e) op[(size_t)(tt * 16 + 4 * g + e) * WA] = o[e]; } } while (0)
__device__ __forceinline__ void chain_item(Frame& F, int l, int item) {
    int tid = F.tid; asm volatile("" : "+v"(tid));
    const int lane = tid & 63, w = F.wave, g = lane >> 4, lq = lane & 15;
    const int bh = item, ft = w & 3, b = bh / 6, h = bh % 6;
    const unsigned char* ck = F.ws + WS_CK + (size_t)(bh << 6) * CK_BYTES;
    float* OA = (float*)(F.ws + WS_OA);
    constexpr int PF = 6;
    if (w >= 4) {
        const int pt = tid - 256;
        for (int c = 0; c < PF; ++c) { unsigned t0 = *(const unsigned*)(ck + (size_t)c * CK_BYTES + pt * 128), t1 = 0u; if (pt < 128) t1 = *(const unsigned*)(ck + (size_t)c * CK_BYTES + (256 + pt) * 128); asm volatile("" :: "v"(t0), "v"(t1)); }
        for (int c = 0; c < 64; c += 2) {
#pragma unroll
            for (int k = 0; k < 2; ++k) { const int cc = c + k + PF;
                if (cc < 64) { unsigned t0 = *(const unsigned*)(ck + (size_t)cc * CK_BYTES + pt * 128), t1 = 0u; if (pt < 128) t1 = *(const unsigned*)(ck + (size_t)cc * CK_BYTES + (256 + pt) * 128); asm volatile("" :: "v"(t0), "v"(t1)); }
                LBAR(); }
        }
        return;
    }
    f32x4 Z[4];
#pragma unroll
    for (int mt = 0; mt < 4; ++mt) Z[mt] = (f32x4){0.f, 0.f, 0.f, 0.f};
    bf16x8 mfA[8], mfB[8]; f32x4 nfA[4], nfB[4];
    CHAIN_LOAD_MN(mfA, nfA, ck);
    for (int c = 0; c < 64; c += 2) {
        CHAIN_STEP(mfA, nfA, mfB, nfB, c);
        LBAR();
        CHAIN_STEP(mfB, nfB, mfA, nfA, c + 1);
        LBAR();
    }
    float* so = F.out + O_PWKV + (((size_t)l * NBP + b) * 6 + h) * 4096 + (size_t)(ft * 16 + lq) * 64 + 4 * g;
#pragma unroll
    for (int mt = 0; mt < 4; ++mt) *(f32x4*)(so + mt * 16) = Z[mt];
}

__device__ __forceinline__ int q_next(Frame& F, int qi) {
    volatile LAS unsigned* slot = F.MISC + 12;
    if (F.tid == 0) slot[0] = __hip_atomic_fetch_add(F.ctl + CW_Q + 64 * (qi + 8 * F.rep), 1u, RLX_AGENT);
    __syncthreads();
    const int v = (int)slot[0];
    __syncthreads();
    return v;
}


__device__ __forceinline__ void ret1_item(Frame& F, int item) {
    int tid = F.tid; asm volatile("" : "+v"(tid));
    const int lane = tid & 63, w = F.wave, g = lane >> 4, lq = lane & 15;
    const int c = item & 31, bh = item >> 5, b = bh >> 2, h = bh & 3;
    const bf16* H = (const bf16*)(F.ws + WS_H); float* OC = (float*)(F.ws + WS_OC);
    const float gam = 1.0f - exp2f(-5.0f - (float)h), lg2 = log2f(gam);
    LAS bf16* Kl = (LAS bf16*)F.lds;
    LAS bf16* KTd = Kl + 128 * 72;
    LAS bf16* VT = KTd + 64 * 136;
    const size_t rowc = (size_t)b * SEQ + c * 128;
    v4u kv[2], vv[2];
#pragma unroll
    for (int i = 0; i < 2; ++i) { const int cid = tid + NTHR * i, key = cid >> 3, ch = cid & 7;
        kv[i] = *(const v4u*)(H + (rowc + key) * IN_COLS + COL_KC + h * 64 + ch * 8); vv[i] = *(const v4u*)(H + (rowc + key) * IN_COLS + COL_VC + h * 64 + ch * 8); }
    const int qi = 16 * w + lq; const size_t qrow = rowc + qi;
    bf16x8 qf[2];
    qf[0] = *(const bf16x8*)(H + qrow * IN_COLS + COL_QC + h * 64 + 8 * g); qf[1] = *(const bf16x8*)(H + qrow * IN_COLS + COL_QC + h * 64 + 32 + 8 * g);
#pragma unroll
    for (int i = 0; i < 2; ++i) { const int cid = tid + NTHR * i, key = cid >> 3, ch = cid & 7;
        *(LAS v4u*)(Kl + key * 72 + ch * 8) = kv[i];
        const float kd = exp2f((float)(127 - key) * lg2);
        const unsigned ku[4] = {kv[i].x, kv[i].y, kv[i].z, kv[i].w}, vu[4] = {vv[i].x, vv[i].y, vv[i].z, vv[i].w};
#pragma unroll
        for (int e = 0; e < 8; ++e) { KTd[(ch * 8 + e) * 136 + key] = (bf16)f2bf(bfw(ku[e >> 1], e & 1) * kd); VT[(ch * 8 + e) * 136 + key] = (bf16)((vu[e >> 1] >> ((e & 1) * 16)) & 0xffffu); } }
    __syncthreads();
    f32x4 s[8];
#pragma unroll
    for (int jt = 0; jt < 8; ++jt) {
        s[jt] = (f32x4){0.f, 0.f, 0.f, 0.f};
        if (jt <= w) {
#pragma unroll
            for (int ks = 0; ks < 2; ++ks) { const bf16x8 a = *(const LAS bf16x8*)(Kl + (jt * 16 + lq) * 72 + 32 * ks + 8 * g); s[jt] = mfma16(a, qf[ks], s[jt]); }
#pragma unroll
            for (int e = 0; e < 4; ++e) { const int kj = jt * 16 + 4 * g + e; s[jt][e] = kj <= qi ? s[jt][e] * exp2f((float)(qi - kj) * lg2) : 0.f; }
        }
    }
    f32x4 o[4];
#pragma unroll
    for (int ft = 0; ft < 4; ++ft) o[ft] = (f32x4){0.f, 0.f, 0.f, 0.f};
#pragma unroll
    for (int pp = 0; pp < 4; ++pp) {
        if (2 * pp <= w) {
            union { unsigned u[4]; bf16x8 v; } pb;
            pb.u[0] = pk2(s[2 * pp][0], s[2 * pp][1]); pb.u[1] = pk2(s[2 * pp][2], s[2 * pp][3]); pb.u[2] = pk2(s[2 * pp + 1][0], s[2 * pp + 1][1]); pb.u[3] = pk2(s[2 * pp + 1][2], s[2 * pp + 1][3]);
            const int k0 = (2 * pp) * 16 + 4 * g, k1 = (2 * pp + 1) * 16 + 4 * g;
#pragma unroll
            for (int ft = 0; ft < 4; ++ft) {
                union { unsigned long long q[2]; bf16x8 v; } av;
                av.q[0] = *(const LAS unsigned long long*)(VT + (ft * 16 + lq) * 136 + k0); av.q[1] = *(const LAS unsigned long long*)(VT + (ft * 16 + lq) * 136 + k1);
                o[ft] = mfma16(av.v, pb.v, o[ft]);
            }
        }
    }
    float* op = OC + qrow * 256 + h * 64 + 4 * g;
#pragma unroll
    for (int ft = 0; ft < 4; ++ft) *(f32x4*)(op + ft * 16) = o[ft];
    float* kvp = (float*)(F.ws + WS_KV) + (size_t)item * 4096;
#pragma unroll
    for (int ti = 0; ti < 2; ++ti) {
        const int tl = 2 * w + ti, ft = tl >> 2, et = tl & 3;
        f32x4 acc = (f32x4){0.f, 0.f, 0.f, 0.f};
#pragma unroll
        for (int ks = 0; ks < 4; ++ks) acc = mfma16(*(const LAS bf16x8*)(VT + (ft * 16 + lq) * 136 + 32 * ks + 8 * g), *(const LAS bf16x8*)(KTd + (et * 16 + lq) * 136 + 32 * ks + 8 * g), acc);
#pragma unroll
        for (int e = 0; e < 4; ++e) kvp[(ft * 16 + 4 * g + e) * 64 + et * 16 + lq] = acc[e];
    }
    __syncthreads();
}
__device__ __forceinline__ void ret2_item(Frame& F, int l, int item) {
    int tid = F.tid; asm volatile("" : "+v"(tid));
    const int lane = tid & 63, w = F.wave, g = lane >> 4, lq = lane & 15;
    const int c = item & 31, bh = item >> 5, b = bh >> 2, h = bh & 3;
    if (c == 0) return;
    const bf16* H = (const bf16*)(F.ws + WS_H); float* OC = (float*)(F.ws + WS_OC2);
    const float gam = 1.0f - exp2f(-5.0f - (float)h), lg2 = log2f(gam), gch = exp2f(128.0f * lg2);
    LAS bf16* RT = (LAS bf16*)F.lds;
    const float* kvb = (const float*)(F.ws + WS_KV) + (size_t)(bh * 32) * 4096 + tid * 8;
    f32x4 r0 = (f32x4){0.f, 0.f, 0.f, 0.f}, r1 = r0;
#pragma unroll 4
    for (int cc = 0; cc < c; ++cc) { const f32x4 a = *(const f32x4*)(kvb + (size_t)cc * 4096), bq = *(const f32x4*)(kvb + (size_t)cc * 4096 + 4); r0 = r0 * gch + a; r1 = r1 * gch + bq; }
    { const int f = tid >> 3, e0 = (tid & 7) * 8;
      *(LAS v4u*)(RT + f * 72 + e0) = (v4u){pk2(r0[0], r0[1]), pk2(r0[2], r0[3]), pk2(r1[0], r1[1]), pk2(r1[2], r1[3])};
      if (c == 31) {
          const f32x4 a = *(const f32x4*)(kvb + (size_t)31 * 4096), bq = *(const f32x4*)(kvb + (size_t)31 * 4096 + 4); const f32x4 f0 = r0 * gch + a, f1 = r1 * gch + bq;
          float* po = F.out + O_PRET + (((size_t)l * NBP + b) * 4 + h) * 4096 + f;
#pragma unroll
          for (int e = 0; e < 4; ++e) { po[dimC(e0 + e) * 64] = f0[e]; po[dimC(e0 + 4 + e) * 64] = f1[e]; }
      } }
    __syncthreads();
    const int qi = 16 * w + lq; const size_t qrow = (size_t)b * SEQ + c * 128 + qi;
    const float qdec = exp2f((float)(qi + 1) * lg2);
    bf16x8 qf[2];
    qf[0] = *(const bf16x8*)(H + qrow * IN_COLS + COL_QC + h * 64 + 8 * g); qf[1] = *(const bf16x8*)(H + qrow * IN_COLS + COL_QC + h * 64 + 32 + 8 * g);
    float* op = OC + qrow * 256 + h * 64 + 4 * g;
#pragma unroll
    for (int ft = 0; ft < 4; ++ft) { f32x4 x = (f32x4){0.f, 0.f, 0.f, 0.f};
#pragma unroll
        for (int ks = 0; ks < 2; ++ks) x = mfma16(*(const LAS bf16x8*)(RT + (ft * 16 + lq) * 72 + 32 * ks + 8 * g), qf[ks], x);
        *(f32x4*)(op + ft * 16) = x * qdec; }
    __syncthreads();
}

__device__ __forceinline__ void sret_item(Frame& F, int l, const bf16* H, float* OC, int item) {
    int tid = F.tid; asm volatile("" : "+v"(tid));
    const int b = item >> 2, h = item & 3, f = tid & 63, eg = tid >> 6;
    const float gam = 1.0f - exp2f(-5.0f - (float)h);
    const float* r0 = inp(F, 6) + (((size_t)l * NBS + b) * 4 + h) * 4096;
    LAS float* red = (LAS float*)F.lds;
    float S[8];
#pragma unroll
    for (int e = 0; e < 8; ++e) S[e] = r0[dimC(eg * 8 + e) * 64 + f];
    for (int t = 0; t < TS; ++t) {
        const size_t row = MP + b * 4 + t; const bf16* hp = H + row * IN_COLS;
        const float vf = bf2f(hp[COL_VC + h * 64 + f]);
        float part = 0.f;
#pragma unroll
        for (int e = 0; e < 8; ++e) { const float ke = bf2f(hp[COL_KC + h * 64 + eg * 8 + e]), qe = bf2f(hp[COL_QC + h * 64 + eg * 8 + e]); S[e] = gam * S[e] + ke * vf; part += qe * S[e]; }
        red[eg * 64 + f] = part;
        __syncthreads();
        if (tid < 64) { float o = 0.f;
#pragma unroll
            for (int q = 0; q < 8; ++q) o += red[q * 64 + tid];
            OC[row * 256 + h * 64 + tid] = o; }
        __syncthreads();
    }
    float* so = F.out + O_SRET + (((size_t)l * NBS + b) * 4 + h) * 4096;
#pragma unroll
    for (int e = 0; e < 8; ++e) so[dimC(eg * 8 + e) * 64 + f] = S[e];
}

__device__ __forceinline__ void sattn_item(Frame& F, int l, const bf16* H, float* OB, float* LSE, int item) {
    int lane = F.lane; asm volatile("" : "+v"(lane));
    const int qx = item * 8 + F.wave;
    const int b = qx / 24, t = (qx / 6) & 3, h = qx % 6; const size_t row = MP + b * 4 + t;
    LAS float* qs = (LAS float*)(F.lds + F.wave * 2048);
    LAS float* qp = qs + 64; LAS float* pw = qs + 128;
    const float* ck = inp(F, 4) + ((size_t)l * NBS + b) * WBUF * 384 + h * 64; const float* cv = inp(F, 5) + ((size_t)l * NBS + b) * WBUF * 384 + h * 64;
    const bf16* hk = H + (size_t)(MP + b * 4) * IN_COLS + COL_KB + h * 64; const bf16* hv = H + (size_t)(MP + b * 4) * IN_COLS + COL_VB + h * 64;
    { const float qv = bf2f(H[row * IN_COLS + COL_QB + h * 64 + lane]) * 0.125f; qs[dimB(lane)] = qv; qp[lane] = qv; }
    asm volatile("s_waitcnt lgkmcnt(0)" ::: "memory");
    for (int di = 0; di < 3; ++di) {
        const int d = di == 0 ? 1 : (di == 1 ? 4 : 16);
        float sc[3];
#pragma unroll
        for (int rnd = 0; rnd < 3; ++rnd) {
            const int jk = rnd * 64 + lane; float acc = -1e30f;
            if (jk <= 128) {
                const int idx = WBUF + t - d * jk; acc = 0.f;
                if (idx < WBUF) { const f32x4* kp = (const f32x4*)(ck + (size_t)idx * 384);
#pragma unroll
                    for (int q = 0; q < 16; ++q) { const f32x4 kx = kp[q], qq = *(const LAS f32x4*)(qs + 4 * q); acc += (kx[0] * qq[0] + kx[1] * qq[1]) + (kx[2] * qq[2] + kx[3] * qq[3]); }
                } else { const v4u* kp = (const v4u*)(hk + (size_t)(idx - WBUF) * IN_COLS);
#pragma unroll
                    for (int q = 0; q < 8; ++q) { const v4u kx = kp[q]; const f32x4 q0 = *(const LAS f32x4*)(qp + 8 * q), q1 = *(const LAS f32x4*)(qp + 8 * q + 4);
                        acc += (bfw(kx.x, 0) * q0[0] + bfw(kx.x, 1) * q0[1]) + (bfw(kx.y, 0) * q0[2] + bfw(kx.y, 1) * q0[3]) + (bfw(kx.z, 0) * q1[0] + bfw(kx.z, 1) * q1[1]) + (bfw(kx.w, 0) * q1[2] + bfw(kx.w, 1) * q1[3]); }
                }
            }
            sc[rnd] = acc;
        }
        const float m = wave_max(fmaxf(fmaxf(sc[0], sc[1]), sc[2]));
        float psum = 0.f;
#pragma unroll
        for (int rnd = 0; rnd < 3; ++rnd) { const int jk = rnd * 64 + lane; const float p = jk <= 128 ? __expf(sc[rnd] - m) : 0.f; psum += p; pw[jk] = p; }
        const float lsum = wave_sum(psum);
        asm volatile("s_waitcnt lgkmcnt(0)" ::: "memory");
        float o = 0.f;
#pragma unroll 8
        for (int jk = 0; jk <= 128; ++jk) {
            const int idx = WBUF + t - d * jk;
            const float vval = idx >= WBUF ? bf2f(hv[(size_t)(idx - WBUF) * IN_COLS + lane]) : cv[(size_t)idx * 384 + lane];
            o += pw[jk] * vval;
        }
        OB[((size_t)di * MT + row) * 384 + h * 64 + lane] = o / lsum;
        if (lane == 0) LSE[((size_t)di * MT + row) * 6 + h] = m + __logf(lsum);
    }
}

__device__ __forceinline__ void winout_item(Frame& F, int l, int item) {
    int tid = F.tid; asm volatile("" : "+v"(tid));
    const bf16* H = (const bf16*)(F.ws + WS_H);
    for (int q = tid; q < 64 * 96; q += NTHR) {
        const int r = item * 64 + q / 96, tk = q % 96;
        size_t row; float* ok; float* ov; size_t wrow;
        if (r < NBP * WBUF) { const int b = r >> 11, tt = r & (WBUF - 1); row = (size_t)b * SEQ + (SEQ - WBUF) + tt; wrow = ((size_t)l * NBP + b) * WBUF + tt; ok = F.out + O_PWINK; ov = F.out + O_PWINV; }
        else { const int rs = r - NBP * WBUF, b = rs >> 2, t = rs & 3; row = MP + rs; wrow = ((size_t)l * NBS + b) * WBUF + (WBUF - TS + t); ok = F.out + O_SWINK; ov = F.out + O_SWINV; }
        const bf16* hp = H + row * IN_COLS;
        if (tk < 48) {
            const int hh = tk >> 3, part = tk & 7; const v4u a = *(const v4u*)(hp + COL_KB + hh * 64 + 8 * part);
            const float v[8] = {bfw(a.x, 0), bfw(a.x, 1), bfw(a.y, 0), bfw(a.y, 1), bfw(a.z, 0), bfw(a.z, 1), bfw(a.w, 0), bfw(a.w, 1)};
            float* o = ok + wrow * 384 + hh * 64;
            if (part < 2) { *(f32x4*)(o + 4 * part) = (f32x4){v[0], v[2], v[4], v[6]}; *(f32x4*)(o + 8 + 4 * part) = (f32x4){v[1], v[3], v[5], v[7]}; }
            else { *(f32x4*)(o + 8 * part) = (f32x4){v[0], v[1], v[2], v[3]}; *(f32x4*)(o + 8 * part + 4) = (f32x4){v[4], v[5], v[6], v[7]}; }
        } else { const int c2 = tk - 48; const v4u a = *(const v4u*)(hp + COL_VB + 8 * c2); float* o = ov + wrow * 384 + 8 * c2;
            *(f32x4*)o = (f32x4){bfw(a.x, 0), bfw(a.x, 1), bfw(a.y, 0), bfw(a.y, 1)}; *(f32x4*)(o + 4) = (f32x4){bfw(a.z, 0), bfw(a.z, 1), bfw(a.w, 0), bfw(a.w, 1)}; }
    }
    if (item < NBP + NBS) {
        const bool isS = item >= NBP; const int b = isS ? item - NBP : item; const size_t row = isS ? MP + b * 4 + 3 : (size_t)b * SEQ + SEQ - 1;
        float* o = F.out + (isS ? O_SSHIFT + ((size_t)l * NBS + b) * A_COLS : O_PSHIFT + ((size_t)l * NBP + b) * A_COLS);
        for (int c = tid; c < A_COLS; c += NTHR) o[c] = bf2f(H[row * IN_COLS + c]);
    }
}
__device__ __forceinline__ void pa_phase(Frame& F, int l) {
    const bf16* H = (const bf16*)(F.ws + WS_H); float* OB = (float*)(F.ws + WS_OB); float* LSE = (float*)(F.ws + WS_LSE);
    constexpr int N_RW = 258, N_RET1 = NBP * 4 * 32, N_ATT = NBP * 6 * 3 * 32;
    for (;;) {
        int r = q_next(F, l * 4 + 0);
        if (r >= N_RW + N_RET1 + N_ATT) break;
        if (r < N_RW) { rwkv_item(F, l, r); continue; } r -= N_RW;
        if (r < N_RET1) { ret1_item(F, r); continue; } r -= N_RET1;
        attn_unit(F, H, OB, LSE, r);
    }
}
__device__ __forceinline__ void mixers_phase(Frame& F, int l) {
    const bf16* H = (const bf16*)(F.ws + WS_H); const float* SC = (const float*)(F.ws + WS_SC); float* OA = (float*)(F.ws + WS_OA);
    float* OB = (float*)(F.ws + WS_OB); float* LSE = (float*)(F.ws + WS_LSE); float* OC = (float*)(F.ws + WS_OC);
    constexpr int N_CHAIN = NBP * 6, N_RET2 = NBP * 4 * 32, N_SATT = (MS * 6) / 8, N_SRET = NBS * 4, N_SSCAN = NBS * 6 * 2, N_WOUT = (NBP * WBUF + MS) / 64, N_COPY = 0;
    constexpr int N_ALL = N_CHAIN + N_RET2 + N_SATT + N_SRET + N_SSCAN + N_WOUT + N_COPY;
    for (;;) {
        int r = q_next(F, l * 4 + 1);
        if (r >= N_ALL) break;
        if (r < N_CHAIN) { chain_item(F, l, r); continue; } r -= N_CHAIN;
        if (r < N_SATT) { sattn_item(F, l, H, OB, LSE, r); continue; } r -= N_SATT;
        if (r < N_RET2) { ret2_item(F, l, r); continue; } r -= N_RET2;
        if (r < N_SRET) { sret_item(F, l, H, OC, r); continue; } r -= N_SRET;
        if (r < N_SSCAN) { const int bh = r >> 1, half = r & 1, b = bh / 6, h = bh % 6;
            scan_item(F, SC, OA, b * TS, MP + b * TS, TS, h, half, inp(F, 3) + (((size_t)l * NBS + b) * 6 + h) * 4096, F.out + O_SWKV + (((size_t)l * NBS + b) * 6 + h) * 4096); continue; } r -= N_SSCAN;
        if (r < N_WOUT) { winout_item(F, l, r); continue; } r -= N_WOUT;
        copy_item(F, l, r);
    }
}

__device__ __forceinline__ void copy_tail(Frame& F, int l, int qi, int lo, int hi) {
    for (;;) { const int r = q_next(F, qi) + lo; if (r >= hi) break; copy_item(F, l, r); }
}

__device__ __forceinline__ void post_phase(Frame& F, int l) {
    const bf16* H = (const bf16*)(F.ws + WS_H); const float* VX = (const float*)(F.ws + WS_VX); const float* OA = (const float*)(F.ws + WS_OA);
    const float* OB = (const float*)(F.ws + WS_OB); const float* LSE = (const float*)(F.ws + WS_LSE); const float* OC = (const float*)(F.ws + WS_OC); const float* OC2 = (const float*)(F.ws + WS_OC2);
    const float* Gt = (const float*)(F.ws + WS_G); const float* RK = (const float*)(F.ws + WS_RK); bf16* MIX = (bf16*)(F.ws + WS_MIX);
    const float* gna = inp(F, 17) + l * WA; const float* gnb = inp(F, 18) + l * WA; const float* rgg = inp(F, 19) + l * 256; const float* rgb = inp(F, 20) + l * 256;
    int lane = F.lane; asm volatile("" : "+v"(lane));
    for (int row = F.bid * NWAVES + F.wave; row < MV; row += F.G * NWAVES) {
        bf16* mx = MIX + (size_t)row * DM;
#pragma unroll
        for (int bt = 0; bt < 2; ++bt) {
            const int i4 = lane + 64 * bt; const bool act = i4 < 96; const int c = (act ? i4 : 0) * 4, h = c >> 6;
            { const f32x4 o = *(const f32x4*)(OA + (size_t)row * WA + c);
              const float mean = red16((o[0] + o[1]) + (o[2] + o[3])) * (1.f / 64.f); const f32x4 d = o - mean;
              const float var = red16((d[0] * d[0] + d[1] * d[1]) + (d[2] * d[2] + d[3] * d[3])) * (1.f / 64.f); const float rstd = rsqrtf(var + GN_EPS_A);
              const f32x4 gg = *(const f32x4*)(gna + c), gb = *(const f32x4*)(gnb + c), vx = *(const f32x4*)(VX + (size_t)row * WA + c), gt = *(const f32x4*)(Gt + (size_t)row * WA + c);
              const float rk = RK[row * 6 + h];
              const f32x4 y = (d * rstd * gg + gb + vx * rk) * gt;
              if (act) *(u32x2*)(mx + c) = (u32x2){pk2(y[0], y[1]), pk2(y[2], y[3])}; }
            { const float l0 = LSE[((size_t)0 * MT + row) * 6 + h], l1 = LSE[((size_t)1 * MT + row) * 6 + h], l2 = LSE[((size_t)2 * MT + row) * 6 + h];
              const float m = fmaxf(fmaxf(l0, l1), l2); const float e0 = fexp(l0 - m), e1 = fexp(l1 - m), e2 = fexp(l2 - m); const float inv = __builtin_amdgcn_rcpf(e0 + e1 + e2);
              const f32x4 b0 = *(const f32x4*)(OB + ((size_t)0 * MT + row) * 384 + c), b1 = *(const f32x4*)(OB + ((size_t)1 * MT + row) * 384 + c), b2 = *(const f32x4*)(OB + ((size_t)2 * MT + row) * 384 + c);
              const f32x4 y = (b0 * e0 + b1 * e1 + b2 * e2) * inv;
              if (act) *(u32x2*)(mx + WA + c) = (u32x2){pk2(y[0], y[1]), pk2(y[2], y[3])}; }
        }
        {
            const int c = lane * 4;
            f32x4 o = *(const f32x4*)(OC + (size_t)row * 256 + c);
            if (row < MP && (row & (SEQ - 1)) >= 128) o = o + *(const f32x4*)(OC2 + (size_t)row * 256 + c);
            const float mean = red16((o[0] + o[1]) + (o[2] + o[3])) * (1.f / 64.f); const f32x4 d = o - mean;
            const float var = red16((d[0] * d[0] + d[1] * d[1]) + (d[2] * d[2] + d[3] * d[3])) * (1.f / 64.f); const float rstd = rsqrtf(var + LN_EPS);
            const f32x4 gg = *(const f32x4*)(rgg + c), gb = *(const f32x4*)(rgb + c);
            const u32x2 gu = *(const u32x2*)(H + (size_t)row * IN_COLS + COL_GC + c);
            const f32x4 gc = (f32x4){bfw(gu.x, 0), bfw(gu.x, 1), bfw(gu.y, 0), bfw(gu.y, 1)};
            f32x4 y = d * rstd * gg + gb;
#pragma unroll
            for (int e = 0; e < 4; ++e) y[e] = y[e] * gc[e] * fsig(gc[e]);
            *(u32x2*)(mx + 2 * WA + c) = (u32x2){pk2(y[0], y[1]), pk2(y[2], y[3])};
        }
    }
}

__device__ __forceinline__ void ln_phase(Frame& F, const float* V, const float* gw, const float* bw, float* outP, float* outS, bf16* ob) {
    const int lane = F.lane;
    for (int row = F.bid * NWAVES + F.wave; row < MV; row += F.G * NWAVES) {
        const GAS f32x4* xr = (const GAS f32x4*)(V + (size_t)row * DM) + lane;
        f32x4 v[4]; float s = 0.f;
#pragma unroll
        for (int j = 0; j < 4; ++j) { v[j] = xr[64 * j]; s += (v[j].x + v[j].y) + (v[j].z + v[j].w); }
        const float mean = wave_sum(s) * (1.f / DM); float s2 = 0.f;
#pragma unroll
        for (int j = 0; j < 4; ++j) { v[j] = v[j] - mean; s2 += (v[j].x * v[j].x + v[j].y * v[j].y) + (v[j].z * v[j].z + v[j].w * v[j].w); }
        const float rstd = rsqrtf(wave_sum(s2) * (1.f / DM) + LN_EPS);
        float* orow = row < MP ? outP + (size_t)row * DM : outS + (size_t)(row - MP) * DM;
#pragma unroll
        for (int j = 0; j < 4; ++j) {
            const f32x4 gg = ((const f32x4*)gw)[lane + 64 * j], bb = ((const f32x4*)bw)[lane + 64 * j];
            const f32x4 y = v[j] * rstd * gg + bb;
            ((GAS f32x4*)orow)[lane + 64 * j] = y;
            if (ob) ((GAS unsigned long long*)(ob + (size_t)row * DM))[lane + 64 * j] = (unsigned long long)pk2(y.x, y.y) | ((unsigned long long)pk2(y.z, y.w) << 32);
        }
    }
}

struct Args { const float* in[29]; float* out; unsigned char* ws; int ph_lo, ph_hi; };
static_assert(sizeof(Args) == 29 * 8 + 8 + 8 + 8, "Args has no padding");
__global__ void __launch_bounds__(NTHR, 2) mk_fwd(Args args) {
    extern __shared__ __attribute__((aligned(16))) unsigned char lds[];
    Frame F;
    F.lds = (LAS unsigned char*)lds; F.MISC = (volatile LAS unsigned*)(F.lds + MISC_OFF);
    F.tid = threadIdx.x; F.lane = F.tid & 63; F.wave = __builtin_amdgcn_readfirstlane(F.tid >> 6); F.G = gridDim.x; F.bid = blockIdx.x;
    F.out = args.out; F.ws = args.ws; F.ctl = (gu32*)(args.ws + WS_CTL);
    for (int u = F.tid; u < (LDS_BYTES - LDSCTL_OFF) / 4; u += NTHR) ((LAS unsigned*)(F.lds + LDSCTL_OFF))[u] = 0u;
    __syncthreads();
    if (F.tid < 29) ((LAS unsigned long long*)(F.lds + INTAB_OFF))[F.tid] = (unsigned long long)args.in[F.tid];
    __syncthreads();
    const bool multi = args.ph_hi - args.ph_lo > 1;
    XcdBarrier bar; bar.bar = (unsigned*)(F.ctl + CW_BAR); bar.x = 0; bar.st = nullptr;
    if (multi) bar = xcd_barrier_post((unsigned*)(F.ctl + CW_BAR), F.MISC + 8);
    for (int ph = args.ph_lo; ph < args.ph_hi; ++ph) {
#ifndef PHM
#define PHM 0x3ff
#endif
#ifndef DBL
#define DBL 0
#endif
        const int nrep_ = (DBL != 0 && ((ph == 0) ? ((DBL >> 9) & 1) : ((DBL >> ((ph - 1) % NST)) & 1))) ? 2 : 1;
        for (int rep_ = 0; rep_ < nrep_; ++rep_) {
        { unsigned char* wsl = args.ws; float* outl = args.out; asm volatile("" : "+s"(wsl), "+s"(outl)); F.ws = wsl; F.out = outl;
          int tl = threadIdx.x; asm volatile("" : "+v"(tl)); F.tid = tl; F.lane = tl & 63; F.wave = __builtin_amdgcn_readfirstlane(tl >> 6); F.rep = rep_; }
        if (rep_) { XcdBarrier b2 = bar; unsigned* bb = bar.bar; unsigned xx = bar.x; asm volatile("" : "+s"(bb), "+s"(xx)); b2.bar = bb; b2.x = xx; xcd_barrier(b2); }
        if (ph == 0) { if (PHM & 1) p0_prologue(F); }
        else {
            const int l = (ph - 1) / NST, st = (ph - 1) % NST;
            unsigned char* wb = F.ws + WS_W + (size_t)l * LW;
            if (st == 0 && (PHM & 2)) {
                pg8::Gemm g{(const bf16*)(F.ws + WS_XB), (const bf16*)(wb + W_IN), MT, IN_COLS, DM}; pg8::StaticOrder S; S.init(MT, IN_COLS, F.G, F.bid);
                pg8::EpiHRot E{(bf16*)(F.ws + WS_H), IN_COLS, (const float*)(F.ws + WS_TAB)};
                pg8::gemm_phase<pg8::EpiHRot, pg8::StaticOrder, true, true>(F.lds, g, S, E);
            } else if (st == 1) { if (PHM & 4) pa_phase(F, l); }
            else if (st == 2) { if (PHM & 8) mixers_phase(F, l); }
            else if (st == 3) { if (PHM & 16) post_phase(F, l); }
            else if (st == 4) { if (PHM & 32) {
                pg8::Gemm g{(const bf16*)(F.ws + WS_MIX), (const bf16*)(wb + W_OUT), MT, DM, DM}; pg8::StaticOrder S; S.init(MT, DM, F.G, F.bid);
                const float* bP = l == 0 ? inp(F, 0) : (const float*)(F.ws + WS_XF); const float* bS = l == 0 ? inp(F, 1) : (const float*)(F.ws + WS_XF) + (size_t)MP * DM;
                pg8::EpiResF32 E{bP, bS, (float*)(F.ws + WS_V), DN_ALPHA, MP, MV};
                pg8::gemm_phase<pg8::EpiResF32, pg8::StaticOrder, true, true>(F.lds, g, S, E); copy_tail(F, l, l * 4 + 2, 0, 128); }
            } else if (st == 5) ln_phase(F, (const float*)(F.ws + WS_V), inp(F, 22) + l * DM, inp(F, 23) + l * DM, (float*)(F.ws + WS_X1F), (float*)(F.ws + WS_X1F) + (size_t)MP * DM, (bf16*)(F.ws + WS_X1B));
            else if (st == 6) { if (PHM & 64) {
                pg8::Gemm g{(const bf16*)(F.ws + WS_X1B), (const bf16*)(wb + W_GU), MT, NGU, DM}; pg8::StaticOrder S; S.init(MT, NGU, F.G, F.bid);
                pg8::EpiSwiglu E{(bf16*)(F.ws + WS_HFF), DFF};
                pg8::gemm_phase<pg8::EpiSwiglu, pg8::StaticOrder, true, true>(F.lds, g, S, E); }
            } else if (st == 7) { if (PHM & 128) {
                pg8::Gemm g{(const bf16*)(F.ws + WS_HFF), (const bf16*)(wb + W_D), MT, DM, DFF}; pg8::StaticOrder S; S.init(MT, DM, F.G, F.bid);
                pg8::EpiResF32 E{(const float*)(F.ws + WS_X1F), (const float*)(F.ws + WS_X1F) + (size_t)MP * DM, (float*)(F.ws + WS_V), DN_ALPHA, MP, MV};
                pg8::gemm_phase<pg8::EpiResF32, pg8::StaticOrder, true, true>(F.lds, g, S, E); copy_tail(F, l, l * 4 + 3, 128, 512); }
            } else {
                if (l == 0) ln_phase(F, (const float*)(F.ws + WS_V), inp(F, 27) + l * DM, inp(F, 28) + l * DM, (float*)(F.ws + WS_XF), (float*)(F.ws + WS_XF) + (size_t)MP * DM, (bf16*)(F.ws + WS_XB));
                else ln_phase(F, (const float*)(F.ws + WS_V), inp(F, 27) + l * DM, inp(F, 28) + l * DM, F.out + O_YP, F.out + O_YS, nullptr);
            }
        }
        }
        if (ph + 1 < args.ph_hi) { XcdBarrier b2 = bar; unsigned* bb = bar.bar; unsigned xx = bar.x; asm volatile("" : "+s"(bb), "+s"(xx)); b2.bar = bb; b2.x = xx; xcd_barrier(b2); }
    }
}

#ifndef MK_SPLIT
#define MK_SPLIT 0
#endif
extern "C" void kernel_launch(void* const* d_in, const int* in_sizes, int n_in, void* d_out, int out_size, void* d_ws, size_t ws_size, hipStream_t stream) {
    static int grid = 0;
    if (grid == 0) {
        if (n_in != 29 || out_size != (int)O_END || ws_size < WS_END) { fprintf(stderr, "kernel_launch: unexpected shapes (n_in %d out %d ws %zu)\n", n_in, out_size, ws_size); grid = -1; return; }
        int dev = 0, cus = 0, per_cu = 0;
        if (hipGetDevice(&dev) != hipSuccess || hipDeviceGetAttribute(&cus, hipDeviceAttributeMultiprocessorCount, dev) != hipSuccess) { grid = -1; return; }
        if (hipFuncSetAttribute((const void*)mk_fwd, hipFuncAttributeMaxDynamicSharedMemorySize, LDS_BYTES) != hipSuccess) { fprintf(stderr, "kernel_launch: hipFuncSetAttribute failed\n"); grid = -1; return; }
        if (hipOccupancyMaxActiveBlocksPerMultiprocessor(&per_cu, (const void*)mk_fwd, NTHR, LDS_BYTES) != hipSuccess || per_cu < 1) { fprintf(stderr, "kernel_launch: occupancy query says %d blocks per CU\n", per_cu); (void)hipGetLastError(); grid = -1; return; }
        grid = cus;
        if (grid != 256) { fprintf(stderr, "kernel_launch: built for 256 CUs, device has %d\n", cus); grid = -1; return; }
    }
    if (grid < 0) return;
    (void)hipMemsetAsync((char*)d_ws + WS_CTL, 0, CTL_ZERO_BYTES, stream);
    Args a{};
    for (int i = 0; i < 29; ++i) a.in[i] = (const float*)d_in[i];
    a.out = (float*)d_out; a.ws = (unsigned char*)d_ws;
#if MK_SPLIT
    for (int ph = 0; ph < NPHASE; ++ph) { a.ph_lo = ph; a.ph_hi = ph + 1; hipLaunchKernelGGL(mk_fwd, dim3(grid), dim3(NTHR), LDS_BYTES, stream, a); }
#else
    a.ph_lo = 0; a.ph_hi = NPHASE; hipLaunchKernelGGL(mk_fwd, dim3(grid), dim3(NTHR), LDS_BYTES, stream, a);
#endif
}
```

```cpp
#include <hip/hip_runtime.h>
#include <cstdio>
#include <cstdint>
namespace pg8 {
#define PG8_LAS __attribute__((address_space(3)))
typedef unsigned short bf16_t;
typedef short bf16x8 __attribute__((ext_vector_type(8)));
typedef float f32x4 __attribute__((ext_vector_type(4)));
typedef unsigned u32x4 __attribute__((ext_vector_type(4)));
constexpr int BM = 256, BK = 64, HALF = 128, HTB = HALF * BK * 2  , STAGE_BYTES = 8 * HTB, NXCD = 8, WGM = 8;

__host__ __device__ __forceinline__ int lds_byte(int r, int c) { const int st = (r >> 4) * 2 + (c >> 5), rr = r & 15, cc = c & 31, ob = rr * 64 + cc * 2; return st * 1024 + (ob ^ (((ob >> 9) & 1) << 5)); }
__host__ __device__ __forceinline__ void stage_rc(int b, int& R, int& C) { const int st = b / 1024, sb = b % 1024, swz = sb ^ (((sb >> 9) & 1) << 5); R = (st >> 1) * 16 + swz / 64; C = (st & 1) * 32 + (swz % 64) / 2; }
__host__ __device__ __forceinline__ int perm32(int rho) { const int n = rho >> 4, i = rho & 15; return 8 * (i >> 2) + 4 * n + (i & 3); }

struct Unit { int pm, pn; };
struct Gemm { const bf16_t* A; const bf16_t* Bt; int M, N, K; };

struct StaticOrder {
    int nM, nN, nwg, G, c;
    __host__ __device__ void init(int M, int N, int G_, int c_) { nM = M / BM; nN = N / BM; nwg = nM * nN; G = G_; c = c_; }
    __host__ __device__ bool next(int i, Unit& u) const {
        const long L = (long)i * G + c; if (L >= nwg) return false;
        int wgid = (int)L; { const int q = nwg / NXCD, r = nwg % NXCD, xcd = wgid % NXCD, off = wgid / NXCD; wgid = (xcd < r ? xcd * (q + 1) : r * (q + 1) + (xcd - r) * q) + off; }
        const int nig = WGM * nN, gid = wgid / nig, fm = gid * WGM, gsz = (nM - fm) < WGM ? (nM - fm) : WGM;
        u.pm = fm + ((wgid % nig) % gsz); u.pn = (wgid % nig) / gsz; return true;
    }
    __device__ __forceinline__ void a_ready(const Unit&) const {}
    __device__ __forceinline__ void done(const Unit&) const {}
};

__device__ __forceinline__ unsigned cvt_pk_bf16(float lo, float hi) { unsigned r; asm volatile("v_cvt_pk_bf16_f32 %0, %1, %2" : "=v"(r) : "v"(lo), "v"(hi)); return r; }
typedef float f32x2 __attribute__((ext_vector_type(2)));

struct EpiH {
    static constexpr bool PERM = true, AFTER_DRAIN = false;
    bf16_t* O; int ldc;
    __device__ __forceinline__ void operator()(const f32x4 (&acc)[2][2][4][2], const Unit& u, int wr, int wc, int fr, int fq) const {
        const int row0 = u.pm * BM + wr * 64 + fr, col0 = u.pn * BM + wc * 32 + 8 * fq;
#pragma unroll
        for (int ai = 0; ai < 2; ++ai)
#pragma unroll
            for (int m = 0; m < 4; ++m) { bf16_t* rowp = O + (size_t)(row0 + ai * HALF + m * 16) * ldc + col0;
#pragma unroll
                for (int bj = 0; bj < 2; ++bj) { const f32x4 v0 = acc[ai][bj][m][0], v1 = acc[ai][bj][m][1];
                    u32x4 w; w.x = cvt_pk_bf16(v0[0], v0[1]); w.y = cvt_pk_bf16(v0[2], v0[3]); w.z = cvt_pk_bf16(v1[0], v1[1]); w.w = cvt_pk_bf16(v1[2], v1[3]);
                    *(u32x4*)(rowp + bj * HALF) = w; } }
    }
};
__device__ __forceinline__ float silu_f(float x) { return x * __builtin_amdgcn_rcpf(1.0f + __builtin_amdgcn_exp2f(-1.4426950408889634f * x)); }
struct EpiSwiglu {
    static constexpr bool PERM = true, AFTER_DRAIN = false;
    bf16_t* O; int ldc;
    __device__ __forceinline__ void operator()(const f32x4 (&acc)[2][2][4][2], const Unit& u, int wr, int wc, int fr, int fq) const {
        const int row0 = u.pm * BM + wr * 64 + fr, col0 = u.pn * HALF + wc * 32 + 8 * fq;
#pragma unroll
        for (int ai = 0; ai < 2; ++ai)
#pragma unroll
            for (int m = 0; m < 4; ++m) { bf16_t* rowp = O + (size_t)(row0 + ai * HALF + m * 16) * ldc + col0;
                const f32x4 g0 = acc[ai][0][m][0], g1 = acc[ai][0][m][1], u0 = acc[ai][1][m][0], u1 = acc[ai][1][m][1];
                u32x4 w; w.x = cvt_pk_bf16(silu_f(g0[0]) * u0[0], silu_f(g0[1]) * u0[1]); w.y = cvt_pk_bf16(silu_f(g0[2]) * u0[2], silu_f(g0[3]) * u0[3]);
                w.z = cvt_pk_bf16(silu_f(g1[0]) * u1[0], silu_f(g1[1]) * u1[1]); w.w = cvt_pk_bf16(silu_f(g1[2]) * u1[2], silu_f(g1[3]) * u1[3]);
                *(u32x4*)rowp = w; }
    }
};
struct EpiResF32 {
    static constexpr bool PERM = false, AFTER_DRAIN = false;
    const float* baseP; const float* baseS; float* V; float alpha; int mp, mv;
    __device__ __forceinline__ void operator()(const f32x4 (&acc)[2][2][4][2], const Unit& u, int wr, int wc, int fr, int fq) const {
        const int row0 = u.pm * BM + wr * 64 + fr, col0 = u.pn * BM + wc * 32 + 4 * fq;
#pragma unroll
        for (int ai = 0; ai < 2; ++ai)
#pragma unroll
            for (int m = 0; m < 4; ++m) { const int row = row0 + ai * HALF + m * 16;
                if (row < mv) { const float* bp = (row < mp ? baseP + (size_t)row * 1024 : baseS + (size_t)(row - mp) * 1024) + col0; float* vp = V + (size_t)row * 1024 + col0;
#pragma unroll
                    for (int bj = 0; bj < 2; ++bj)
#pragma unroll
                        for (int n = 0; n < 2; ++n) { const f32x4 b = *(const f32x4*)(bp + bj * HALF + n * 16); *(f32x4*)(vp + bj * HALF + n * 16) = b * alpha + acc[ai][bj][m][n]; } } }
    }
};
template <class Epi, class Sched, bool ALIGN_EPI = false, bool SP2 = false>
__device__ __forceinline__ void gemm_phase(PG8_LAS unsigned char* lds, const Gemm g, const Sched& S, const Epi& E) {
    int tid_ = threadIdx.x; asm volatile("" : "+v"(tid_));
    const int tid = tid_, wid = __builtin_amdgcn_readfirstlane(tid >> 6), lane = tid & 63, wr = wid >> 2, wc = wid & 3, fr = lane & 15, fq = lane >> 4;
    const int K = g.K, nt = K / BK;
    unsigned voffA[2], voffB[2];
#pragma unroll
    for (int i = 0; i < 2; ++i) { int R, C; stage_rc(tid * 16 + i * 8192, R, C); const int Rb = Epi::PERM ? ((R & ~31) + perm32(R & 31)) : R;
        voffA[i] = (unsigned)(R * K + C) * 2u; voffB[i] = (unsigned)(Rb * K + C) * 2u; }
    const size_t kstep = (size_t)(BK * 2);
    const size_t hstep = (size_t)HALF * K * 2;
    const size_t tstep = 2 * hstep;
    const unsigned ldsw = (unsigned)wid * 1024u;
    const int aoff = lds_byte(wr * 64 + fr, fq * 8), boff = lds_byte(wc * 32 + fr, fq * 8);
#define PG8_SA(b, h) (((b) * 2 + (h)) * HTB)
#define PG8_SB(b, h) ((4 + (b) * 2 + (h)) * HTB)
#define PG8_STAGE(bufoff, gbase, voff) do { _Pragma("unroll") for (int _i = 0; _i < 2; ++_i) \
        __builtin_amdgcn_global_load_lds((const unsigned*)((const char*)(gbase) + (voff)[_i]), (PG8_LAS unsigned*)(lds + (bufoff) + ldsw + _i * 8192), 16, 0, 0); } while (0)
#define PG8_LDA(dst, b, h) do { _Pragma("unroll") for (int m = 0; m < 4; ++m) _Pragma("unroll") for (int k = 0; k < 2; ++k) dst[m][k] = *(const PG8_LAS bf16x8*)(lds + PG8_SA(b, h) + aoff + m * 2048 + k * 1024); } while (0)
#define PG8_LDB(dst, b, h) do { _Pragma("unroll") for (int n = 0; n < 2; ++n) _Pragma("unroll") for (int k = 0; k < 2; ++k) dst[n][k] = *(const PG8_LAS bf16x8*)(lds + PG8_SB(b, h) + boff + n * 2048 + k * 1024); } while (0)
#define PG8_MMA(ai, bj, At, Bt) do { __builtin_amdgcn_s_setprio(1); _Pragma("unroll") for (int m = 0; m < 4; ++m) _Pragma("unroll") for (int n = 0; n < 2; ++n) _Pragma("unroll") for (int k = 0; k < 2; ++k) \
        acc[ai][bj][m][n] = __builtin_amdgcn_mfma_f32_16x16x32_bf16(Bt[n][k], At[m][k], acc[ai][bj][m][n], 0, 0, 0); __builtin_amdgcn_s_setprio(0); } while (0)
#define PG8_WAIT_V(n) asm volatile("s_waitcnt vmcnt(" #n ")" ::: "memory")
#define PG8_WAIT_L(n) asm volatile("s_waitcnt lgkmcnt(" #n ")" ::: "memory")
#define PG8_BAR __builtin_amdgcn_s_barrier()
#define PG8_SCHED __builtin_amdgcn_sched_barrier(0)
    Unit cur, nxt; int ui = 0;
    if (!S.next(0, cur)) return;
    f32x4 acc[2][2][4][2];
#pragma unroll
    for (int a = 0; a < 2; ++a)
#pragma unroll
        for (int b = 0; b < 2; ++b)
#pragma unroll
            for (int m = 0; m < 4; ++m)
#pragma unroll
                for (int n = 0; n < 2; ++n) acc[a][b][m][n] = (f32x4){0.f, 0.f, 0.f, 0.f};
    bf16x8 At[4][2], B0[2][2], B1[2][2];
    const char* cA = (const char*)g.A + (size_t)cur.pm * tstep; const char* cB = (const char*)g.Bt + (size_t)cur.pn * tstep;
    S.a_ready(cur);
    if constexpr (SP2) {
        PG8_STAGE(PG8_SB(0, 0), cB, voffB); PG8_STAGE(PG8_SB(0, 1), cB + hstep, voffB); PG8_STAGE(PG8_SA(0, 0), cA, voffA); PG8_STAGE(PG8_SA(0, 1), cA + hstep, voffA);
        if (wr == 1) PG8_BAR;
        PG8_WAIT_V(2); PG8_BAR;
        PG8_STAGE(PG8_SB(1, 0), cB + kstep, voffB); PG8_STAGE(PG8_SA(1, 0), cA + kstep, voffA); PG8_STAGE(PG8_SB(1, 1), cB + hstep + kstep, voffB);
        PG8_WAIT_V(6); PG8_BAR;
    } else {
        PG8_STAGE(PG8_SB(0, 0), cB, voffB); PG8_STAGE(PG8_SA(0, 0), cA, voffA); PG8_STAGE(PG8_SB(0, 1), cB + hstep, voffB); PG8_STAGE(PG8_SA(0, 1), cA + hstep, voffA);
        if (wr == 1) PG8_BAR;
        PG8_WAIT_V(4); PG8_BAR;
        PG8_STAGE(PG8_SB(1, 0), cB + kstep, voffB); PG8_STAGE(PG8_SA(1, 0), cA + kstep, voffA); PG8_STAGE(PG8_SB(1, 1), cB + hstep + kstep, voffB);
        PG8_WAIT_V(6); PG8_BAR;
    }
    for (;;) {
        const bool has_next = S.next(ui + 1, nxt);
        const char* nA = has_next ? (const char*)g.A + (size_t)nxt.pm * tstep : cA; const char* nB = has_next ? (const char*)g.Bt + (size_t)nxt.pn * tstep : cB;
        for (int t = 0; t < nt; t += 2) {
            const bool last = (t == nt - 2);
            const char* a1 = cA + (size_t)(t + 1) * kstep;
            const char* a2 = last ? nA : cA + (size_t)(t + 2) * kstep; const char* b2 = last ? nB : cB + (size_t)(t + 2) * kstep;
            const char* a3 = a2 + kstep; const char* b3 = b2 + kstep;
            if (last && has_next) S.a_ready(nxt);
            if constexpr (SP2) {
            PG8_LDB(B0, 0, 0); PG8_LDB(B1, 0, 1); PG8_SCHED; PG8_LDA(At, 0, 0); PG8_STAGE(PG8_SA(1, 1), a1 + hstep, voffA);
            PG8_WAIT_V(8); PG8_WAIT_L(0); PG8_BAR; PG8_MMA(0, 0, At, B0); PG8_MMA(0, 1, At, B1); PG8_BAR; PG8_SCHED;
            PG8_LDA(At, 0, 1); PG8_STAGE(PG8_SB(0, 0), b2, voffB); PG8_STAGE(PG8_SB(0, 1), b2 + hstep, voffB); PG8_STAGE(PG8_SA(0, 0), a2, voffA);
            PG8_WAIT_V(8); PG8_WAIT_L(0); PG8_BAR; PG8_MMA(1, 0, At, B0); PG8_MMA(1, 1, At, B1); PG8_BAR; PG8_SCHED;
            PG8_LDB(B0, 1, 0); PG8_LDB(B1, 1, 1); PG8_SCHED; PG8_LDA(At, 1, 0); PG8_STAGE(PG8_SA(0, 1), a2 + hstep, voffA);
            PG8_WAIT_V(8); PG8_WAIT_L(0); PG8_BAR; PG8_MMA(0, 0, At, B0); PG8_MMA(0, 1, At, B1); PG8_BAR; PG8_SCHED;
            PG8_LDA(At, 1, 1); PG8_STAGE(PG8_SB(1, 0), b3, voffB); PG8_STAGE(PG8_SB(1, 1), b3 + hstep, voffB); PG8_STAGE(PG8_SA(1, 0), a3, voffA);
            PG8_WAIT_V(8); PG8_WAIT_L(0); PG8_BAR; PG8_MMA(1, 0, At, B0); PG8_MMA(1, 1, At, B1); PG8_BAR; PG8_SCHED;
            } else {
            PG8_LDB(B0, 0, 0); PG8_SCHED; PG8_LDA(At, 0, 0); PG8_STAGE(PG8_SA(1, 1), a1 + hstep, voffA);
            PG8_WAIT_L(8); PG8_BAR; PG8_WAIT_L(0); PG8_MMA(0, 0, At, B0); PG8_BAR; PG8_SCHED;
            PG8_LDB(B1, 0, 1); PG8_STAGE(PG8_SB(0, 0), b2, voffB);
            PG8_BAR; PG8_WAIT_L(0); PG8_MMA(0, 1, At, B1); PG8_BAR;
            PG8_LDA(At, 0, 1); PG8_STAGE(PG8_SA(0, 0), a2, voffA);
            PG8_BAR; PG8_WAIT_L(0); PG8_MMA(1, 0, At, B0); PG8_BAR; PG8_SCHED;
            PG8_STAGE(PG8_SB(0, 1), b2 + hstep, voffB);
            PG8_WAIT_V(6); PG8_BAR; PG8_MMA(1, 1, At, B1); PG8_BAR;
            PG8_LDB(B0, 1, 0); PG8_SCHED; PG8_LDA(At, 1, 0); PG8_STAGE(PG8_SA(0, 1), a2 + hstep, voffA);
            PG8_WAIT_L(8); PG8_BAR; PG8_WAIT_L(0); PG8_MMA(0, 0, At, B0); PG8_BAR; PG8_SCHED;
            PG8_LDB(B1, 1, 1); PG8_STAGE(PG8_SB(1, 0), b3, voffB);
            PG8_BAR; PG8_WAIT_L(0); PG8_MMA(0, 1, At, B1); PG8_BAR;
            PG8_LDA(At, 1, 1); PG8_STAGE(PG8_SA(1, 0), a3, voffA);
            PG8_BAR; PG8_WAIT_L(0); PG8_MMA(1, 0, At, B0); PG8_BAR; PG8_SCHED;
            PG8_STAGE(PG8_SB(1, 1), b3 + hstep, voffB);
            PG8_WAIT_V(6); PG8_BAR; PG8_MMA(1, 1, At, B1); PG8_BAR;
            }
        }
        if constexpr (ALIGN_EPI) { if (wr == 0) PG8_BAR; }
        if constexpr (!Epi::AFTER_DRAIN) { E(acc, cur, wr, wc, fr, fq); S.done(cur); }
        if (!has_next) break;
#pragma unroll
        for (int a = 0; a < 2; ++a)
#pragma unroll
            for (int b = 0; b < 2; ++b)
#pragma unroll
                for (int m = 0; m < 4; ++m)
#pragma unroll
                    for (int n = 0; n < 2; ++n) acc[a][b][m][n] = (f32x4){0.f, 0.f, 0.f, 0.f};
        cur = nxt; cA = nA; cB = nB; ++ui;
        if constexpr (ALIGN_EPI) { if (wr == 1) PG8_BAR; }
    }
    PG8_WAIT_V(0);
    if constexpr (!ALIGN_EPI) { if (wr == 0) PG8_BAR; }
    PG8_BAR;
    if constexpr (Epi::AFTER_DRAIN) { E.fused(acc, cur, wr, wc, fr, fq, lds, wid, lane); S.done(cur); }
#undef PG8_SA
#undef PG8_SB
#undef PG8_STAGE
#undef PG8_LDA
#undef PG8_LDB
#undef PG8_MMA
#undef PG8_WAIT_V
#undef PG8_WAIT_L
#undef PG8_BAR
#undef PG8_SCHED
}
}
#define GAS __attribute__((address_space(1)))
#define LAS __attribute__((address_space(3)))
typedef unsigned short bf16;
typedef unsigned v4u __attribute__((ext_vector_type(4)));
typedef float f32x4 __attribute__((ext_vector_type(4)));
typedef short bf16x8 __attribute__((ext_vector_type(8)));
typedef GAS unsigned gu32;
typedef GAS unsigned long long gu64;
#define RLX_AGENT __ATOMIC_RELAXED, __HIP_MEMORY_SCOPE_AGENT
#define LDS_WAIT() asm volatile("s_waitcnt lgkmcnt(0)" ::: "memory")
#define VM_WAIT() asm volatile("s_waitcnt vmcnt(0)" ::: "memory")
__device__ __forceinline__ unsigned long long rt() { return __builtin_amdgcn_s_memrealtime(); }

typedef float f32x2_t __attribute__((ext_vector_type(2))); typedef __bf16 bf16x2_t __attribute__((ext_vector_type(2)));
__device__ __forceinline__ unsigned pk2(float lo, float hi) { f32x2_t v = {lo, hi}; bf16x2_t b = __builtin_convertvector(v, bf16x2_t); return __builtin_bit_cast(unsigned, b); }
__device__ __forceinline__ unsigned f2bf(float f) { return pk2(f, f) & 0xffffu; }
#define XB_TMO      128
#define XB_XCNT(j)  (256  + 64 * (j))
#define XB_XSUB(j)  (1280 + 64 * (j))
#define XB_XGEN(j)  (2304 + 64 * (j))
#define XB_TOP      3328
#define XB_TOPGEN   3392
#define XCD_BAR_WORDS 3456
#define XB_SPIN_CAP (1u << 18)

__device__ __forceinline__ unsigned xb_ld(unsigned* p)              { return __hip_atomic_load(p, __ATOMIC_RELAXED, __HIP_MEMORY_SCOPE_AGENT); }
__device__ __forceinline__ unsigned xb_add(unsigned* p, unsigned v) { return __hip_atomic_fetch_add(p, v, __ATOMIC_RELAXED, __HIP_MEMORY_SCOPE_AGENT); }
__device__ __forceinline__ unsigned xb_xcc_id() { return (unsigned)__builtin_amdgcn_s_getreg((3 << 11) | 20) & 0xFu; }
#define XB_SPIN(cond, bar) do { unsigned _sp = 0; while (cond) { __builtin_amdgcn_s_sleep(1); \
    if ((++_sp & 255u) == 0u) { if (xb_ld(&(bar)[XB_TMO])) break; if (_sp > XB_SPIN_CAP) { atomicAdd(&(bar)[XB_TMO], 1u); break; } } } } while (0)

struct XcdBarrier {
    unsigned* bar; unsigned x;
    volatile LAS unsigned* st;
};

__device__ __forceinline__ XcdBarrier xcd_barrier_post(unsigned* bar, volatile LAS unsigned* st) {
    XcdBarrier b; b.bar = bar; b.x = xb_xcc_id(); b.st = st;
    if (threadIdx.x == 0) (void)xb_add(&bar[XB_XCNT(b.x)], 1u);
    return b;
}
__device__ __forceinline__ void xcd_barrier_complete(unsigned* bar, unsigned x, unsigned& nloc, unsigned& nx) {
    const unsigned G = gridDim.x * gridDim.y * gridDim.z;
    unsigned sum, cnt, mine, sp = 0u;
    for (;;) {
        sum = 0u; cnt = 0u; mine = 0u;
#pragma unroll
        for (unsigned j = 0; j < 16; ++j) { const unsigned c = xb_ld(&bar[XB_XCNT(j)]); sum += c; cnt += (c > 0u) ? 1u : 0u; mine = (j == x) ? c : mine; }
        if (sum == G) break;
        __builtin_amdgcn_s_sleep(1);
        if ((++sp & 255u) == 0u) { if (xb_ld(&bar[XB_TMO])) break; if (sp > XB_SPIN_CAP) { atomicAdd(&bar[XB_TMO], 1u); break; } }
    }
    nloc = mine > 0u ? mine : 1u; nx = cnt > 0u ? cnt : 1u;
}

__device__ __forceinline__ void xcd_barrier(const XcdBarrier& b) {
    asm volatile("s_waitcnt vmcnt(0)" ::: "memory");
    __syncthreads();
    if (threadIdx.x == 0) {
        unsigned* bar = b.bar;
        __builtin_amdgcn_s_waitcnt(0);
        unsigned nloc = b.st[0], nx = b.st[1];
        if (nloc == 0u) { xcd_barrier_complete(bar, b.x, nloc, nx); b.st[0] = nloc; b.st[1] = nx; }
        const unsigned old = xb_add(&bar[XB_XSUB(b.x)], 1u);
        const unsigned gen = old / nloc;
        if (old + 1u == (gen + 1u) * nloc) {
            __builtin_amdgcn_fence(__ATOMIC_RELEASE, "agent");
            asm volatile("s_waitcnt vmcnt(0)" ::: "memory");
            const unsigned og = xb_add(&bar[XB_TOP], 1u);
            const unsigned tg = og / nx;
            if (og + 1u == (tg + 1u) * nx) xb_add(&bar[XB_TOPGEN], 1u);
            else XB_SPIN(xb_ld(&bar[XB_TOPGEN]) == tg, bar);
            __builtin_amdgcn_fence(__ATOMIC_ACQUIRE, "agent");
            xb_add(&bar[XB_XGEN(b.x)], 1u);
            asm volatile("s_waitcnt vmcnt(0)" ::: "memory");
        } else {
            XB_SPIN(xb_ld(&bar[XB_XGEN(b.x)]) == gen, bar);
            __builtin_amdgcn_fence(__ATOMIC_ACQUIRE, "agent");
            asm volatile("s_waitcnt vmcnt(0)" ::: "memory");
        }
    }
    __syncthreads();
}

constexpr int DM = 1024, SEQ = 4096, NBP = 4, MP = NBP * SEQ, NBS = 32, TS = 4, MS = NBS * TS, MV = MP + MS, MT = 65 * 256;
constexpr int IN_COLS = 3584, A_COLS = 1408, WA = 384, DFF = 2816, NGU = 2 * DFF, WBUF = 2048;
constexpr int COL_QB = 1408, COL_KB = 1792, COL_VB = 2176, COL_QC = 2560, COL_KC = 2816, COL_VC = 3072, COL_GC = 3328;
constexpr float DN_ALPHA = 1.4142135623730951f;
constexpr float LN_EPS = 1e-5f, GN_EPS_A = 64e-5f, DECAY_SCALE = 0.6065306597126334f;
constexpr int NPOS = SEQ + TS;
constexpr size_t O_YP = 0, O_YS = O_YP + (size_t)MP * DM, O_PSHIFT = O_YS + (size_t)MS * DM, O_PWKV = O_PSHIFT + 2 * NBP * A_COLS, O_PWINK = O_PWKV + 2 * NBP * 6 * 4096,
                 O_PWINV = O_PWINK + (size_t)2 * NBP * WBUF * 384, O_PRET = O_PWINV + (size_t)2 * NBP * WBUF * 384, O_SSHIFT = O_PRET + 2 * NBP * 4 * 4096,
                 O_SWKV = O_SSHIFT + 2 * NBS * A_COLS, O_SWINK = O_SWKV + 2 * NBS * 6 * 4096, O_SWINV = O_SWINK + (size_t)2 * NBS * WBUF * 384,
                 O_SRET = O_SWINV + (size_t)2 * NBS * WBUF * 384, O_END = O_SRET + 2 * NBS * 4 * 4096;
static_assert(O_END == 133204992, "output size");
constexpr size_t MiB = 1u << 20;
constexpr size_t WS_CTL = 0, CTL_ZERO_BYTES = 1 * MiB, WS_TAB = 1 * MiB, WS_W = 4 * MiB, LW = 26 * MiB;
constexpr size_t W_IN = 0, W_OUT = W_IN + (size_t)IN_COLS * DM * 2, W_GU = W_OUT + (size_t)DM * DM * 2, W_D = W_GU + (size_t)NGU * DM * 2, W_WL = W_D + (size_t)DM * DFF * 2,
                 W_AL = W_WL + (size_t)WA * 64 * 2, W_GL = W_AL + (size_t)WA * 64 * 2, W_LEND = W_GL + (size_t)WA * 128 * 2;
static_assert(W_LEND <= LW, "weights");
constexpr size_t WS_XB = 56 * MiB, WS_XF = 89 * MiB, WS_X1F = 154 * MiB, WS_X1B = 219 * MiB, WS_MIX = 252 * MiB, WS_G = 285 * MiB, WS_T0 = 310 * MiB;
constexpr size_t WS_H = WS_T0, WS_CK = 424 * MiB, WS_VX = 496 * MiB, WS_SC = 521 * MiB, WS_KV = 523 * MiB, WS_OC2 = 532 * MiB, WS_ZF = 550 * MiB, WS_OA = 571 * MiB, WS_OB = 596 * MiB, WS_LSE = 670 * MiB, WS_OC = 672 * MiB, WS_RK = 689 * MiB, WS_END = 690 * MiB;
constexpr size_t WS_V = WS_T0, WS_HFF = 375 * MiB;
static_assert(WS_H + (size_t)MT * IN_COLS * 2 <= WS_CK && WS_CK + (size_t)1536 * 49152 <= WS_VX && WS_VX + (size_t)MT * 384 * 4 <= WS_SC && WS_SC + (size_t)MS * 2304 * 4 <= WS_OA && WS_OB + (size_t)3 * MT * 384 * 4 <= WS_LSE && WS_OC + (size_t)MT * 256 * 4 <= WS_RK, "ws map");
static_assert(WS_V + (size_t)MT * DM * 4 <= WS_HFF && WS_HFF + (size_t)MT * DFF * 2 <= WS_END && WS_XF + (size_t)MT * DM * 4 <= WS_X1F && WS_G + (size_t)MT * 384 * 4 <= WS_T0, "ws map 2");
constexpr int TAB_COSB = 0, TAB_SINB = NPOS * 8, TAB_COSC = NPOS * 16, TAB_SINC = NPOS * 48, TAB_END = NPOS * 80;
constexpr int CW_BAR = 4096, CW_Q = 8192;
constexpr int RING_BYTES = 147456, LDSCTL_OFF = RING_BYTES, MISC_OFF = LDSCTL_OFF + 320, INTAB_OFF = LDSCTL_OFF + 1024, LDS_BYTES = RING_BYTES + 2048;
constexpr int NWAVES = 8, NTHR = 512;
constexpr int NST = 9, NPHASE = 1 + 2 * NST;

struct Frame {
    LAS unsigned char* lds; volatile LAS unsigned* MISC; gu32* ctl;
    int tid, lane, wave, G, bid, rep;
    float* out; unsigned char* ws; const float* const* inb; unsigned zoff;
};
__device__ __forceinline__ const float* inp(const Frame& F, int k) { return F.inb[k + F.zoff]; }
__device__ __forceinline__ float bf2f(bf16 v) { return __uint_as_float((unsigned)v << 16); }
__device__ __forceinline__ float wave_sum(float v) {
#pragma unroll
    for (int o = 1; o < 64; o <<= 1) v += __shfl_xor(v, o);
    return v;
}
__device__ __forceinline__ float wave_max(float v) {
#pragma unroll
    for (int o = 1; o < 64; o <<= 1) v = fmaxf(v, __shfl_xor(v, o));
    return v;
}
__device__ __forceinline__ float dpp_f(float x, const int ctrl_sel) {
    const int xi = __float_as_int(x); int r;
    if (ctrl_sel == 0) r = __builtin_amdgcn_update_dpp(xi, xi, 0xB1, 0xF, 0xF, false);
    else if (ctrl_sel == 1) r = __builtin_amdgcn_update_dpp(xi, xi, 0x4E, 0xF, 0xF, false);
    else if (ctrl_sel == 2) r = __builtin_amdgcn_update_dpp(xi, xi, 0x141, 0xF, 0xF, false);
    else r = __builtin_amdgcn_update_dpp(xi, xi, 0x140, 0xF, 0xF, false);
    return __int_as_float(r);
}
__device__ __forceinline__ float red16(float x) { x += dpp_f(x, 0); x += dpp_f(x, 1); x += dpp_f(x, 2); x += dpp_f(x, 3); return x; }
__device__ __forceinline__ float sigmoid_f(float x) { return 1.0f / (1.0f + __expf(-x)); }

__host__ __device__ __forceinline__ int phys_col(int c) {
    if (c >= COL_QB && c < COL_VB) { int d = c & 63; if (d < 16) d = d < 8 ? 2 * d : 2 * (d - 8) + 1; return (c & ~63) + d; }
    if (c >= COL_QC && c < COL_VC) { int d = c & 63; d = d < 32 ? 2 * d : 2 * (d - 32) + 1; return (c & ~63) + d; }
    return c;
}
__host__ __device__ __forceinline__ int dimB(int p) { return p < 16 ? (p >> 1) + 8 * (p & 1) : p; }
__host__ __device__ __forceinline__ int dimC(int p) { return (p >> 1) + 32 * (p & 1); }
template <bool PERMUTE>
__device__ __forceinline__ void p0_transpose_item(const float* W, int K, int N, bf16* WT, int k0, int n0, int drow0, LAS float* scr, int lane) {
#pragma unroll 8
    for (int i = 0; i < 32; ++i) { const int kk = 2 * i + (lane >> 5); scr[kk * 33 + (lane & 31)] = W[(size_t)(k0 + kk) * N + n0 + (lane & 31)]; }
    LDS_WAIT(); asm volatile("" ::: "memory");
    const int c = lane & 7;
#pragma unroll
    for (int j = 0; j < 4; ++j) { const int n = (lane >> 3) + 8 * j; const LAS float* s = scr + (8 * c) * 33 + n;
        v4u o; o.x = pk2(s[0 * 33], s[1 * 33]); o.y = pk2(s[2 * 33], s[3 * 33]); o.z = pk2(s[4 * 33], s[5 * 33]); o.w = pk2(s[6 * 33], s[7 * 33]);
        *(GAS v4u*)(WT + (size_t)(PERMUTE ? phys_col(n0 + n) : drow0 + n) * K + k0 + 8 * c) = o; }
    LDS_WAIT(); asm volatile("" ::: "memory");
}
__device__ __forceinline__ void p0_prologue(Frame& F) {
    LAS float* scr = (LAS float*)(F.lds + F.wave * 16384);
    const int gw = F.bid * NWAVES + F.wave, NGW = F.G * NWAVES;
    constexpr int I_IN = 16 * (IN_COLS / 32), I_OUT = 16 * (DM / 32), I_G = 16 * (DFF / 32), I_D = (DFF / 64) * (DM / 32), I_L = I_IN + I_OUT + 2 * I_G + I_D;
    for (int it = gw; it < 2 * I_L; it += NGW) {
        const int l = it / I_L; int r = it % I_L; bf16* wb = (bf16*)(F.ws + WS_W + (size_t)l * LW);
        if (r < I_IN) { const int nblk = IN_COLS / 32, kb = r / nblk, nb = r % nblk; p0_transpose_item<true>(inp(F, 7) + (size_t)l * DM * IN_COLS, DM, IN_COLS, (bf16*)((char*)wb + W_IN), 64 * kb, 32 * nb, 32 * nb, scr, F.lane); continue; } r -= I_IN;
        if (r < I_OUT) { const int nblk = DM / 32, kb = r / nblk, nb = r % nblk; p0_transpose_item<false>(inp(F, 21) + (size_t)l * DM * DM, DM, DM, (bf16*)((char*)wb + W_OUT), 64 * kb, 32 * nb, 32 * nb, scr, F.lane); continue; } r -= I_OUT;
        if (r < 2 * I_G) { const int up = r >= I_G; if (up) r -= I_G; const int nblk = DFF / 32, kb = r / nblk, nb = r % nblk, n0 = 32 * nb;
            p0_transpose_item<false>((up ? inp(F, 25) : inp(F, 24)) + (size_t)l * DM * DFF, DM, DFF, (bf16*)((char*)wb + W_GU), 64 * kb, n0, (n0 >> 7) * 256 + (n0 & 127) + (up ? 128 : 0), scr, F.lane); continue; } r -= 2 * I_G;
        { const int nblk = DM / 32, kb = r / nblk, nb = r % nblk; p0_transpose_item<false>(inp(F, 26) + (size_t)l * DFF * DM, DFF, DM, (bf16*)((char*)wb + W_D), 64 * kb, 32 * nb, 32 * nb, scr, F.lane); }
    }
    bf16* XB = (bf16*)(F.ws + WS_XB); bf16* MIX = (bf16*)(F.ws + WS_MIX); bf16* X1B = (bf16*)(F.ws + WS_X1B); bf16* HFF = (bf16*)(F.ws + WS_HFF);
    for (int m = gw; m < MT; m += NGW) {
        GAS unsigned long long* o8 = (GAS unsigned long long*)(XB + (size_t)m * DM) + F.lane;
        if (m < MV) { const float* src = m < MP ? inp(F, 0) + (size_t)m * DM : inp(F, 1) + (size_t)(m - MP) * DM; const GAS f32x4* xr = (const GAS f32x4*)src + F.lane;
#pragma unroll
            for (int j = 0; j < 4; ++j) { const f32x4 v = xr[64 * j]; o8[64 * j] = (unsigned long long)pk2(v.x, v.y) | ((unsigned long long)pk2(v.z, v.w) << 32); }
        } else {
#pragma unroll
            for (int j = 0; j < 4; ++j) { o8[64 * j] = 0ull; ((GAS unsigned long long*)(MIX + (size_t)m * DM) + F.lane)[64 * j] = 0ull; ((GAS unsigned long long*)(X1B + (size_t)m * DM) + F.lane)[64 * j] = 0ull; }
            for (int j = F.lane; j < DFF / 4; j += 64) ((GAS unsigned long long*)(HFF + (size_t)m * DFF))[j] = 0ull;
        }
    }
    for (int e = F.bid * NTHR + F.tid; e < 2 * WA * 256; e += F.G * NTHR) {
        const int l = e / (WA * 256), r = e % (WA * 256), n = r >> 8, k = r & 255; unsigned char* wb = F.ws + WS_W + (size_t)l * LW;
        if (k < 64) ((bf16*)(wb + W_WL))[n * 64 + k] = (bf16)f2bf(inp(F, 10)[((size_t)l * 64 + k) * WA + n]);
        else if (k < 128) ((bf16*)(wb + W_AL))[n * 64 + (k - 64)] = (bf16)f2bf(inp(F, 12)[((size_t)l * 64 + (k - 64)) * WA + n]);
        else ((bf16*)(wb + W_GL))[n * 128 + (k - 128)] = (bf16)f2bf(inp(F, 13)[((size_t)l * 128 + (k - 128)) * WA + n]);
    }
    float* tab = (float*)(F.ws + WS_TAB);
    for (int e = F.bid * NTHR + F.tid; e < NPOS * 40; e += F.G * NTHR) {
        const int idx = e / 40, j = e % 40; const float pos = (float)(idx < SEQ ? idx : 8192 + (idx - SEQ));
        if (j < 8) { const float inv = powf(500000.0f, -(float)(2 * j) / 16.0f); const float ang = pos * inv; tab[TAB_COSB + idx * 8 + j] = cosf(ang); tab[TAB_SINB + idx * 8 + j] = sinf(ang); }
        else { const int jj = j - 8; const float inv = 1.0f / powf(10000.0f, (float)jj / 31.0f); const float ang = pos * inv; tab[TAB_COSC + idx * 32 + jj] = cosf(ang); tab[TAB_SINC + idx * 32 + jj] = sinf(ang); }
    }
}


namespace pg8 {
struct EpiHRot {
    static constexpr bool PERM = true, AFTER_DRAIN = false;
    bf16_t* O; int ldc; const float* tab;
    __device__ __forceinline__ void operator()(const f32x4 (&acc)[2][2][4][2], const Unit& u, int wr, int wc, int fr, int fq) const {
        const int row0 = u.pm * BM + wr * 64 + fr;
#pragma unroll
        for (int bj = 0; bj < 2; ++bj) {
            const int cb = u.pn * BM + bj * HALF + wc * 32;
            const int mode = (cb >= COL_QB && cb < COL_VB && (cb & 63) == 0) ? 1 : ((cb >= COL_QC && cb < COL_VC) ? 2 : 0);
            const float scale = (cb >= COL_KC && cb < COL_VC) ? 0.125f : 1.0f;
            const bool rot = mode == 2 || (mode == 1 && fq < 2);
            const int toff = mode == 1 ? 4 * fq : 16 * ((cb >> 5) & 1) + 4 * fq;
#pragma unroll
            for (int ai = 0; ai < 2; ++ai)
#pragma unroll
                for (int m = 0; m < 4; ++m) {
                    const int row = row0 + ai * HALF + m * 16;
                    f32x4 v0 = acc[ai][bj][m][0], v1 = acc[ai][bj][m][1];
                    if (mode != 0) {
                        if (rot) {
                            const int posidx = row < MP ? (row & (SEQ - 1)) : (row < MV ? SEQ + ((row - MP) & 3) : 0);
                            const f32x4 cs = *(const f32x4*)(tab + (mode == 1 ? TAB_COSB + posidx * 8 : TAB_COSC + posidx * 32) + toff);
                            const f32x4 sn = *(const f32x4*)(tab + (mode == 1 ? TAB_SINB + posidx * 8 : TAB_SINC + posidx * 32) + toff);
                            const f32x4 a = v0, b = v1;
                            v0[0] = a[0] * cs[0] - a[1] * sn[0]; v0[1] = a[1] * cs[0] + a[0] * sn[0]; v0[2] = a[2] * cs[1] - a[3] * sn[1]; v0[3] = a[3] * cs[1] + a[2] * sn[1];
                            v1[0] = b[0] * cs[2] - b[1] * sn[2]; v1[1] = b[1] * cs[2] + b[0] * sn[2]; v1[2] = b[2] * cs[3] - b[3] * sn[3]; v1[3] = b[3] * cs[3] + b[2] * sn[3];
                        }
                        v0 = v0 * scale; v1 = v1 * scale;
                    }
                    u32x4 w; w.x = cvt_pk_bf16(v0[0], v0[1]); w.y = cvt_pk_bf16(v0[2], v0[3]); w.z = cvt_pk_bf16(v1[0], v1[1]); w.w = cvt_pk_bf16(v1[2], v1[3]);
                    *(u32x4*)(O + (size_t)row * ldc + cb + 8 * fq) = w;
                }
        }
    }
};
}

__device__ __forceinline__ f32x4 mfma16(bf16x8 a, bf16x8 b, f32x4 c) { return __builtin_amdgcn_mfma_f32_16x16x32_bf16(a, b, c, 0, 0, 0); }

__device__ __forceinline__ void scan_item(Frame& F, const float* SC, float* OA, int scrow0, int rowbase, int T, int h, int half, const float* S0, float* Sout) {
    constexpr int CH = 32;
    LAS float* buf = (LAS float*)F.lds;
    LAS float* vbuf = buf + 2 * CH * 320;
    int tid = F.tid; asm volatile("" : "+v"(tid));
    const int lane = tid & 63, w = F.wave, rg = lane >> 4, j = lane & 15;
    const int vrow = half * 32 + w * 4 + rg;
    float S[4];
    if (S0) { const f32x4 s = *(const f32x4*)(S0 + vrow * 64 + 4 * j); S[0] = s[0]; S[1] = s[1]; S[2] = s[2]; S[3] = s[3]; } else { S[0] = S[1] = S[2] = S[3] = 0.f; }
    const int nch = (T + CH - 1) / CH;
    f32x4 st[5]; float sv[2];
    int sstep[5], soff[5], ldso[5];
#pragma unroll
    for (int i = 0; i < 5; ++i) { const int idx = tid + NTHR * i, step = idx / 80, rem = idx % 80, v5 = rem >> 4, q = rem & 15; const int vid = v5 < 3 ? v5 : v5 + 1;
        sstep[i] = step; soff[i] = vid * 64 + q * 4; ldso[i] = step * 320 + v5 * 64 + q * 4; }
    const int vstep0 = tid >> 5, vr = tid & 31;
#define SCAN_ISSUE(c) do { _Pragma("unroll") for (int i = 0; i < 5; ++i) { const int t = (c) * CH + sstep[i]; st[i] = t < T ? *(const f32x4*)(SC + ((size_t)(scrow0 + t) * 6 + h) * 384 + soff[i]) : (f32x4){0.f, 0.f, 0.f, 0.f}; } \
        _Pragma("unroll") for (int i = 0; i < 2; ++i) { const int t = (c) * CH + vstep0 + 16 * i; sv[i] = t < T ? SC[((size_t)(scrow0 + t) * 6 + h) * 384 + 192 + half * 32 + vr] : 0.f; } } while (0)
#define SCAN_WRITE(bs) do { _Pragma("unroll") for (int i = 0; i < 5; ++i) *(LAS f32x4*)(buf + (bs) * CH * 320 + ldso[i]) = st[i]; \
        _Pragma("unroll") for (int i = 0; i < 2; ++i) vbuf[(bs) * CH * 32 + (vstep0 + 16 * i) * 32 + vr] = sv[i]; } while (0)
    SCAN_ISSUE(0); SCAN_WRITE(0);
    __syncthreads();
    for (int c = 0; c < nch; ++c) {
        const int bs = c & 1;
        if (c + 1 < nch) SCAN_ISSUE(c + 1);
        const int ns = (T - c * CH) < CH ? (T - c * CH) : CH;
        const LAS float* bp = buf + bs * CH * 320 + 4 * j; const LAS float* vp = vbuf + bs * CH * 32 + w * 4 + rg;
        for (int s = 0; s < ns; ++s) {
            const f32x4 r4 = *(const LAS f32x4*)(bp + s * 320), w4 = *(const LAS f32x4*)(bp + s * 320 + 64), k4 = *(const LAS f32x4*)(bp + s * 320 + 128),
                        kk4 = *(const LAS f32x4*)(bp + s * 320 + 192), b4 = *(const LAS f32x4*)(bp + s * 320 + 256);
            const float vv = vp[s * 32];
            float sa = (S[0] * kk4[0] + S[1] * kk4[1]) + (S[2] * kk4[2] + S[3] * kk4[3]);
            sa = red16(sa);
#pragma unroll
            for (int e = 0; e < 4; ++e) S[e] = S[e] * w4[e] + (vv * k4[e] - sa * b4[e]);
            float o = (S[0] * r4[0] + S[1] * r4[1]) + (S[2] * r4[2] + S[3] * r4[3]);
            o = red16(o);
            if (j == 0) OA[(size_t)(rowbase + c * CH + s) * WA + h * 64 + vrow] = o;
        }
        if (c + 1 < nch) SCAN_WRITE(bs ^ 1);
        __syncthreads();
    }
#undef SCAN_ISSUE
#undef SCAN_WRITE
    *(f32x4*)(Sout + vrow * 64 + 4 * j) = (f32x4){S[0], S[1], S[2], S[3]};
}

__device__ __forceinline__ void attn_unit(Frame& F, const bf16* H, float* OB, float* LSE, int unit) {
    const int cls = unit & 31, di = (unit >> 5) % 3, bh = unit / 96, h = bh % 6, b = bh / 6;
    const int d = di == 0 ? 1 : (di == 1 ? 4 : 16), nbk = 32 / d, r = cls / nbk, n = cls % nbk;
    LAS bf16* Kl = (LAS bf16*)F.lds;
    LAS bf16* VT = Kl + 256 * 72;
    int tid = F.tid; asm volatile("" : "+v"(tid));
    const int lane = tid & 63, w = F.wave, g = lane >> 4, lq = lane & 15;
#pragma unroll
    for (int i = 0; i < 4; ++i) {
        const int cid = tid + NTHR * i, ki = cid >> 3, ch = cid & 7, ci = (n - 1) * 128 + ki;
        v4u kv = (v4u){0u, 0u, 0u, 0u}, vv = kv;
        if (ci >= 0) { const size_t row = (size_t)b * SEQ + (size_t)ci * d + r; kv = *(const v4u*)(H + row * IN_COLS + COL_KB + h * 64 + ch * 8); vv = *(const v4u*)(H + row * IN_COLS + COL_VB + h * 64 + ch * 8); }
        *(LAS v4u*)(Kl + ki * 72 + ch * 8) = kv;
        LAS bf16* vt = VT + (ch * 8) * 264 + ki;
        vt[0 * 264] = (bf16)(vv.x & 0xffffu); vt[1 * 264] = (bf16)(vv.x >> 16); vt[2 * 264] = (bf16)(vv.y & 0xffffu); vt[3 * 264] = (bf16)(vv.y >> 16);
        vt[4 * 264] = (bf16)(vv.z & 0xffffu); vt[5 * 264] = (bf16)(vv.z >> 16); vt[6 * 264] = (bf16)(vv.w & 0xffffu); vt[7 * 264] = (bf16)(vv.w >> 16);
    }
    __syncthreads();
    const int qi = 16 * w + lq;
    const size_t qrow = (size_t)b * SEQ + (size_t)(n * 128 + qi) * d + r;
    bf16x8 qf[2];
    qf[0] = *(const bf16x8*)(H + qrow * IN_COLS + COL_QB + h * 64 + 8 * g); qf[1] = *(const bf16x8*)(H + qrow * IN_COLS + COL_QB + h * 64 + 32 + 8 * g);
    f32x4 s[10];
#pragma unroll
    for (int tt = 0; tt < 9; ++tt) {
        const int kt = w + tt; s[tt] = (f32x4){0.f, 0.f, 0.f, 0.f};
#pragma unroll
        for (int ks = 0; ks < 2; ++ks) { const bf16x8 a = *(const LAS bf16x8*)(Kl + (kt * 16 + lq) * 72 + 32 * ks + 8 * g); s[tt] = mfma16(a, qf[ks], s[tt]); }
    }
    s[9] = (f32x4){0.f, 0.f, 0.f, 0.f};
    float m = -1e30f;
#pragma unroll
    for (int tt = 0; tt < 9; ++tt)
#pragma unroll
        for (int e = 0; e < 4; ++e) { const int ki = (w + tt) * 16 + 4 * g + e; const bool ok = ki >= qi && ki <= qi + 128 && (n > 0 || ki >= 128);
            const float sv = ok ? s[tt][e] * 0.125f : -1e30f; s[tt][e] = sv; m = fmaxf(m, sv); }
    m = fmaxf(m, __shfl_xor(m, 16)); m = fmaxf(m, __shfl_xor(m, 32));
    float lsum = 0.f;
#pragma unroll
    for (int tt = 0; tt < 9; ++tt)
#pragma unroll
        for (int e = 0; e < 4; ++e) { const float p = s[tt][e] > -1e29f ? __expf(s[tt][e] - m) : 0.f; s[tt][e] = p; lsum += p; }
    lsum += __shfl_xor(lsum, 16); lsum += __shfl_xor(lsum, 32);
    f32x4 o[4];
#pragma unroll
    for (int dt = 0; dt < 4; ++dt) o[dt] = (f32x4){0.f, 0.f, 0.f, 0.f};
#pragma unroll
    for (int pp = 0; pp < 5; ++pp) {
        const int T0 = 2 * pp, T1 = 2 * pp + 1;
        union { unsigned u[4]; bf16x8 v; } pb;
        pb.u[0] = pk2(s[T0][0], s[T0][1]); pb.u[1] = pk2(s[T0][2], s[T0][3]); pb.u[2] = pk2(s[T1][0], s[T1][1]); pb.u[3] = pk2(s[T1][2], s[T1][3]);
        const int k0 = (w + T0) * 16 + 4 * g, k1 = (w + (T1 < 9 ? T1 : T0)) * 16 + 4 * g;
#pragma unroll
        for (int dt = 0; dt < 4; ++dt) {
            union { unsigned long long q[2]; bf16x8 v; } av;
            av.q[0] = *(const LAS unsigned long long*)(VT + (dt * 16 + lq) * 264 + k0); av.q[1] = *(const LAS unsigned long long*)(VT + (dt * 16 + lq) * 264 + k1);
            o[dt] = mfma16(av.v, pb.v, o[dt]);
        }
    }
    const float inv = 1.0f / lsum;
    float* op = OB + ((size_t)di * MT + qrow) * 384 + h * 64 + 4 * g;
#pragma unroll
    for (int dt = 0; dt < 4; ++dt) *(f32x4*)(op + dt * 16) = o[dt] * inv;
    if (g == 0) LSE[((size_t)di * MT + qrow) * 6 + h] = m + __logf(lsum);
    __syncthreads();
}

__device__ __forceinline__ void copy_item(Frame& F, int l, int item) {
    const int which = item >> 8, b = (item >> 3) & 31, part = item & 7;
    constexpr int N4 = (WBUF - TS) * 384 / 4, P4 = N4 / 8;
    static_assert(N4 % 8 == 0, "copy split");
    const f32x4* src = (const f32x4*)((which ? inp(F, 5) : inp(F, 4)) + (((size_t)l * NBS + b) * WBUF + TS) * 384) + (size_t)part * P4;
    f32x4* dst = (f32x4*)(F.out + (which ? O_SWINV : O_SWINK) + ((size_t)l * NBS + b) * WBUF * 384) + (size_t)part * P4;
    int tid = F.tid; asm volatile("" : "+v"(tid));
    for (int base = tid; base < P4; base += NTHR * 8) {
        f32x4 v[8];
#pragma unroll
        for (int k = 0; k < 8; ++k) { const int i = base + NTHR * k; v[k] = __builtin_nontemporal_load(src + (i < P4 ? i : tid)); }
#pragma unroll
        for (int k = 0; k < 8; ++k) { const int i = base + NTHR * k; if (i < P4) __builtin_nontemporal_store(v[k], dst + i); }
    }
}


constexpr int CK_BYTES = 49152;
constexpr int CK_M = 0, CK_Q = 8192, CK_N = 16384, CK_O = 32768;
constexpr int MS_ = 72;
constexpr int L_XL = 0, L_KKD = 33792, L_RD = L_KKD + 9216, L_KDI = L_RD + 9216, L_BDI = L_KDI + 9216, L_KDET = L_BDI + 9216, L_BDET = L_KDET + 9216, L_VT = L_BDET + 9216,
              L_AUB = L_VT + 9216, L_AUK = L_AUB + 9216, L_AOK = L_AUK + 9216, L_AOB = L_AOK + 9216, L_DG = L_AOB + 9216, L_DI = L_DG + 4 * 16 * 17 * 4, L_TT = L_DI + 4 * 16 * 24 * 2,
              L_LC = L_TT + 1024, L_SS = L_LC + 256, L_END5 = L_SS + 1024;
constexpr int L_UT = L_KDI, L_KT = L_BDI;
constexpr int L_MQ = L_AUB;
static_assert(L_XL + 64 * 264 * 2 <= L_KKD && L_END5 <= RING_BYTES && (L_DI % 16) == 0 && (L_DG % 16) == 0, "rwkv item LDS map");
#define LBAR() asm volatile("s_waitcnt lgkmcnt(0)\n\ts_barrier" ::: "memory")

typedef unsigned u32x2 __attribute__((ext_vector_type(2)));
__device__ __forceinline__ float dpp_shr(float x, const int n) {
    const int xi = __float_as_int(x); int r;
    if (n == 1) r = __builtin_amdgcn_update_dpp(0, xi, 0x111, 0xF, 0xF, true);
    else if (n == 2) r = __builtin_amdgcn_update_dpp(0, xi, 0x112, 0xF, 0xF, true);
    else if (n == 4) r = __builtin_amdgcn_update_dpp(0, xi, 0x114, 0xF, 0xF, true);
    else r = __builtin_amdgcn_update_dpp(0, xi, 0x118, 0xF, 0xF, true);
    return __int_as_float(r);
}
__device__ __forceinline__ float bfw(unsigned w, int e) { return __uint_as_float((e & 1) ? (w & 0xffff0000u) : (w << 16)); }
__device__ __forceinline__ float fsig(float x) { return __builtin_amdgcn_rcpf(1.0f + __builtin_amdgcn_exp2f(-1.4426950408889634f * x)); }
__device__ __forceinline__ float ftanh(float x) { return 1.0f - 2.0f * __builtin_amdgcn_rcpf(1.0f + __builtin_amdgcn_exp2f(2.8853900817779268f * x)); }
__device__ __forceinline__ float fexp(float x) { return __builtin_amdgcn_exp2f(1.4426950408889634f * x); }

__device__ __forceinline__ void rwkv_item(Frame& F, int l, int tile) {
    int tid = F.tid; asm volatile("" : "+v"(tid));
    const int w = F.wave;
    const bool isS = tile >= 256;
    const int R0 = isS ? MP + (tile - 256) * 64 : tile * 64;
    const bf16* H = (const bf16*)(F.ws + WS_H);
    const unsigned char* wb = F.ws + WS_W + (size_t)l * LW;
    const float* mu = inp(F, 8) + l * A_COLS;
    LAS unsigned char* lds = F.lds;
    {
        const int tok = tid >> 3, cg = tid & 7, row = R0 + tok, col0 = 1152 + cg * 32;
        const bf16* hc = H + (size_t)row * IN_COLS + col0;
        bool zero_prev = false; const float* sp = nullptr;
        if (!isS) zero_prev = (row & (SEQ - 1)) == 0; else if (((row - MP) & 3) == 0) sp = inp(F, 2) + ((size_t)l * NBS + ((row - MP) >> 2)) * A_COLS + col0;
        v4u cu[4], pu[4];
#pragma unroll
        for (int q = 0; q < 4; ++q) { cu[q] = *(const v4u*)(hc + q * 8); pu[q] = (v4u){0u, 0u, 0u, 0u}; if (!zero_prev && !sp) pu[q] = *(const v4u*)(hc - IN_COLS + q * 8); }
#pragma unroll
        for (int q = 0; q < 4; ++q) {
            const unsigned cw[4] = {cu[q].x, cu[q].y, cu[q].z, cu[q].w}, pw[4] = {pu[q].x, pu[q].y, pu[q].z, pu[q].w};
            const f32x4 m0 = *(const f32x4*)(mu + col0 + q * 8), m1 = *(const f32x4*)(mu + col0 + q * 8 + 4);
            float xo[8];
#pragma unroll
            for (int e = 0; e < 8; ++e) {
                const float c = bfw(cw[e >> 1], e & 1); float p = bfw(pw[e >> 1], e & 1);
                if (sp) p = sp[q * 8 + e];
                float x = c + (p - c) * (e < 4 ? m0[e & 3] : m1[e & 3]);
                if (cg < 2) x = ftanh(x); else if (cg >= 4) x = fsig(x);
                xo[e] = x;
            }
            v4u o; o.x = pk2(xo[0], xo[1]); o.y = pk2(xo[2], xo[3]); o.z = pk2(xo[4], xo[5]); o.w = pk2(xo[6], xo[7]);
            *(LAS v4u*)(lds + L_XL + (tok * 264 + cg * 32 + q * 8) * 2) = o;
        }
    }
    LBAR();
    const int mt = w & 3, cth = w >> 2;
    const bf16* WlT = (const bf16*)(wb + W_WL); const bf16* AlT = (const bf16*)(wb + W_AL); const bf16* GlT = (const bf16*)(wb + W_GL);
    const float* w0 = inp(F, 9) + l * WA; const float* a0 = inp(F, 11) + l * WA; const float* kkw = inp(F, 14) + l * WA; const float* kaw = inp(F, 15) + l * WA; const float* rkw = inp(F, 16) + l * WA;
  for (int h = 0; h < 6; ++h) {
    int tidh = tid; asm volatile("" : "+v"(tidh));
    const int lane = tidh & 63, g = lane >> 4, lq = lane & 15, tk = mt * 16 + lq, row = R0 + tk;
    bool zero_prev = false; const float* sp = nullptr;
    if (!isS) zero_prev = (row & (SEQ - 1)) == 0; else if (((row - MP) & 3) == 0) sp = inp(F, 2) + ((size_t)l * NBS + ((row - MP) >> 2)) * A_COLS;
    float lwv[8], L[8], xr[8], k2[8], kk[8], bb[8];
    {
        f32x4 dw[2], da[2], dg[2];
#pragma unroll
        for (int cl = 0; cl < 2; ++cl) { const int ct = 2 * cth + cl; dw[cl] = (f32x4){0.f, 0.f, 0.f, 0.f}; da[cl] = dw[cl]; dg[cl] = dw[cl];
#pragma unroll
            for (int ks = 0; ks < 2; ++ks) {
                const bf16x8 a1 = *(const bf16x8*)(WlT + (size_t)(h * 64 + ct * 16 + lq) * 64 + 32 * ks + 8 * g), a2 = *(const bf16x8*)(AlT + (size_t)(h * 64 + ct * 16 + lq) * 64 + 32 * ks + 8 * g);
                const bf16x8 b1 = *(const LAS bf16x8*)(lds + L_XL + (tk * 264 + 32 * ks + 8 * g) * 2), b2 = *(const LAS bf16x8*)(lds + L_XL + (tk * 264 + 64 + 32 * ks + 8 * g) * 2);
                dw[cl] = mfma16(a1, b1, dw[cl]); da[cl] = mfma16(a2, b2, da[cl]); }
#pragma unroll
            for (int ks = 0; ks < 4; ++ks) { const bf16x8 a = *(const bf16x8*)(GlT + (size_t)(h * 64 + ct * 16 + lq) * 128 + 32 * ks + 8 * g);
                const bf16x8 b = *(const LAS bf16x8*)(lds + L_XL + (tk * 264 + 128 + 32 * ks + 8 * g) * 2); dg[cl] = mfma16(a, b, dg[cl]); } }
        float* gp = (float*)(F.ws + WS_G) + (size_t)row * WA + h * 64 + cth * 32 + 4 * g;
#pragma unroll
        for (int cl = 0; cl < 2; ++cl) *(f32x4*)(gp + cl * 16) = dg[cl];
        float ssum = 0.f, rksum = 0.f; float xv[8];
#pragma unroll
        for (int cl = 0; cl < 2; ++cl) {
            const int c16 = (2 * cth + cl) * 16 + 4 * g, ch = h * 64 + c16;
            float xs[3][4];
#pragma unroll
            for (int part = 0; part < 3; ++part) {
                const bf16* hp = H + (size_t)row * IN_COLS + part * WA + ch;
                const u32x2 cu = *(const u32x2*)hp; u32x2 pu = (u32x2){0u, 0u};
                if (!zero_prev && !sp) pu = *(const u32x2*)(hp - IN_COLS);
                const f32x4 m4 = *(const f32x4*)(mu + part * WA + ch);
                const unsigned cw[2] = {cu.x, cu.y}, pw[2] = {pu.x, pu.y};
#pragma unroll
                for (int e = 0; e < 4; ++e) {
                    const float c = bfw(cw[e >> 1], e & 1); float p = bfw(pw[e >> 1], e & 1);
                    if (sp) p = sp[part * WA + ch + e];
                    xs[part][e] = c + (p - c) * m4[e];
                }
            }
            const f32x4 w04 = *(const f32x4*)(w0 + ch), a04 = *(const f32x4*)(a0 + ch), kk4 = *(const f32x4*)(kkw + ch), ka4 = *(const f32x4*)(kaw + ch), rk4 = *(const f32x4*)(rkw + ch);
#pragma unroll
            for (int e = 0; e < 4; ++e) {
                const int i = cl * 4 + e;
                const float a = fsig(a04[e] + da[cl][e]);
                lwv[i] = -DECAY_SCALE * fsig(w04[e] + dw[cl][e]);
                xr[i] = xs[0][e]; xv[i] = xs[2][e];
                const float kq = xs[1][e] * kk4[e]; kk[i] = kq; ssum += kq * kq;
                k2[i] = xs[1][e] * (1.0f + (a - 1.0f) * ka4[e]);
                bb[i] = a;
                rksum += xr[i] * k2[i] * rk4[e];
                if (!isS) *(LAS bf16*)(lds + L_VT + ((c16 + e) * MS_ + tk) * 2) = (bf16)f2bf(xv[i]);
            }
        }
        ssum += __shfl_xor(ssum, 16); ssum += __shfl_xor(ssum, 32); rksum += __shfl_xor(rksum, 16); rksum += __shfl_xor(rksum, 32);
        if (g == 0) { *(LAS float*)(lds + L_SS + (tk * 4 + cth * 2) * 4) = ssum; *(LAS float*)(lds + L_SS + (tk * 4 + cth * 2 + 1) * 4) = rksum; }
        float* vx = (float*)(F.ws + WS_VX) + (size_t)row * WA + h * 64 + cth * 32 + 4 * g;
#pragma unroll
        for (int cl = 0; cl < 2; ++cl) *(f32x4*)(vx + cl * 16) = (f32x4){xv[cl * 4], xv[cl * 4 + 1], xv[cl * 4 + 2], xv[cl * 4 + 3]};
        if (isS) {
            float* sc = (float*)(F.ws + WS_SC) + ((size_t)(row - MP) * 6 + h) * 384 + cth * 32 + 4 * g;
#pragma unroll
            for (int cl = 0; cl < 2; ++cl) *(f32x4*)(sc + 192 + cl * 16) = (f32x4){xv[cl * 4], xv[cl * 4 + 1], xv[cl * 4 + 2], xv[cl * 4 + 3]};
        } else {
#pragma unroll
            for (int i = 0; i < 8; ++i) { float s = lwv[i];
                s += dpp_shr(s, 1); s += dpp_shr(s, 2); s += dpp_shr(s, 4); s += dpp_shr(s, 8); L[i] = s;
                if (lq == 15) *(LAS float*)(lds + L_TT + (mt * 64 + (2 * cth + (i >> 2)) * 16 + 4 * g + (i & 3)) * 4) = s; }
        }
    }
    LBAR();
    {
        const LAS float* ss = (const LAS float*)(lds + L_SS) + tk * 4;
        const float kn = rsqrtf(fmaxf(ss[0] + ss[2], 1e-12f));
#pragma unroll
        for (int i = 0; i < 8; ++i) { kk[i] *= kn; bb[i] *= kk[i]; }
        if (cth == 0 && g == 0) ((float*)(F.ws + WS_RK))[row * 6 + h] = ss[1] + ss[3];
    }
    if (isS) {
        float* sc = (float*)(F.ws + WS_SC) + ((size_t)(row - MP) * 6 + h) * 384 + cth * 32 + 4 * g;
#pragma unroll
        for (int cl = 0; cl < 2; ++cl) { const int i = cl * 4;
            *(f32x4*)(sc + cl * 16) = (f32x4){xr[i], xr[i + 1], xr[i + 2], xr[i + 3]};
            *(f32x4*)(sc + 64 + cl * 16) = (f32x4){fexp(lwv[i]), fexp(lwv[i + 1]), fexp(lwv[i + 2]), fexp(lwv[i + 3])};
            *(f32x4*)(sc + 128 + cl * 16) = (f32x4){k2[i], k2[i + 1], k2[i + 2], k2[i + 3]};
            *(f32x4*)(sc + 256 + cl * 16) = (f32x4){kk[i], kk[i + 1], kk[i + 2], kk[i + 3]};
            *(f32x4*)(sc + 320 + cl * 16) = (f32x4){bb[i], bb[i + 1], bb[i + 2], bb[i + 3]}; }
        LBAR();
        continue;
    }
#pragma unroll
    for (int cl = 0; cl < 2; ++cl) {
        float v_kkd[4], v_rd[4], v_kdi[4], v_bdi[4];
#pragma unroll
        for (int e = 0; e < 4; ++e) {
            const int i = cl * 4 + e, c16 = (2 * cth + cl) * 16 + 4 * g + e;
            const LAS float* tt = (const LAS float*)(lds + L_TT) + c16;
            const float t0 = tt[0], t1 = tt[64], t2 = tt[128], t3 = tt[192];
            const float off = (mt > 0 ? t0 : 0.f) + (mt > 1 ? t1 : 0.f) + (mt > 2 ? t2 : 0.f), LC = (t0 + t1) + (t2 + t3);
            const float Lt = L[i] + off, Lp = Lt - lwv[i];
            const float eL = fexp(Lt), eLp = fexp(Lp), eN = fexp(-Lt), eC = fexp(LC - Lt);
            v_kkd[e] = kk[i] * eLp; v_rd[e] = xr[i] * eL; v_kdi[e] = k2[i] * eN; v_bdi[e] = bb[i] * eN;
            *(LAS bf16*)(lds + L_KDET + (c16 * MS_ + tk) * 2) = (bf16)f2bf(k2[i] * eC);
            *(LAS bf16*)(lds + L_BDET + (c16 * MS_ + tk) * 2) = (bf16)f2bf(bb[i] * eC);
            if (mt == 0 && lq == 0) *(LAS float*)(lds + L_LC + c16 * 4) = fexp(LC);
        }
        const int o2 = (tk * MS_ + (2 * cth + cl) * 16 + 4 * g) * 2;
        *(LAS u32x2*)(lds + L_KKD + o2) = (u32x2){pk2(v_kkd[0], v_kkd[1]), pk2(v_kkd[2], v_kkd[3])};
        *(LAS u32x2*)(lds + L_RD + o2) = (u32x2){pk2(v_rd[0], v_rd[1]), pk2(v_rd[2], v_rd[3])};
        *(LAS u32x2*)(lds + L_KDI + o2) = (u32x2){pk2(v_kdi[0], v_kdi[1]), pk2(v_kdi[2], v_kdi[3])};
        *(LAS u32x2*)(lds + L_BDI + o2) = (u32x2){pk2(v_bdi[0], v_bdi[1]), pk2(v_bdi[2], v_bdi[3])};
    }
    LBAR();
    {
        const int p = w >> 1;
        const int xoff = p < 2 ? L_KKD : L_RD, yoff = (p == 0 || p == 3) ? L_BDI : L_KDI, doff = p == 0 ? L_AUB : (p == 1 ? L_AUK : (p == 2 ? L_AOK : L_AOB));
#pragma unroll
        for (int ti = 0; ti < 2; ++ti) {
            const int tt = 2 * (w & 1) + ti;
            const bf16x8 a0 = *(const LAS bf16x8*)(lds + xoff + ((tt * 16 + lq) * MS_ + 8 * g) * 2), a1 = *(const LAS bf16x8*)(lds + xoff + ((tt * 16 + lq) * MS_ + 32 + 8 * g) * 2);
#pragma unroll
            for (int st = 0; st < 4; ++st) {
                f32x4 acc = (f32x4){0.f, 0.f, 0.f, 0.f};
                if (st <= tt) {
                    const bf16x8 b0 = *(const LAS bf16x8*)(lds + yoff + ((st * 16 + lq) * MS_ + 8 * g) * 2), b1 = *(const LAS bf16x8*)(lds + yoff + ((st * 16 + lq) * MS_ + 32 + 8 * g) * 2);
                    acc = mfma16(a0, b0, acc); acc = mfma16(a1, b1, acc);
                }
                const int s = st * 16 + lq;
#pragma unroll
                for (int e = 0; e < 4; ++e) {
                    const int t = tt * 16 + 4 * g + e;
                    const float val = (p < 2 ? s < t : s <= t) ? acc[e] : 0.f;
                    *(LAS bf16*)(lds + doff + (t * MS_ + s) * 2) = (bf16)f2bf(val);
                    if (p == 0 && st == tt) *(LAS float*)(lds + L_DG + ((tt * 16 + 4 * g + e) * 17 + lq) * 4) = val;
                }
            }
        }
    }
    LBAR();
    f32x4 X[4];
    if (w < 4) {
#pragma unroll
        for (int tt = 0; tt < 4; ++tt) { X[tt] = (f32x4){0.f, 0.f, 0.f, 0.f};
#pragma unroll
            for (int ks = 0; ks < 2; ++ks) X[tt] = mfma16(*(const LAS bf16x8*)(lds + L_AUK + ((tt * 16 + lq) * MS_ + 32 * ks + 8 * g) * 2), *(const LAS bf16x8*)(lds + L_VT + ((w * 16 + lq) * MS_ + 32 * ks + 8 * g) * 2), X[tt]); }
    } else {
#pragma unroll
        for (int tt = 0; tt < 4; ++tt)
#pragma unroll
            for (int e = 0; e < 4; ++e) X[tt][e] = bf2f(*(const LAS bf16*)(lds + L_KKD + ((tt * 16 + 4 * g + e) * MS_ + (w - 4) * 16 + lq) * 2));
        if (w == 7) {
            const LAS float* dg = (const LAS float*)(lds + L_DG) + g * 16 * 17;
            float Y[16];
#pragma unroll
            for (int t = 0; t < 16; ++t) { float acc = (t == lq) ? 1.0f : 0.0f;
#pragma unroll
                for (int s = 0; s < t; ++s) acc -= dg[t * 17 + s] * Y[s];
                Y[t] = acc; }
#pragma unroll
            for (int t = 0; t < 16; ++t) *(LAS bf16*)(lds + L_DI + ((g * 16 + t) * 24 + lq) * 2) = (bf16)f2bf(Y[t]);
        }
    }
    LBAR();
    {
        union { unsigned u[4]; bf16x8 v; } xb[2];
        xb[0].u[0] = xb[0].u[1] = xb[0].u[2] = xb[0].u[3] = 0u; xb[1].u[0] = xb[1].u[1] = xb[1].u[2] = xb[1].u[3] = 0u;
#pragma unroll
        for (int I = 0; I < 4; ++I) {
            f32x4 acc = X[I];
            if (I > 0) {
                union { unsigned long long q[2]; bf16x8 v; } av; f32x4 up = (f32x4){0.f, 0.f, 0.f, 0.f};
                av.q[0] = *(const LAS unsigned long long*)(lds + L_AUB + ((I * 16 + lq) * MS_ + 4 * g) * 2); av.q[1] = *(const LAS unsigned long long*)(lds + L_AUB + ((I * 16 + lq) * MS_ + 16 + 4 * g) * 2);
                up = mfma16(av.v, xb[0].v, up);
                if (I > 2) { av.q[0] = *(const LAS unsigned long long*)(lds + L_AUB + ((I * 16 + lq) * MS_ + 32 + 4 * g) * 2); av.q[1] = 0ull; up = mfma16(av.v, xb[1].v, up); }
                acc = acc - up;
            }
            union { unsigned u[4]; bf16x8 v; } rb; rb.u[0] = pk2(acc[0], acc[1]); rb.u[1] = pk2(acc[2], acc[3]); rb.u[2] = 0u; rb.u[3] = 0u;
            union { unsigned long long q[2]; bf16x8 v; } dv; dv.q[0] = *(const LAS unsigned long long*)(lds + L_DI + ((I * 16 + lq) * 24 + 4 * g) * 2); dv.q[1] = 0ull;
            const f32x4 xi = mfma16(dv.v, rb.v, (f32x4){0.f, 0.f, 0.f, 0.f});
            X[I] = xi;
            if (I == 0) { xb[0].u[0] = pk2(xi[0], xi[1]); xb[0].u[1] = pk2(xi[2], xi[3]); }
            else if (I == 1) { xb[0].u[2] = pk2(xi[0], xi[1]); xb[0].u[3] = pk2(xi[2], xi[3]); }
            else if (I == 2) { xb[1].u[0] = pk2(xi[0], xi[1]); xb[1].u[1] = pk2(xi[2], xi[3]); }
            *(LAS u32x2*)(lds + (w < 4 ? L_UT + (w * 16 + lq) * MS_ * 2 : L_KT + ((w - 4) * 16 + lq) * MS_ * 2) + (I * 16 + 4 * g) * 2) = (u32x2){pk2(xi[0], xi[1]), pk2(xi[2], xi[3])};
        }
    }
    LBAR();
    unsigned char* ck = F.ws + WS_CK + (size_t)((((tile >> 6) * 6 + h) << 6) + (tile & 63)) * CK_BYTES;
    {
        const int which = w >> 1;
#pragma unroll
        for (int ri = 0; ri < 2; ++ri) {
            const int rt = 2 * (w & 1) + ri;
#pragma unroll
            for (int nt = 0; nt < 4; ++nt) {
                f32x4 acc = (f32x4){0.f, 0.f, 0.f, 0.f}, acc2 = acc;
                if (which == 0 || which == 2) {
                    const int aoff = which == 0 ? L_BDET : L_AOB;
#pragma unroll
                    for (int ks = 0; ks < 2; ++ks) acc = mfma16(*(const LAS bf16x8*)(lds + aoff + ((rt * 16 + lq) * MS_ + 32 * ks + 8 * g) * 2), *(const LAS bf16x8*)(lds + L_KT + ((nt * 16 + lq) * MS_ + 32 * ks + 8 * g) * 2), acc);
                    LAS bf16* dstp = (LAS bf16*)(lds + L_MQ + (which == 0 ? 0 : 8192)) + ((rt * 2 + (nt >> 1)) * 64 + (lq >> 2) * 16) * 8 + (nt & 1) * 4 + (lq & 3);
#pragma unroll
                    for (int e = 0; e < 4; ++e) {
                        const int rr = rt * 16 + 4 * g + e, cc = nt * 16 + lq;
                        float val;
                        if (which == 0) val = (rr == cc ? *(const LAS float*)(lds + L_LC + rr * 4) : 0.f) - acc[e];
                        else val = bf2f(*(const LAS bf16*)(lds + L_RD + (rr * MS_ + cc) * 2)) - acc[e];
                        dstp[(4 * g + e) * 8] = (bf16)f2bf(val);
                    }
                } else {
                    const int a1 = which == 1 ? L_KDET : L_AOK, a2 = which == 1 ? L_BDET : L_AOB;
#pragma unroll
                    for (int ks = 0; ks < 2; ++ks) {
                        acc = mfma16(*(const LAS bf16x8*)(lds + a1 + ((rt * 16 + lq) * MS_ + 32 * ks + 8 * g) * 2), *(const LAS bf16x8*)(lds + L_VT + ((nt * 16 + lq) * MS_ + 32 * ks + 8 * g) * 2), acc);
                        acc2 = mfma16(*(const LAS bf16x8*)(lds + a2 + ((rt * 16 + lq) * MS_ + 32 * ks + 8 * g) * 2), *(const LAS bf16x8*)(lds + L_UT + ((nt * 16 + lq) * MS_ + 32 * ks + 8 * g) * 2), acc2);
                    }
                    *(f32x4*)(ck + (which == 1 ? CK_N : CK_O) + (size_t)((nt * 4 + rt) * 64 + lane) * 16) = acc - acc2;
                }
            }
        }
    }
    LBAR();
#pragma unroll
    for (int i = 0; i < 2; ++i) { const int o16 = (tidh + NTHR * i) * 16; *(v4u*)(ck + CK_M + o16) = *(const LAS v4u*)(lds + L_MQ + o16); }
    LBAR();
  }
}

__device__ __forceinline__ void touch_lds(const void* gsrc, unsigned lds_dst) { unsigned keep;
    asm volatile("s_mov_b32 %0, m0\n\ts_mov_b32 m0, %2\n\ts_nop 0\n\tglobal_load_lds_dword %1, off\n\ts_mov_b32 m0, %0" : "=&s"(keep) : "v"(gsrc), "s"(lds_dst) : "memory"); }
#define CHAIN_LOAD_MN(MF, NF, cp_) do { const unsigned char* cq_ = (cp_); \
    _Pragma("unroll") for (int i = 0; i < 8; ++i) MF[i] = *(const bf16x8*)(cq_ + CK_M + (size_t)(i * 64 + lane) * 16); \
    _Pragma("unroll") for (int i = 0; i < 4; ++i) NF[i] = *(const f32x4*)(cq_ + CK_N + (size_t)((ft * 4 + i) * 64 + lane) * 16); } while (0)
#define CHAIN_STEP(MF, NF, MFN, NFN, c_) do { \
    CHAIN_LOAD_MN(MFN, NFN, ck + (size_t)((c_) + 1 < 64 ? (c_) + 1 : 63) * CK_BYTES); \
    union { unsigned u[4]; bf16x8 v; v4u q; } zb[2]; \
    _Pragma("unroll") for (int ks = 0; ks < 2; ++ks) { zb[ks].u[0] = pk2(Z[2 * ks][0], Z[2 * ks][1]); zb[ks].u[1] = pk2(Z[2 * ks][2], Z[2 * ks][3]); zb[ks].u[2] = pk2(Z[2 * ks + 1][0], Z[2 * ks + 1][1]); zb[ks].u[3] = pk2(Z[2 * ks + 1][2], Z[2 * ks + 1][3]); \
        *(LAS v4u*)(F.lds + ((c_) & 1) * 8192 + ((ft * 2 + ks) * 64 + lane) * 16) = zb[ks].q; } \
    _Pragma("unroll") for (int mt = 0; mt < 4; ++mt) { f32x4 z = NF[mt]; z = mfma16(MF[mt * 2], zb[0].v, z); z = mfma16(MF[mt * 2 + 1], zb[1].v, z); Z[mt] = z; } } while (0)
__device__ __forceinline__ void chain_item(Frame& F, int l, int item) {
    int tid = F.tid; asm volatile("" : "+v"(tid));
    const int lane = tid & 63, w = F.wave, g = lane >> 4, lq = lane & 15;
    const int bh = item, ft = w & 3, b = bh / 6, h = bh % 6;
    const unsigned char* ck = F.ws + WS_CK + (size_t)(bh << 6) * CK_BYTES;
    unsigned char* zf = F.ws + WS_ZF + (size_t)(bh << 6) * 8192;
    constexpr int PF = 6;
    if (w >= 4) {
        const int pt = tid - 256;
        const unsigned pdst = (unsigned)__builtin_amdgcn_readfirstlane((unsigned)(uintptr_t)(F.lds + 32768 + (w - 4) * 256));
        for (int c = 0; c < PF; ++c) if (pt < 192) touch_lds(ck + (size_t)c * CK_BYTES + (pt < 64 ? CK_M + pt * 128 : CK_N + (pt - 64) * 128), pdst);
        for (int c = 0; c < 64; ++c) {
            const int cc = c + PF;
            if (cc < 64 && pt < 192) touch_lds(ck + (size_t)cc * CK_BYTES + (pt < 64 ? CK_M + pt * 128 : CK_N + (pt - 64) * 128), pdst);
            LBAR();
#pragma unroll
            for (int i = 0; i < 2; ++i) { const int o16 = (pt + 256 * i) * 16; *(v4u*)(zf + (size_t)c * 8192 + o16) = *(const LAS v4u*)(F.lds + (c & 1) * 8192 + o16); }
        }
        return;
    }
    f32x4 Z[4];
#pragma unroll
    for (int mt = 0; mt < 4; ++mt) Z[mt] = (f32x4){0.f, 0.f, 0.f, 0.f};
    bf16x8 mfA[8], mfB[8]; f32x4 nfA[4], nfB[4];
    CHAIN_LOAD_MN(mfA, nfA, ck);
    for (int c = 0; c < 64; c += 2) {
        CHAIN_STEP(mfA, nfA, mfB, nfB, c);
        LBAR();
        CHAIN_STEP(mfB, nfB, mfA, nfA, c + 1);
        LBAR();
    }
    float* so = F.out + O_PWKV + (((size_t)l * NBP + b) * 6 + h) * 4096 + (size_t)(ft * 16 + lq) * 64 + 4 * g;
#pragma unroll
    for (int mt = 0; mt < 4; ++mt) *(f32x4*)(so + mt * 16) = Z[mt];
}

__device__ __forceinline__ int q_next(Frame& F, int qi) {
    volatile LAS unsigned* slot = F.MISC + 12;
    if (F.tid == 0) slot[0] = __hip_atomic_fetch_add(F.ctl + CW_Q + 64 * (qi + 8 * F.rep), 1u, RLX_AGENT);
    __syncthreads();
    const int v = (int)slot[0];
    __syncthreads();
    return v;
}


__device__ __forceinline__ void ret1_item(Frame& F, int item) {
    int tid = F.tid; asm volatile("" : "+v"(tid));
    const int lane = tid & 63, w = F.wave, g = lane >> 4, lq = lane & 15;
    const int c = item & 31, bh = item >> 5, b = bh >> 2, h = bh & 3;
    const bf16* H = (const bf16*)(F.ws + WS_H); float* OC = (float*)(F.ws + WS_OC);
    const float gam = 1.0f - exp2f(-5.0f - (float)h), lg2 = log2f(gam);
    LAS bf16* Kl = (LAS bf16*)F.lds;
    LAS bf16* KTd = Kl + 128 * 72;
    LAS bf16* VT = KTd + 64 * 136;
    const size_t rowc = (size_t)b * SEQ + c * 128;
    v4u kv[2], vv[2];
#pragma unroll
    for (int i = 0; i < 2; ++i) { const int cid = tid + NTHR * i, key = cid >> 3, ch = cid & 7;
        kv[i] = *(const v4u*)(H + (rowc + key) * IN_COLS + COL_KC + h * 64 + ch * 8); vv[i] = *(const v4u*)(H + (rowc + key) * IN_COLS + COL_VC + h * 64 + ch * 8); }
    const int qi = 16 * w + lq; const size_t qrow = rowc + qi;
    bf16x8 qf[2];
    qf[0] = *(const bf16x8*)(H + qrow * IN_COLS + COL_QC + h * 64 + 8 * g); qf[1] = *(const bf16x8*)(H + qrow * IN_COLS + COL_QC + h * 64 + 32 + 8 * g);
#pragma unroll
    for (int i = 0; i < 2; ++i) { const int cid = tid + NTHR * i, key = cid >> 3, ch = cid & 7;
        *(LAS v4u*)(Kl + key * 72 + ch * 8) = kv[i];
        const float kd = exp2f((float)(127 - key) * lg2);
        const unsigned ku[4] = {kv[i].x, kv[i].y, kv[i].z, kv[i].w}, vu[4] = {vv[i].x, vv[i].y, vv[i].z, vv[i].w};
#pragma unroll
        for (int e = 0; e < 8; ++e) { KTd[(ch * 8 + e) * 136 + key] = (bf16)f2bf(bfw(ku[e >> 1], e & 1) * kd); VT[(ch * 8 + e) * 136 + key] = (bf16)((vu[e >> 1] >> ((e & 1) * 16)) & 0xffffu); } }
    __syncthreads();
    f32x4 s[8];
#pragma unroll
    for (int jt = 0; jt < 8; ++jt) {
        s[jt] = (f32x4){0.f, 0.f, 0.f, 0.f};
        if (jt <= w) {
#pragma unroll
            for (int ks = 0; ks < 2; ++ks) { const bf16x8 a = *(const LAS bf16x8*)(Kl + (jt * 16 + lq) * 72 + 32 * ks + 8 * g); s[jt] = mfma16(a, qf[ks], s[jt]); }
#pragma unroll
            for (int e = 0; e < 4; ++e) { const int kj = jt * 16 + 4 * g + e; s[jt][e] = kj <= qi ? s[jt][e] * exp2f((float)(qi - kj) * lg2) : 0.f; }
        }
    }
    f32x4 o[4];
#pragma unroll
    for (int ft = 0; ft < 4; ++ft) o[ft] = (f32x4){0.f, 0.f, 0.f, 0.f};
#pragma unroll
    for (int pp = 0; pp < 4; ++pp) {
        if (2 * pp <= w) {
            union { unsigned u[4]; bf16x8 v; } pb;
            pb.u[0] = pk2(s[2 * pp][0], s[2 * pp][1]); pb.u[1] = pk2(s[2 * pp][2], s[2 * pp][3]); pb.u[2] = pk2(s[2 * pp + 1][0], s[2 * pp + 1][1]); pb.u[3] = pk2(s[2 * pp + 1][2], s[2 * pp + 1][3]);
            const int k0 = (2 * pp) * 16 + 4 * g, k1 = (2 * pp + 1) * 16 + 4 * g;
#pragma unroll
            for (int ft = 0; ft < 4; ++ft) {
                union { unsigned long long q[2]; bf16x8 v; } av;
                av.q[0] = *(const LAS unsigned long long*)(VT + (ft * 16 + lq) * 136 + k0); av.q[1] = *(const LAS unsigned long long*)(VT + (ft * 16 + lq) * 136 + k1);
                o[ft] = mfma16(av.v, pb.v, o[ft]);
            }
        }
    }
    float* op = OC + qrow * 256 + h * 64 + 4 * g;
#pragma unroll
    for (int ft = 0; ft < 4; ++ft) *(f32x4*)(op + ft * 16) = o[ft];
    float* kvp = (float*)(F.ws + WS_KV) + (size_t)item * 4096;
#pragma unroll
    for (int ti = 0; ti < 2; ++ti) {
        const int tl = 2 * w + ti, ft = tl >> 2, et = tl & 3;
        f32x4 acc = (f32x4){0.f, 0.f, 0.f, 0.f};
#pragma unroll
        for (int ks = 0; ks < 4; ++ks) acc = mfma16(*(const LAS bf16x8*)(VT + (ft * 16 + lq) * 136 + 32 * ks + 8 * g), *(const LAS bf16x8*)(KTd + (et * 16 + lq) * 136 + 32 * ks + 8 * g), acc);
#pragma unroll
        for (int e = 0; e < 4; ++e) kvp[(ft * 16 + 4 * g + e) * 64 + et * 16 + lq] = acc[e];
    }
    __syncthreads();
}
__device__ __forceinline__ void ret2_item(Frame& F, int l, int item) {
    int tid = F.tid; asm volatile("" : "+v"(tid));
    const int lane = tid & 63, w = F.wave, g = lane >> 4, lq = lane & 15;
    const int c = item & 31, bh = item >> 5, b = bh >> 2, h = bh & 3;
    if (c == 0) return;
    const bf16* H = (const bf16*)(F.ws + WS_H); float* OC = (float*)(F.ws + WS_OC2);
    const float gam = 1.0f - exp2f(-5.0f - (float)h), lg2 = log2f(gam), gch = exp2f(128.0f * lg2);
    LAS bf16* RT = (LAS bf16*)F.lds;
    const float* kvb = (const float*)(F.ws + WS_KV) + (size_t)(bh * 32) * 4096 + tid * 8;
    f32x4 r0 = (f32x4){0.f, 0.f, 0.f, 0.f}, r1 = r0;
#pragma unroll 4
    for (int cc = 0; cc < c; ++cc) { const f32x4 a = *(const f32x4*)(kvb + (size_t)cc * 4096), bq = *(const f32x4*)(kvb + (size_t)cc * 4096 + 4); r0 = r0 * gch + a; r1 = r1 * gch + bq; }
    { const int f = tid >> 3, e0 = (tid & 7) * 8;
      *(LAS v4u*)(RT + f * 72 + e0) = (v4u){pk2(r0[0], r0[1]), pk2(r0[2], r0[3]), pk2(r1[0], r1[1]), pk2(r1[2], r1[3])};
      if (c == 31) {
          const f32x4 a = *(const f32x4*)(kvb + (size_t)31 * 4096), bq = *(const f32x4*)(kvb + (size_t)31 * 4096 + 4); const f32x4 f0 = r0 * gch + a, f1 = r1 * gch + bq;
          float* po = F.out + O_PRET + (((size_t)l * NBP + b) * 4 + h) * 4096 + f;
#pragma unroll
          for (int e = 0; e < 4; ++e) { po[dimC(e0 + e) * 64] = f0[e]; po[dimC(e0 + 4 + e) * 64] = f1[e]; }
      } }
    __syncthreads();
    const int qi = 16 * w + lq; const size_t qrow = (size_t)b * SEQ + c * 128 + qi;
    const float qdec = exp2f((float)(qi + 1) * lg2);
    bf16x8 qf[2];
    qf[0] = *(const bf16x8*)(H + qrow * IN_COLS + COL_QC + h * 64 + 8 * g); qf[1] = *(const bf16x8*)(H + qrow * IN_COLS + COL_QC + h * 64 + 32 + 8 * g);
    float* op = OC + qrow * 256 + h * 64 + 4 * g;
#pragma unroll
    for (int ft = 0; ft < 4; ++ft) { f32x4 x = (f32x4){0.f, 0.f, 0.f, 0.f};
#pragma unroll
        for (int ks = 0; ks < 2; ++ks) x = mfma16(*(const LAS bf16x8*)(RT + (ft * 16 + lq) * 72 + 32 * ks + 8 * g), qf[ks], x);
        *(f32x4*)(op + ft * 16) = x * qdec; }
    __syncthreads();
}

__device__ __forceinline__ void sret_item(Frame& F, int l, const bf16* H, float* OC, int item) {
    int tid = F.tid; asm volatile("" : "+v"(tid));
    const int b = item >> 2, h = item & 3, f = tid & 63, eg = tid >> 6;
    const float gam = 1.0f - exp2f(-5.0f - (float)h);
    const float* r0 = inp(F, 6) + (((size_t)l * NBS + b) * 4 + h) * 4096;
    LAS float* red = (LAS float*)F.lds;
    float S[8];
#pragma unroll
    for (int e = 0; e < 8; ++e) S[e] = r0[dimC(eg * 8 + e) * 64 + f];
    for (int t = 0; t < TS; ++t) {
        const size_t row = MP + b * 4 + t; const bf16* hp = H + row * IN_COLS;
        const float vf = bf2f(hp[COL_VC + h * 64 + f]);
        float part = 0.f;
#pragma unroll
        for (int e = 0; e < 8; ++e) { const float ke = bf2f(hp[COL_KC + h * 64 + eg * 8 + e]), qe = bf2f(hp[COL_QC + h * 64 + eg * 8 + e]); S[e] = gam * S[e] + ke * vf; part += qe * S[e]; }
        red[eg * 64 + f] = part;
        __syncthreads();
        if (tid < 64) { float o = 0.f;
#pragma unroll
            for (int q = 0; q < 8; ++q) o += red[q * 64 + tid];
            OC[row * 256 + h * 64 + tid] = o; }
        __syncthreads();
    }
    float* so = F.out + O_SRET + (((size_t)l * NBS + b) * 4 + h) * 4096;
#pragma unroll
    for (int e = 0; e < 8; ++e) so[dimC(eg * 8 + e) * 64 + f] = S[e];
}

__device__ __forceinline__ void sattn_item(Frame& F, int l, const bf16* H, float* OB, float* LSE, int item) {
    int lane = F.lane; asm volatile("" : "+v"(lane));
    const int qx = item * 8 + F.wave;
    const int di = qx % 3, qq = qx / 3, b = qq / 24, t = (qq / 6) & 3, h = qq % 6; const size_t row = MP + b * 4 + t;
    const int d = di == 0 ? 1 : (di == 1 ? 4 : 16);
    LAS float* qs = (LAS float*)(F.lds + F.wave * 2048);
    LAS float* qp = qs + 64; LAS float* pw = qs + 128;
    const float* ck = inp(F, 4) + ((size_t)l * NBS + b) * WBUF * 384 + h * 64; const float* cv = inp(F, 5) + ((size_t)l * NBS + b) * WBUF * 384 + h * 64;
    const bf16* hk = H + (size_t)(MP + b * 4) * IN_COLS + COL_KB + h * 64; const bf16* hv = H + (size_t)(MP + b * 4) * IN_COLS + COL_VB + h * 64;
    { const float qv = bf2f(H[row * IN_COLS + COL_QB + h * 64 + lane]) * 0.125f; qs[dimB(lane)] = qv; qp[lane] = qv; }
    asm volatile("s_waitcnt lgkmcnt(0)" ::: "memory");
    float sc[3];
#pragma unroll
    for (int rnd = 0; rnd < 3; ++rnd) {
        const int jk = rnd * 64 + lane; float acc = -1e30f;
        if (jk <= 128) {
            const int idx = WBUF + t - d * jk; acc = 0.f;
            if (idx < WBUF) { const f32x4* kp = (const f32x4*)(ck + (size_t)idx * 384); f32x4 kx[16];
#pragma unroll
                for (int q = 0; q < 16; ++q) kx[q] = kp[q];
#pragma unroll
                for (int q = 0; q < 16; ++q) { const f32x4 q4 = *(const LAS f32x4*)(qs + 4 * q); acc += (kx[q][0] * q4[0] + kx[q][1] * q4[1]) + (kx[q][2] * q4[2] + kx[q][3] * q4[3]); }
            } else { const v4u* kp = (const v4u*)(hk + (size_t)(idx - WBUF) * IN_COLS);
#pragma unroll
                for (int q = 0; q < 8; ++q) { const v4u kx = kp[q]; const f32x4 q0 = *(const LAS f32x4*)(qp + 8 * q), q1 = *(const LAS f32x4*)(qp + 8 * q + 4);
                    acc += (bfw(kx.x, 0) * q0[0] + bfw(kx.x, 1) * q0[1]) + (bfw(kx.y, 0) * q0[2] + bfw(kx.y, 1) * q0[3]) + (bfw(kx.z, 0) * q1[0] + bfw(kx.z, 1) * q1[1]) + (bfw(kx.w, 0) * q1[2] + bfw(kx.w, 1) * q1[3]); }
            }
        }
        sc[rnd] = acc;
    }
    const float m = wave_max(fmaxf(fmaxf(sc[0], sc[1]), sc[2]));
    float psum = 0.f;
#pragma unroll
    for (int rnd = 0; rnd < 3; ++rnd) { const int jk = rnd * 64 + lane; const float p = jk <= 128 ? __expf(sc[rnd] - m) : 0.f; psum += p; pw[jk] = p; }
    const float lsum = wave_sum(psum);
    asm volatile("s_waitcnt lgkmcnt(0)" ::: "memory");
    const int kg = lane >> 4, dq = (lane & 15) * 4;
    f32x4 o4 = (f32x4){0.f, 0.f, 0.f, 0.f};
#pragma unroll 11
    for (int i = 0; i < 33; ++i) {
        const int jk = 4 * i + kg;
        if (jk <= 128) {
            const int idx = WBUF + t - d * jk; f32x4 vv;
            if (idx >= WBUF) { const u32x2 u = *(const u32x2*)(hv + (size_t)(idx - WBUF) * IN_COLS + dq); vv = (f32x4){bfw(u.x, 0), bfw(u.x, 1), bfw(u.y, 0), bfw(u.y, 1)}; }
            else vv = *(const f32x4*)(cv + (size_t)idx * 384 + dq);
            o4 = o4 + vv * pw[jk];
        }
    }
#pragma unroll
    for (int e = 0; e < 4; ++e) { o4[e] += __shfl_xor(o4[e], 16); o4[e] += __shfl_xor(o4[e], 32); }
    if (kg == 0) *(f32x4*)(OB + ((size_t)di * MT + row) * 384 + h * 64 + dq) = o4 * (1.0f / lsum);
    if (lane == 0) LSE[((size_t)di * MT + row) * 6 + h] = m + __logf(lsum);
}

__device__ __forceinline__ void winout_item(Frame& F, int l, int item) {
    int tid = F.tid; asm volatile("" : "+v"(tid));
    const bf16* H = (const bf16*)(F.ws + WS_H);
    for (int q = tid; q < 64 * 96; q += NTHR) {
        const int r = item * 64 + q / 96, tk = q % 96;
        size_t row; float* ok; float* ov; size_t wrow;
        if (r < NBP * WBUF) { const int b = r >> 11, tt = r & (WBUF - 1); row = (size_t)b * SEQ + (SEQ - WBUF) + tt; wrow = ((size_t)l * NBP + b) * WBUF + tt; ok = F.out + O_PWINK; ov = F.out + O_PWINV; }
        else { const int rs = r - NBP * WBUF, b = rs >> 2, t = rs & 3; row = MP + rs; wrow = ((size_t)l * NBS + b) * WBUF + (WBUF - TS + t); ok = F.out + O_SWINK; ov = F.out + O_SWINV; }
        const bf16* hp = H + row * IN_COLS;
        if (tk < 48) {
            const int hh = tk >> 3, part = tk & 7; const v4u a = *(const v4u*)(hp + COL_KB + hh * 64 + 8 * part);
            const float v[8] = {bfw(a.x, 0), bfw(a.x, 1), bfw(a.y, 0), bfw(a.y, 1), bfw(a.z, 0), bfw(a.z, 1), bfw(a.w, 0), bfw(a.w, 1)};
            float* o = ok + wrow * 384 + hh * 64;
            if (part < 2) { *(f32x4*)(o + 4 * part) = (f32x4){v[0], v[2], v[4], v[6]}; *(f32x4*)(o + 8 + 4 * part) = (f32x4){v[1], v[3], v[5], v[7]}; }
            else { *(f32x4*)(o + 8 * part) = (f32x4){v[0], v[1], v[2], v[3]}; *(f32x4*)(o + 8 * part + 4) = (f32x4){v[4], v[5], v[6], v[7]}; }
        } else { const int c2 = tk - 48; const v4u a = *(const v4u*)(hp + COL_VB + 8 * c2); float* o = ov + wrow * 384 + 8 * c2;
            *(f32x4*)o = (f32x4){bfw(a.x, 0), bfw(a.x, 1), bfw(a.y, 0), bfw(a.y, 1)}; *(f32x4*)(o + 4) = (f32x4){bfw(a.z, 0), bfw(a.z, 1), bfw(a.w, 0), bfw(a.w, 1)}; }
    }
    if (item < NBP + NBS) {
        const bool isS = item >= NBP; const int b = isS ? item - NBP : item; const size_t row = isS ? MP + b * 4 + 3 : (size_t)b * SEQ + SEQ - 1;
        float* o = F.out + (isS ? O_SSHIFT + ((size_t)l * NBS + b) * A_COLS : O_PSHIFT + ((size_t)l * NBP + b) * A_COLS);
        for (int c = tid; c < A_COLS; c += NTHR) o[c] = bf2f(H[row * IN_COLS + c]);
    }
}
__device__ __forceinline__ void pa_phase(Frame& F, int l) {
    const bf16* H = (const bf16*)(F.ws + WS_H); float* OB = (float*)(F.ws + WS_OB); float* LSE = (float*)(F.ws + WS_LSE);
    constexpr int N_RW = 258, N_RET1 = NBP * 4 * 32, N_ATT = NBP * 6 * 3 * 32;
    for (;;) {
        int r = q_next(F, l * 4 + 0);
        if (r >= N_RW + N_RET1 + N_ATT) break;
        if (r < N_RW) { rwkv_item(F, l, r); continue; } r -= N_RW;
        if (r < N_RET1) { ret1_item(F, r); continue; } r -= N_RET1;
        attn_unit(F, H, OB, LSE, r);
    }
}
__device__ __forceinline__ void mixers_phase(Frame& F, int l) {
    const bf16* H = (const bf16*)(F.ws + WS_H); const float* SC = (const float*)(F.ws + WS_SC); float* OA = (float*)(F.ws + WS_OA);
    float* OB = (float*)(F.ws + WS_OB); float* LSE = (float*)(F.ws + WS_LSE); float* OC = (float*)(F.ws + WS_OC);
    constexpr int N_CHAIN = NBP * 6, N_RET2 = NBP * 4 * 32, N_SATT = (MS * 6 * 3) / 8, N_SRET = NBS * 4, N_SSCAN = NBS * 6 * 2, N_WOUT = (NBP * WBUF + MS) / 64, N_COPY = 0;
    constexpr int N_ALL = N_CHAIN + N_RET2 + N_SATT + N_SRET + N_SSCAN + N_WOUT + N_COPY;
    for (;;) {
        int r = q_next(F, l * 4 + 1);
        if (r >= N_ALL) break;
#ifndef PBX
#define PBX 0
#endif
        if (r < N_CHAIN) { chain_item(F, l, r); if (PBX & 1) chain_item(F, l, r); continue; } r -= N_CHAIN;
        if (r < N_SATT) { sattn_item(F, l, H, OB, LSE, r); if (PBX & 2) sattn_item(F, l, H, OB, LSE, r); continue; } r -= N_SATT;
        if (r < N_RET2) { ret2_item(F, l, r); if (PBX & 4) ret2_item(F, l, r); continue; } r -= N_RET2;
        if (r < N_SRET) { sret_item(F, l, H, OC, r); if (PBX & 8) sret_item(F, l, H, OC, r); continue; } r -= N_SRET;
        if (r < N_SSCAN) { const int bh = r >> 1, half = r & 1, b = bh / 6, h = bh % 6;
            scan_item(F, SC, OA, b * TS, MP + b * TS, TS, h, half, inp(F, 3) + (((size_t)l * NBS + b) * 6 + h) * 4096, F.out + O_SWKV + (((size_t)l * NBS + b) * 6 + h) * 4096); continue; } r -= N_SSCAN;
        if (r < N_WOUT) { winout_item(F, l, r); if (PBX & 32) winout_item(F, l, r); continue; } r -= N_WOUT;
        copy_item(F, l, r);
    }
}

__device__ __forceinline__ void copy_tail(Frame& F, int l, int qi, int lo, int hi) {
    for (;;) { const int r = q_next(F, qi) + lo; if (r >= hi) break; copy_item(F, l, r); }
}

__device__ __forceinline__ void post_item(Frame& F, int l, int tile) {
    const bf16* H = (const bf16*)(F.ws + WS_H); const float* VX = (const float*)(F.ws + WS_VX); const float* OA = (const float*)(F.ws + WS_OA);
    const float* OB = (const float*)(F.ws + WS_OB); const float* LSE = (const float*)(F.ws + WS_LSE); const float* OC = (const float*)(F.ws + WS_OC); const float* OC2 = (const float*)(F.ws + WS_OC2);
    const float* Gt = (const float*)(F.ws + WS_G); const float* RK = (const float*)(F.ws + WS_RK); bf16* MIX = (bf16*)(F.ws + WS_MIX);
    const float* gna = inp(F, 17) + l * WA; const float* gnb = inp(F, 18) + l * WA; const float* rgg = inp(F, 19) + l * 256; const float* rgb = inp(F, 20) + l * 256;
    int tid = F.tid; asm volatile("" : "+v"(tid));
    const int lane = tid & 63, w = F.wave, g = lane >> 4, lq = lane & 15;
    const bool isS = tile >= 256; const int R0 = isS ? MP + (tile - 256) * 64 : tile * 64;
    LAS float* OL = (LAS float*)F.lds;
    if (isS) {
        for (int q = tid; q < 64 * 96; q += NTHR) { const int r = q / 96, c4 = q % 96; *(LAS f32x4*)(OL + r * 388 + c4 * 4) = *(const f32x4*)(OA + (size_t)(R0 + r) * WA + c4 * 4); }
    } else {
        const int b = tile >> 6, c = tile & 63, tt = w & 3, fth = w >> 2;
#pragma unroll 2
        for (int h = 0; h < 6; ++h) {
            const size_t ci = (size_t)(((b * 6 + h) << 6) + c);
            const unsigned char* cp = F.ws + WS_CK + ci * CK_BYTES; const unsigned char* zp = F.ws + WS_ZF + ci * 8192;
            const bf16x8 q0 = *(const bf16x8*)(cp + CK_Q + (size_t)((tt * 2) * 64 + lane) * 16), q1 = *(const bf16x8*)(cp + CK_Q + (size_t)((tt * 2 + 1) * 64 + lane) * 16);
#pragma unroll
            for (int fi = 0; fi < 2; ++fi) { const int ft = fth * 2 + fi;
                f32x4 o = *(const f32x4*)(cp + CK_O + (size_t)((ft * 4 + tt) * 64 + lane) * 16);
                o = mfma16(q0, *(const bf16x8*)(zp + (size_t)((ft * 2) * 64 + lane) * 16), o); o = mfma16(q1, *(const bf16x8*)(zp + (size_t)((ft * 2 + 1) * 64 + lane) * 16), o);
#pragma unroll
                for (int e = 0; e < 4; ++e) OL[(tt * 16 + 4 * g + e) * 388 + h * 64 + ft * 16 + lq] = o[e]; }
        }
    }
    __syncthreads();
    const int nrow = (R0 + 64 <= MV) ? 64 : (MV - R0);
    for (int r = w; r < nrow; r += NWAVES) {
        const int row = R0 + r;
        bf16* mx = MIX + (size_t)row * DM;
#pragma unroll
        for (int bt = 0; bt < 2; ++bt) {
            const int i4 = lane + 64 * bt; const bool act = i4 < 96; const int c = (act ? i4 : 0) * 4, h = c >> 6;
            { const f32x4 o = *(const LAS f32x4*)(OL + r * 388 + c);
              const float mean = red16((o[0] + o[1]) + (o[2] + o[3])) * (1.f / 64.f); const f32x4 d = o - mean;
              const float var = red16((d[0] * d[0] + d[1] * d[1]) + (d[2] * d[2] + d[3] * d[3])) * (1.f / 64.f); const float rstd = rsqrtf(var + GN_EPS_A);
              const f32x4 gg = *(const f32x4*)(gna + c), gb = *(const f32x4*)(gnb + c), vx = *(const f32x4*)(VX + (size_t)row * WA + c), gt = *(const f32x4*)(Gt + (size_t)row * WA + c);
              const float rk = RK[row * 6 + h];
              const f32x4 y = (d * rstd * gg + gb + vx * rk) * gt;
              if (act) *(u32x2*)(mx + c) = (u32x2){pk2(y[0], y[1]), pk2(y[2], y[3])}; }
            { const float l0 = LSE[((size_t)0 * MT + row) * 6 + h], l1 = LSE[((size_t)1 * MT + row) * 6 + h], l2 = LSE[((size_t)2 * MT + row) * 6 + h];
              const float m = fmaxf(fmaxf(l0, l1), l2); const float e0 = fexp(l0 - m), e1 = fexp(l1 - m), e2 = fexp(l2 - m); const float inv = __builtin_amdgcn_rcpf(e0 + e1 + e2);
              const f32x4 b0 = *(const f32x4*)(OB + ((size_t)0 * MT + row) * 384 + c), b1 = *(const f32x4*)(OB + ((size_t)1 * MT + row) * 384 + c), b2 = *(const f32x4*)(OB + ((size_t)2 * MT + row) * 384 + c);
              const f32x4 y = (b0 * e0 + b1 * e1 + b2 * e2) * inv;
              if (act) *(u32x2*)(mx + WA + c) = (u32x2){pk2(y[0], y[1]), pk2(y[2], y[3])}; }
        }
        {
            const int c = lane * 4;
            f32x4 o = *(const f32x4*)(OC + (size_t)row * 256 + c);
            if (row < MP && (row & (SEQ - 1)) >= 128) o = o + *(const f32x4*)(OC2 + (size_t)row * 256 + c);
            const float mean = red16((o[0] + o[1]) + (o[2] + o[3])) * (1.f / 64.f); const f32x4 d = o - mean;
            const float var = red16((d[0] * d[0] + d[1] * d[1]) + (d[2] * d[2] + d[3] * d[3])) * (1.f / 64.f); const float rstd = rsqrtf(var + LN_EPS);
            const f32x4 gg = *(const f32x4*)(rgg + c), gb = *(const f32x4*)(rgb + c);
            const u32x2 gu = *(const u32x2*)(H + (size_t)row * IN_COLS + COL_GC + c);
            const f32x4 gc = (f32x4){bfw(gu.x, 0), bfw(gu.x, 1), bfw(gu.y, 0), bfw(gu.y, 1)};
            f32x4 y = d * rstd * gg + gb;
#pragma unroll
            for (int e = 0; e < 4; ++e) y[e] = y[e] * gc[e] * fsig(gc[e]);
            *(u32x2*)(mx + 2 * WA + c) = (u32x2){pk2(y[0], y[1]), pk2(y[2], y[3])};
        }
    }
    __syncthreads();
}
__device__ __forceinline__ void post_phase(Frame& F, int l) {
    for (int tile = F.bid; tile < 258; tile += F.G) post_item(F, l, tile);
}

__device__ __forceinline__ void ln_phase(Frame& F, const float* V, const float* gw, const float* bw, float* outP, float* outS, bf16* ob) {
    const int lane = F.lane;
    for (int row = F.bid * NWAVES + F.wave; row < MV; row += F.G * NWAVES) {
        const GAS f32x4* xr = (const GAS f32x4*)(V + (size_t)row * DM) + lane;
        f32x4 v[4]; float s = 0.f;
#pragma unroll
        for (int j = 0; j < 4; ++j) { v[j] = xr[64 * j]; s += (v[j].x + v[j].y) + (v[j].z + v[j].w); }
        const float mean = wave_sum(s) * (1.f / DM); float s2 = 0.f;
#pragma unroll
        for (int j = 0; j < 4; ++j) { v[j] = v[j] - mean; s2 += (v[j].x * v[j].x + v[j].y * v[j].y) + (v[j].z * v[j].z + v[j].w * v[j].w); }
        const float rstd = rsqrtf(wave_sum(s2) * (1.f / DM) + LN_EPS);
        float* orow = row < MP ? outP + (size_t)row * DM : outS + (size_t)(row - MP) * DM;
#pragma unroll
        for (int j = 0; j < 4; ++j) {
            const f32x4 gg = ((const f32x4*)gw)[lane + 64 * j], bb = ((const f32x4*)bw)[lane + 64 * j];
            const f32x4 y = v[j] * rstd * gg + bb;
            ((GAS f32x4*)orow)[lane + 64 * j] = y;
            if (ob) ((GAS unsigned long long*)(ob + (size_t)row * DM))[lane + 64 * j] = (unsigned long long)pk2(y.x, y.y) | ((unsigned long long)pk2(y.z, y.w) << 32);
        }
    }
}

struct Args { const float* in[29]; float* out; unsigned char* ws; int ph_lo, ph_hi; };
static_assert(sizeof(Args) == 29 * 8 + 8 + 8 + 8, "Args has no padding");
__global__ void __launch_bounds__(NTHR, 2) mk_fwd(Args args) {
    extern __shared__ __attribute__((aligned(16))) unsigned char lds[];
    Frame F;
    F.lds = (LAS unsigned char*)lds; F.MISC = (volatile LAS unsigned*)(F.lds + MISC_OFF);
    F.tid = threadIdx.x; F.lane = F.tid & 63; F.wave = __builtin_amdgcn_readfirstlane(F.tid >> 6); F.G = gridDim.x; F.bid = blockIdx.x;
    F.out = args.out; F.ws = args.ws; F.ctl = (gu32*)(args.ws + WS_CTL);
    for (int u = F.tid; u < (LDS_BYTES - LDSCTL_OFF) / 4; u += NTHR) ((LAS unsigned*)(F.lds + LDSCTL_OFF))[u] = 0u;
    __syncthreads();
    const bool multi = args.ph_hi - args.ph_lo > 1;
    XcdBarrier bar; bar.bar = (unsigned*)(F.ctl + CW_BAR); bar.x = 0; bar.st = nullptr;
    if (multi) bar = xcd_barrier_post((unsigned*)(F.ctl + CW_BAR), F.MISC + 8);
    for (int ph = args.ph_lo; ph < args.ph_hi; ++ph) {
#ifndef PHM
#define PHM 0x3ff
#endif
#ifndef DBL
#define DBL 0
#endif
        const int nrep_ = (DBL != 0 && ((ph == 0) ? ((DBL >> 9) & 1) : ((DBL >> ((ph - 1) % NST)) & 1))) ? 2 : 1;
        for (int rep_ = 0; rep_ < nrep_; ++rep_) {
        { unsigned zoff; asm volatile("s_mov_b32 %0, 0" : "=s"(zoff));
          F.ws = args.ws + zoff; F.out = args.out + zoff; F.inb = args.in; F.zoff = zoff;
          int tl = threadIdx.x; asm volatile("" : "+v"(tl)); F.tid = tl; F.lane = tl & 63; F.wave = __builtin_amdgcn_readfirstlane(tl >> 6); F.rep = rep_; }
        if (rep_) { XcdBarrier b2 = bar; unsigned* bb = bar.bar; unsigned xx = bar.x; asm volatile("" : "+s"(bb), "+s"(xx)); b2.bar = bb; b2.x = xx; xcd_barrier(b2); }
        if (ph == 0) { if (PHM & 1) p0_prologue(F); }
        else {
            const int l = (ph - 1) / NST, st = (ph - 1) % NST;
            unsigned char* wb = F.ws + WS_W + (size_t)l * LW;
            if (st == 0 && (PHM & 2)) {
                pg8::Gemm g{(const bf16*)(F.ws + WS_XB), (const bf16*)(wb + W_IN), MT, IN_COLS, DM}; pg8::StaticOrder S; S.init(MT, IN_COLS, F.G, F.bid);
                pg8::EpiHRot E{(bf16*)(F.ws + WS_H), IN_COLS, (const float*)(F.ws + WS_TAB)};
                pg8::gemm_phase<pg8::EpiHRot, pg8::StaticOrder, true, true>(F.lds, g, S, E);
            } else if (st == 1) { if (PHM & 4) pa_phase(F, l); }
            else if (st == 2) { if (PHM & 8) mixers_phase(F, l); }
            else if (st == 3) { if (PHM & 16) post_phase(F, l); }
            else if (st == 4) { if (PHM & 32) {
                pg8::Gemm g{(const bf16*)(F.ws + WS_MIX), (const bf16*)(wb + W_OUT), MT, DM, DM}; pg8::StaticOrder S; S.init(MT, DM, F.G, F.bid);
                const float* bP = l == 0 ? inp(F, 0) : (const float*)(F.ws + WS_XF); const float* bS = l == 0 ? inp(F, 1) : (const float*)(F.ws + WS_XF) + (size_t)MP * DM;
                pg8::EpiResF32 E{bP, bS, (float*)(F.ws + WS_V), DN_ALPHA, MP, MV};
                pg8::gemm_phase<pg8::EpiResF32, pg8::StaticOrder, true, true>(F.lds, g, S, E); copy_tail(F, l, l * 4 + 2, 0, 128); }
            } else if (st == 5) ln_phase(F, (const float*)(F.ws + WS_V), inp(F, 22) + l * DM, inp(F, 23) + l * DM, (float*)(F.ws + WS_X1F), (float*)(F.ws + WS_X1F) + (size_t)MP * DM, (bf16*)(F.ws + WS_X1B));
            else if (st == 6) { if (PHM & 64) {
                pg8::Gemm g{(const bf16*)(F.ws + WS_X1B), (const bf16*)(wb + W_GU), MT, NGU, DM}; pg8::StaticOrder S; S.init(MT, NGU, F.G, F.bid);
                pg8::EpiSwiglu E{(bf16*)(F.ws + WS_HFF), DFF};
                pg8::gemm_phase<pg8::EpiSwiglu, pg8::StaticOrder, true, true>(F.lds, g, S, E); }
            } else if (st == 7) { if (PHM & 128) {
                pg8::Gemm g{(const bf16*)(F.ws + WS_HFF), (const bf16*)(wb + W_D), MT, DM, DFF}; pg8::StaticOrder S; S.init(MT, DM, F.G, F.bid);
                pg8::EpiResF32 E{(const float*)(F.ws + WS_X1F), (const float*)(F.ws + WS_X1F) + (size_t)MP * DM, (float*)(F.ws + WS_V), DN_ALPHA, MP, MV};
                pg8::gemm_phase<pg8::EpiResF32, pg8::StaticOrder, true, true>(F.lds, g, S, E); copy_tail(F, l, l * 4 + 3, 128, 512); }
            } else {
                if (l == 0) ln_phase(F, (const float*)(F.ws + WS_V), inp(F, 27) + l * DM, inp(F, 28) + l * DM, (float*)(F.ws + WS_XF), (float*)(F.ws + WS_XF) + (size_t)MP * DM, (bf16*)(F.ws + WS_XB));
                else ln_phase(F, (const float*)(F.ws + WS_V), inp(F, 27) + l * DM, inp(F, 28) + l * DM, F.out + O_YP, F.out + O_YS, nullptr);
            }
        }
        }
        if (ph + 1 < args.ph_hi) { XcdBarrier b2 = bar; unsigned* bb = bar.bar; unsigned xx = bar.x; asm volatile("" : "+s"(bb), "+s"(xx)); b2.bar = bb; b2.x = xx; xcd_barrier(b2); }
    }
}

#ifndef MK_SPLIT
#define MK_SPLIT 0
#endif
extern "C" void kernel_launch(void* const* d_in, const int* in_sizes, int n_in, void* d_out, int out_size, void* d_ws, size_t ws_size, hipStream_t stream) {
    static int grid = 0;
    if (grid == 0) {
        if (n_in != 29 || out_size != (int)O_END || ws_size < WS_END) { fprintf(stderr, "kernel_launch: unexpected shapes (n_in %d out %d ws %zu)\n", n_in, out_size, ws_size); grid = -1; return; }
        int dev = 0, cus = 0, per_cu = 0;
        if (hipGetDevice(&dev) != hipSuccess || hipDeviceGetAttribute(&cus, hipDeviceAttributeMultiprocessorCount, dev) != hipSuccess) { grid = -1; return; }
        if (hipFuncSetAttribute((const void*)mk_fwd, hipFuncAttributeMaxDynamicSharedMemorySize, LDS_BYTES) != hipSuccess) { fprintf(stderr, "kernel_launch: hipFuncSetAttribute failed\n"); grid = -1; return; }
        if (hipOccupancyMaxActiveBlocksPerMultiprocessor(&per_cu, (const void*)mk_fwd, NTHR, LDS_BYTES) != hipSuccess || per_cu < 1) { fprintf(stderr, "kernel_launch: occupancy query says %d blocks per CU\n", per_cu); (void)hipGetLastError(); grid = -1; return; }
        grid = cus;
        if (grid != 256) { fprintf(stderr, "kernel_launch: built for 256 CUs, device has %d\n", cus); grid = -1; return; }
    }
    if (grid < 0) return;
    (void)hipMemsetAsync((char*)d_ws + WS_CTL, 0, CTL_ZERO_BYTES, stream);
    Args a{};
    for (int i = 0; i < 29; ++i) a.in[i] = (const float*)d_in[i];
    a.out = (float*)d_out; a.ws = (unsigned char*)d_ws;
#if MK_SPLIT
    for (int ph = 0; ph < NPHASE; ++ph) { a.ph_lo = ph; a.ph_hi = ph + 1; hipLaunchKernelGGL(mk_fwd, dim3(grid), dim3(NTHR), LDS_BYTES, stream, a); }
#else
    a.ph_lo = 0; a.ph_hi = NPHASE; hipLaunchKernelGGL(mk_fwd, dim3(grid), dim3(NTHR), LDS_BYTES, stream, a);
#endif
}
```

```cpp
#include <hip/hip_runtime.h>
#include <cstdio>
#include <cstdint>
namespace pg8 {
#define PG8_LAS __attribute__((address_space(3)))
typedef unsigned short bf16_t;
typedef short bf16x8 __attribute__((ext_vector_type(8)));
typedef float f32x4 __attribute__((ext_vector_type(4)));
typedef unsigned u32x4 __attribute__((ext_vector_type(4)));
constexpr int BM = 256, BK = 64, HALF = 128, HTB = HALF * BK * 2  , STAGE_BYTES = 8 * HTB, NXCD = 8, WGM = 8;

__host__ __device__ __forceinline__ int lds_byte(int r, int c) { const int st = (r >> 4) * 2 + (c >> 5), rr = r & 15, cc = c & 31, ob = rr * 64 + cc * 2; return st * 1024 + (ob ^ (((ob >> 9) & 1) << 5)); }
__host__ __device__ __forceinline__ void stage_rc(int b, int& R, int& C) { const int st = b / 1024, sb = b % 1024, swz = sb ^ (((sb >> 9) & 1) << 5); R = (st >> 1) * 16 + swz / 64; C = (st & 1) * 32 + (swz % 64) / 2; }
__host__ __device__ __forceinline__ int perm32(int rho) { const int n = rho >> 4, i = rho & 15; return 8 * (i >> 2) + 4 * n + (i & 3); }

struct Unit { int pm, pn; };
struct Gemm { const bf16_t* A; const bf16_t* Bt; int M, N, K; };

struct StaticOrder {
    int nM, nN, nwg, G, c;
    __host__ __device__ void init(int M, int N, int G_, int c_) { nM = M / BM; nN = N / BM; nwg = nM * nN; G = G_; c = c_; }
    __host__ __device__ bool next(int i, Unit& u) const {
        const long L = (long)i * G + c; if (L >= nwg) return false;
        int wgid = (int)L; { const int q = nwg / NXCD, r = nwg % NXCD, xcd = wgid % NXCD, off = wgid / NXCD; wgid = (xcd < r ? xcd * (q + 1) : r * (q + 1) + (xcd - r) * q) + off; }
        const int nig = WGM * nN, gid = wgid / nig, fm = gid * WGM, gsz = (nM - fm) < WGM ? (nM - fm) : WGM;
        u.pm = fm + ((wgid % nig) % gsz); u.pn = (wgid % nig) / gsz; return true;
    }
    __device__ __forceinline__ void a_ready(const Unit&) const {}
    __device__ __forceinline__ void done(const Unit&) const {}
};

__device__ __forceinline__ unsigned cvt_pk_bf16(float lo, float hi) { unsigned r; asm volatile("v_cvt_pk_bf16_f32 %0, %1, %2" : "=v"(r) : "v"(lo), "v"(hi)); return r; }
typedef float f32x2 __attribute__((ext_vector_type(2)));

struct EpiH {
    static constexpr bool PERM = true, AFTER_DRAIN = false;
    bf16_t* O; int ldc;
    __device__ __forceinline__ void operator()(const f32x4 (&acc)[2][2][4][2], const Unit& u, int wr, int wc, int fr, int fq) const {
        const int row0 = u.pm * BM + wr * 64 + fr, col0 = u.pn * BM + wc * 32 + 8 * fq;
#pragma unroll
        for (int ai = 0; ai < 2; ++ai)
#pragma unroll
            for (int m = 0; m < 4; ++m) { bf16_t* rowp = O + (size_t)(row0 + ai * HALF + m * 16) * ldc + col0;
#pragma unroll
                for (int bj = 0; bj < 2; ++bj) { const f32x4 v0 = acc[ai][bj][m][0], v1 = acc[ai][bj][m][1];
                    u32x4 w; w.x = cvt_pk_bf16(v0[0], v0[1]); w.y = cvt_pk_bf16(v0[2], v0[3]); w.z = cvt_pk_bf16(v1[0], v1[1]); w.w = cvt_pk_bf16(v1[2], v1[3]);
                    *(u32x4*)(rowp + bj * HALF) = w; } }
    }
};
__device__ __forceinline__ float silu_f(float x) { return x * __builtin_amdgcn_rcpf(1.0f + __builtin_amdgcn_exp2f(-1.4426950408889634f * x)); }
struct EpiSwiglu {
    static constexpr bool PERM = true, AFTER_DRAIN = false;
    bf16_t* O; int ldc;
    __device__ __forceinline__ void operator()(const f32x4 (&acc)[2][2][4][2], const Unit& u, int wr, int wc, int fr, int fq) const {
        const int row0 = u.pm * BM + wr * 64 + fr, col0 = u.pn * HALF + wc * 32 + 8 * fq;
#pragma unroll
        for (int ai = 0; ai < 2; ++ai)
#pragma unroll
            for (int m = 0; m < 4; ++m) { bf16_t* rowp = O + (size_t)(row0 + ai * HALF + m * 16) * ldc + col0;
                const f32x4 g0 = acc[ai][0][m][0], g1 = acc[ai][0][m][1], u0 = acc[ai][1][m][0], u1 = acc[ai][1][m][1];
                u32x4 w; w.x = cvt_pk_bf16(silu_f(g0[0]) * u0[0], silu_f(g0[1]) * u0[1]); w.y = cvt_pk_bf16(silu_f(g0[2]) * u0[2], silu_f(g0[3]) * u0[3]);
                w.z = cvt_pk_bf16(silu_f(g1[0]) * u1[0], silu_f(g1[1]) * u1[1]); w.w = cvt_pk_bf16(silu_f(g1[2]) * u1[2], silu_f(g1[3]) * u1[3]);
                *(u32x4*)rowp = w; }
    }
};
struct EpiResF32 {
    static constexpr bool PERM = false, AFTER_DRAIN = false;
    const float* baseP; const float* baseS; float* V; float alpha; int mp, mv;
    __device__ __forceinline__ void operator()(const f32x4 (&acc)[2][2][4][2], const Unit& u, int wr, int wc, int fr, int fq) const {
        const int row0 = u.pm * BM + wr * 64 + fr, col0 = u.pn * BM + wc * 32 + 4 * fq;
#pragma unroll
        for (int ai = 0; ai < 2; ++ai)
#pragma unroll
            for (int m = 0; m < 4; ++m) { const int row = row0 + ai * HALF + m * 16;
                if (row < mv) { const float* bp = (row < mp ? baseP + (size_t)row * 1024 : baseS + (size_t)(row - mp) * 1024) + col0; float* vp = V + (size_t)row * 1024 + col0;
#pragma unroll
                    for (int bj = 0; bj < 2; ++bj)
#pragma unroll
                        for (int n = 0; n < 2; ++n) { const f32x4 b = *(const f32x4*)(bp + bj * HALF + n * 16); *(f32x4*)(vp + bj * HALF + n * 16) = b * alpha + acc[ai][bj][m][n]; } } }
    }
};
template <class Epi, class Sched, bool ALIGN_EPI = false, bool SP2 = false>
__device__ __forceinline__ void gemm_phase(PG8_LAS unsigned char* lds, const Gemm g, const Sched& S, const Epi& E) {
    int tid_ = threadIdx.x; asm volatile("" : "+v"(tid_));
    const int tid = tid_, wid = __builtin_amdgcn_readfirstlane(tid >> 6), lane = tid & 63, wr = wid >> 2, wc = wid & 3, fr = lane & 15, fq = lane >> 4;
    const int K = g.K, nt = K / BK;
    unsigned voffA[2], voffB[2];
#pragma unroll
    for (int i = 0; i < 2; ++i) { int R, C; stage_rc(tid * 16 + i * 8192, R, C); const int Rb = Epi::PERM ? ((R & ~31) + perm32(R & 31)) : R;
        voffA[i] = (unsigned)(R * K + C) * 2u; voffB[i] = (unsigned)(Rb * K + C) * 2u; }
    const size_t kstep = (size_t)(BK * 2);
    const size_t hstep = (size_t)HALF * K * 2;
    const size_t tstep = 2 * hstep;
    const unsigned ldsw = (unsigned)wid * 1024u;
    const int aoff = lds_byte(wr * 64 + fr, fq * 8), boff = lds_byte(wc * 32 + fr, fq * 8);
#define PG8_SA(b, h) (((b) * 2 + (h)) * HTB)
#define PG8_SB(b, h) ((4 + (b) * 2 + (h)) * HTB)
#define PG8_STAGE(bufoff, gbase, voff) do { _Pragma("unroll") for (int _i = 0; _i < 2; ++_i) \
        __builtin_amdgcn_global_load_lds((const unsigned*)((const char*)(gbase) + (voff)[_i]), (PG8_LAS unsigned*)(lds + (bufoff) + ldsw + _i * 8192), 16, 0, 0); } while (0)
#define PG8_LDA(dst, b, h) do { _Pragma("unroll") for (int m = 0; m < 4; ++m) _Pragma("unroll") for (int k = 0; k < 2; ++k) dst[m][k] = *(const PG8_LAS bf16x8*)(lds + PG8_SA(b, h) + aoff + m * 2048 + k * 1024); } while (0)
#define PG8_LDB(dst, b, h) do { _Pragma("unroll") for (int n = 0; n < 2; ++n) _Pragma("unroll") for (int k = 0; k < 2; ++k) dst[n][k] = *(const PG8_LAS bf16x8*)(lds + PG8_SB(b, h) + boff + n * 2048 + k * 1024); } while (0)
#define PG8_MMA(ai, bj, At, Bt) do { __builtin_amdgcn_s_setprio(1); _Pragma("unroll") for (int m = 0; m < 4; ++m) _Pragma("unroll") for (int n = 0; n < 2; ++n) _Pragma("unroll") for (int k = 0; k < 2; ++k) \
        acc[ai][bj][m][n] = __builtin_amdgcn_mfma_f32_16x16x32_bf16(Bt[n][k], At[m][k], acc[ai][bj][m][n], 0, 0, 0); __builtin_amdgcn_s_setprio(0); } while (0)
#define PG8_WAIT_V(n) asm volatile("s_waitcnt vmcnt(" #n ")" ::: "memory")
#define PG8_WAIT_L(n) asm volatile("s_waitcnt lgkmcnt(" #n ")" ::: "memory")
#define PG8_BAR __builtin_amdgcn_s_barrier()
#define PG8_SCHED __builtin_amdgcn_sched_barrier(0)
    Unit cur, nxt; int ui = 0;
    if (!S.next(0, cur)) return;
    f32x4 acc[2][2][4][2];
#pragma unroll
    for (int a = 0; a < 2; ++a)
#pragma unroll
        for (int b = 0; b < 2; ++b)
#pragma unroll
            for (int m = 0; m < 4; ++m)
#pragma unroll
                for (int n = 0; n < 2; ++n) acc[a][b][m][n] = (f32x4){0.f, 0.f, 0.f, 0.f};
    bf16x8 At[4][2], B0[2][2], B1[2][2];
    const char* cA = (const char*)g.A + (size_t)cur.pm * tstep; const char* cB = (const char*)g.Bt + (size_t)cur.pn * tstep;
    S.a_ready(cur);
    if constexpr (SP2) {
        PG8_STAGE(PG8_SB(0, 0), cB, voffB); PG8_STAGE(PG8_SB(0, 1), cB + hstep, voffB); PG8_STAGE(PG8_SA(0, 0), cA, voffA); PG8_STAGE(PG8_SA(0, 1), cA + hstep, voffA);
        if (wr == 1) PG8_BAR;
        PG8_WAIT_V(2); PG8_BAR;
        PG8_STAGE(PG8_SB(1, 0), cB + kstep, voffB); PG8_STAGE(PG8_SA(1, 0), cA + kstep, voffA); PG8_STAGE(PG8_SB(1, 1), cB + hstep + kstep, voffB);
        PG8_WAIT_V(6); PG8_BAR;
    } else {
        PG8_STAGE(PG8_SB(0, 0), cB, voffB); PG8_STAGE(PG8_SA(0, 0), cA, voffA); PG8_STAGE(PG8_SB(0, 1), cB + hstep, voffB); PG8_STAGE(PG8_SA(0, 1), cA + hstep, voffA);
        if (wr == 1) PG8_BAR;
        PG8_WAIT_V(4); PG8_BAR;
        PG8_STAGE(PG8_SB(1, 0), cB + kstep, voffB); PG8_STAGE(PG8_SA(1, 0), cA + kstep, voffA); PG8_STAGE(PG8_SB(1, 1), cB + hstep + kstep, voffB);
        PG8_WAIT_V(6); PG8_BAR;
    }
    for (;;) {
        const bool has_next = S.next(ui + 1, nxt);
        const char* nA = has_next ? (const char*)g.A + (size_t)nxt.pm * tstep : cA; const char* nB = has_next ? (const char*)g.Bt + (size_t)nxt.pn * tstep : cB;
        for (int t = 0; t < nt; t += 2) {
            const bool last = (t == nt - 2);
            const char* a1 = cA + (size_t)(t + 1) * kstep;
            const char* a2 = last ? nA : cA + (size_t)(t + 2) * kstep; const char* b2 = last ? nB : cB + (size_t)(t + 2) * kstep;
            const char* a3 = a2 + kstep; const char* b3 = b2 + kstep;
            if (last && has_next) S.a_ready(nxt);
            if constexpr (SP2) {
            PG8_LDB(B0, 0, 0); PG8_LDB(B1, 0, 1); PG8_SCHED; PG8_LDA(At, 0, 0); PG8_STAGE(PG8_SA(1, 1), a1 + hstep, voffA);
            PG8_WAIT_V(8); PG8_WAIT_L(0); PG8_BAR; PG8_MMA(0, 0, At, B0); PG8_MMA(0, 1, At, B1); PG8_BAR; PG8_SCHED;
            PG8_LDA(At, 0, 1); PG8_STAGE(PG8_SB(0, 0), b2, voffB); PG8_STAGE(PG8_SB(0, 1), b2 + hstep, voffB); PG8_STAGE(PG8_SA(0, 0), a2, voffA);
            PG8_WAIT_V(8); PG8_WAIT_L(0); PG8_BAR; PG8_MMA(1, 0, At, B0); PG8_MMA(1, 1, At, B1); PG8_BAR; PG8_SCHED;
            PG8_LDB(B0, 1, 0); PG8_LDB(B1, 1, 1); PG8_SCHED; PG8_LDA(At, 1, 0); PG8_STAGE(PG8_SA(0, 1), a2 + hstep, voffA);
            PG8_WAIT_V(8); PG8_WAIT_L(0); PG8_BAR; PG8_MMA(0, 0, At, B0); PG8_MMA(0, 1, At, B1); PG8_BAR; PG8_SCHED;
            PG8_LDA(At, 1, 1); PG8_STAGE(PG8_SB(1, 0), b3, voffB); PG8_STAGE(PG8_SB(1, 1), b3 + hstep, voffB); PG8_STAGE(PG8_SA(1, 0), a3, voffA);
            PG8_WAIT_V(8); PG8_WAIT_L(0); PG8_BAR; PG8_MMA(1, 0, At, B0); PG8_MMA(1, 1, At, B1); PG8_BAR; PG8_SCHED;
            } else {
            PG8_LDB(B0, 0, 0); PG8_SCHED; PG8_LDA(At, 0, 0); PG8_STAGE(PG8_SA(1, 1), a1 + hstep, voffA);
            PG8_WAIT_L(8); PG8_BAR; PG8_WAIT_L(0); PG8_MMA(0, 0, At, B0); PG8_BAR; PG8_SCHED;
            PG8_LDB(B1, 0, 1); PG8_STAGE(PG8_SB(0, 0), b2, voffB);
            PG8_BAR; PG8_WAIT_L(0); PG8_MMA(0, 1, At, B1); PG8_BAR;
            PG8_LDA(At, 0, 1); PG8_STAGE(PG8_SA(0, 0), a2, voffA);
            PG8_BAR; PG8_WAIT_L(0); PG8_MMA(1, 0, At, B0); PG8_BAR; PG8_SCHED;
            PG8_STAGE(PG8_SB(0, 1), b2 + hstep, voffB);
            PG8_WAIT_V(6); PG8_BAR; PG8_MMA(1, 1, At, B1); PG8_BAR;
            PG8_LDB(B0, 1, 0); PG8_SCHED; PG8_LDA(At, 1, 0); PG8_STAGE(PG8_SA(0, 1), a2 + hstep, voffA);
            PG8_WAIT_L(8); PG8_BAR; PG8_WAIT_L(0); PG8_MMA(0, 0, At, B0); PG8_BAR; PG8_SCHED;
            PG8_LDB(B1, 1, 1); PG8_STAGE(PG8_SB(1, 0), b3, voffB);
            PG8_BAR; PG8_WAIT_L(0); PG8_MMA(0, 1, At, B1); PG8_BAR;
            PG8_LDA(At, 1, 1); PG8_STAGE(PG8_SA(1, 0), a3, voffA);
            PG8_BAR; PG8_WAIT_L(0); PG8_MMA(1, 0, At, B0); PG8_BAR; PG8_SCHED;
            PG8_STAGE(PG8_SB(1, 1), b3 + hstep, voffB);
            PG8_WAIT_V(6); PG8_BAR; PG8_MMA(1, 1, At, B1); PG8_BAR;
            }
        }
        if constexpr (ALIGN_EPI) { if (wr == 0) PG8_BAR; }
        if constexpr (!Epi::AFTER_DRAIN) { E(acc, cur, wr, wc, fr, fq); S.done(cur); }
        if (!has_next) break;
#pragma unroll
        for (int a = 0; a < 2; ++a)
#pragma unroll
            for (int b = 0; b < 2; ++b)
#pragma unroll
                for (int m = 0; m < 4; ++m)
#pragma unroll
                    for (int n = 0; n < 2; ++n) acc[a][b][m][n] = (f32x4){0.f, 0.f, 0.f, 0.f};
        cur = nxt; cA = nA; cB = nB; ++ui;
        if constexpr (ALIGN_EPI) { if (wr == 1) PG8_BAR; }
    }
    PG8_WAIT_V(0);
    if constexpr (!ALIGN_EPI) { if (wr == 0) PG8_BAR; }
    PG8_BAR;
    if constexpr (Epi::AFTER_DRAIN) { E.fused(acc, cur, wr, wc, fr, fq, lds, wid, lane); S.done(cur); }
#undef PG8_SA
#undef PG8_SB
#undef PG8_STAGE
#undef PG8_LDA
#undef PG8_LDB
#undef PG8_MMA
#undef PG8_WAIT_V
#undef PG8_WAIT_L
#undef PG8_BAR
#undef PG8_SCHED
}
}
#define GAS __attribute__((address_space(1)))
#define LAS __attribute__((address_space(3)))
typedef unsigned short bf16;
typedef unsigned v4u __attribute__((ext_vector_type(4)));
typedef float f32x4 __attribute__((ext_vector_type(4)));
typedef short bf16x8 __attribute__((ext_vector_type(8)));
typedef GAS unsigned gu32;
typedef GAS unsigned long long gu64;
#define RLX_AGENT __ATOMIC_RELAXED, __HIP_MEMORY_SCOPE_AGENT
#define LDS_WAIT() asm volatile("s_waitcnt lgkmcnt(0)" ::: "memory")
#define VM_WAIT() asm volatile("s_waitcnt vmcnt(0)" ::: "memory")
__device__ __forceinline__ unsigned long long rt() { return __builtin_amdgcn_s_memrealtime(); }

typedef float f32x2_t __attribute__((ext_vector_type(2))); typedef __bf16 bf16x2_t __attribute__((ext_vector_type(2)));
__device__ __forceinline__ unsigned pk2(float lo, float hi) { f32x2_t v = {lo, hi}; bf16x2_t b = __builtin_convertvector(v, bf16x2_t); return __builtin_bit_cast(unsigned, b); }
__device__ __forceinline__ unsigned f2bf(float f) { return pk2(f, f) & 0xffffu; }
#define XB_TMO      128
#define XB_XCNT(j)  (256  + 64 * (j))
#define XB_XSUB(j)  (1280 + 64 * (j))
#define XB_XGEN(j)  (2304 + 64 * (j))
#define XB_TOP      3328
#define XB_TOPGEN   3392
#define XCD_BAR_WORDS 3456
#define XB_SPIN_CAP (1u << 18)

__device__ __forceinline__ unsigned xb_ld(unsigned* p)              { return __hip_atomic_load(p, __ATOMIC_RELAXED, __HIP_MEMORY_SCOPE_AGENT); }
__device__ __forceinline__ unsigned xb_add(unsigned* p, unsigned v) { return __hip_atomic_fetch_add(p, v, __ATOMIC_RELAXED, __HIP_MEMORY_SCOPE_AGENT); }
__device__ __forceinline__ unsigned xb_xcc_id() { return (unsigned)__builtin_amdgcn_s_getreg((3 << 11) | 20) & 0xFu; }
#define XB_SPIN(cond, bar) do { unsigned _sp = 0; while (cond) { __builtin_amdgcn_s_sleep(1); \
    if ((++_sp & 255u) == 0u) { if (xb_ld(&(bar)[XB_TMO])) break; if (_sp > XB_SPIN_CAP) { atomicAdd(&(bar)[XB_TMO], 1u); break; } } } } while (0)

struct XcdBarrier {
    unsigned* bar; unsigned x;
    volatile LAS unsigned* st;
};

__device__ __forceinline__ XcdBarrier xcd_barrier_post(unsigned* bar, volatile LAS unsigned* st) {
    XcdBarrier b; b.bar = bar; b.x = xb_xcc_id(); b.st = st;
    if (threadIdx.x == 0) (void)xb_add(&bar[XB_XCNT(b.x)], 1u);
    return b;
}
__device__ __forceinline__ void xcd_barrier_complete(unsigned* bar, unsigned x, unsigned& nloc, unsigned& nx) {
    const unsigned G = gridDim.x * gridDim.y * gridDim.z;
    unsigned sum, cnt, mine, sp = 0u;
    for (;;) {
        sum = 0u; cnt = 0u; mine = 0u;
#pragma unroll
        for (unsigned j = 0; j < 16; ++j) { const unsigned c = xb_ld(&bar[XB_XCNT(j)]); sum += c; cnt += (c > 0u) ? 1u : 0u; mine = (j == x) ? c : mine; }
        if (sum == G) break;
        __builtin_amdgcn_s_sleep(1);
        if ((++sp & 255u) == 0u) { if (xb_ld(&bar[XB_TMO])) break; if (sp > XB_SPIN_CAP) { atomicAdd(&bar[XB_TMO], 1u); break; } }
    }
    nloc = mine > 0u ? mine : 1u; nx = cnt > 0u ? cnt : 1u;
}

__device__ __forceinline__ void xcd_barrier(const XcdBarrier& b) {
    asm volatile("s_waitcnt vmcnt(0)" ::: "memory");
    __syncthreads();
    if (threadIdx.x == 0) {
        unsigned* bar = b.bar;
        __builtin_amdgcn_s_waitcnt(0);
        unsigned nloc = b.st[0], nx = b.st[1];
        if (nloc == 0u) { xcd_barrier_complete(bar, b.x, nloc, nx); b.st[0] = nloc; b.st[1] = nx; }
        const unsigned old = xb_add(&bar[XB_XSUB(b.x)], 1u);
        const unsigned gen = old / nloc;
        if (old + 1u == (gen + 1u) * nloc) {
            __builtin_amdgcn_fence(__ATOMIC_RELEASE, "agent");
            asm volatile("s_waitcnt vmcnt(0)" ::: "memory");
            const unsigned og = xb_add(&bar[XB_TOP], 1u);
            const unsigned tg = og / nx;
            if (og + 1u == (tg + 1u) * nx) xb_add(&bar[XB_TOPGEN], 1u);
            else XB_SPIN(xb_ld(&bar[XB_TOPGEN]) == tg, bar);
            __builtin_amdgcn_fence(__ATOMIC_ACQUIRE, "agent");
            xb_add(&bar[XB_XGEN(b.x)], 1u);
            asm volatile("s_waitcnt vmcnt(0)" ::: "memory");
        } else {
            XB_SPIN(xb_ld(&bar[XB_XGEN(b.x)]) == gen, bar);
            __builtin_amdgcn_fence(__ATOMIC_ACQUIRE, "agent");
            asm volatile("s_waitcnt vmcnt(0)" ::: "memory");
        }
    }
    __syncthreads();
}

constexpr int DM = 1024, SEQ = 4096, NBP = 4, MP = NBP * SEQ, NBS = 32, TS = 4, MS = NBS * TS, MV = MP + MS, MT = 65 * 256;
constexpr int IN_COLS = 3584, A_COLS = 1408, WA = 384, DFF = 2816, NGU = 2 * DFF, WBUF = 2048;
constexpr int COL_QB = 1408, COL_KB = 1792, COL_VB = 2176, COL_QC = 2560, COL_KC = 2816, COL_VC = 3072, COL_GC = 3328;
constexpr float DN_ALPHA = 1.4142135623730951f;
constexpr float LN_EPS = 1e-5f, GN_EPS_A = 64e-5f, DECAY_SCALE = 0.6065306597126334f;
constexpr int NPOS = SEQ + TS;
constexpr size_t O_YP = 0, O_YS = O_YP + (size_t)MP * DM, O_PSHIFT = O_YS + (size_t)MS * DM, O_PWKV = O_PSHIFT + 2 * NBP * A_COLS, O_PWINK = O_PWKV + 2 * NBP * 6 * 4096,
                 O_PWINV = O_PWINK + (size_t)2 * NBP * WBUF * 384, O_PRET = O_PWINV + (size_t)2 * NBP * WBUF * 384, O_SSHIFT = O_PRET + 2 * NBP * 4 * 4096,
                 O_SWKV = O_SSHIFT + 2 * NBS * A_COLS, O_SWINK = O_SWKV + 2 * NBS * 6 * 4096, O_SWINV = O_SWINK + (size_t)2 * NBS * WBUF * 384,
                 O_SRET = O_SWINV + (size_t)2 * NBS * WBUF * 384, O_END = O_SRET + 2 * NBS * 4 * 4096;
static_assert(O_END == 133204992, "output size");
constexpr size_t MiB = 1u << 20;
constexpr size_t WS_CTL = 0, CTL_ZERO_BYTES = 1 * MiB, WS_TAB = 1 * MiB, WS_W = 4 * MiB, LW = 26 * MiB;
constexpr size_t W_IN = 0, W_OUT = W_IN + (size_t)IN_COLS * DM * 2, W_GU = W_OUT + (size_t)DM * DM * 2, W_D = W_GU + (size_t)NGU * DM * 2, W_WL = W_D + (size_t)DM * DFF * 2,
                 W_AL = W_WL + (size_t)WA * 64 * 2, W_GL = W_AL + (size_t)WA * 64 * 2, W_LEND = W_GL + (size_t)WA * 128 * 2;
static_assert(W_LEND <= LW, "weights");
constexpr size_t WS_XB = 56 * MiB, WS_XF = 89 * MiB, WS_X1F = 154 * MiB, WS_X1B = 219 * MiB, WS_MIX = 252 * MiB, WS_G = 285 * MiB, WS_T0 = 310 * MiB;
constexpr size_t WS_H = WS_T0, WS_CK = 424 * MiB, WS_VX = 496 * MiB, WS_SC = 521 * MiB, WS_KV = 523 * MiB, WS_OC2 = 532 * MiB, WS_ZF = 550 * MiB, WS_OA = 571 * MiB, WS_OB = 596 * MiB, WS_LSE = 670 * MiB, WS_OC = 672 * MiB, WS_RK = 689 * MiB, WS_END = 690 * MiB;
constexpr size_t WS_V = WS_T0, WS_HFF = 375 * MiB;
static_assert(WS_H + (size_t)MT * IN_COLS * 2 <= WS_CK && WS_CK + (size_t)1536 * 49152 <= WS_VX && WS_VX + (size_t)MT * 384 * 4 <= WS_SC && WS_SC + (size_t)MS * 2304 * 4 <= WS_OA && WS_OB + (size_t)3 * MT * 384 * 4 <= WS_LSE && WS_OC + (size_t)MT * 256 * 4 <= WS_RK, "ws map");
static_assert(WS_V + (size_t)MT * DM * 4 <= WS_HFF && WS_HFF + (size_t)MT * DFF * 2 <= WS_END && WS_XF + (size_t)MT * DM * 4 <= WS_X1F && WS_G + (size_t)MT * 384 * 4 <= WS_T0, "ws map 2");
constexpr int TAB_COSB = 0, TAB_SINB = NPOS * 8, TAB_COSC = NPOS * 16, TAB_SINC = NPOS * 48, TAB_END = NPOS * 80;
constexpr int CW_BAR = 4096, CW_Q = 8192;
constexpr int RING_BYTES = 147456, LDSCTL_OFF = RING_BYTES, MISC_OFF = LDSCTL_OFF + 320, INTAB_OFF = LDSCTL_OFF + 1024, LDS_BYTES = RING_BYTES + 2048;
constexpr int NWAVES = 8, NTHR = 512;
constexpr int NST = 9, NPHASE = 1 + 2 * NST;

struct Frame {
    LAS unsigned char* lds; volatile LAS unsigned* MISC; gu32* ctl;
    int tid, lane, wave, G, bid, rep;
    float* out; unsigned char* ws; const float* const* inb; unsigned zoff;
};
__device__ __forceinline__ const float* inp(const Frame& F, int k) { return F.inb[k + F.zoff]; }
__device__ __forceinline__ float bf2f(bf16 v) { return __uint_as_float((unsigned)v << 16); }
__device__ __forceinline__ float wave_sum(float v) {
#pragma unroll
    for (int o = 1; o < 64; o <<= 1) v += __shfl_xor(v, o);
    return v;
}
__device__ __forceinline__ float wave_max(float v) {
#pragma unroll
    for (int o = 1; o < 64; o <<= 1) v = fmaxf(v, __shfl_xor(v, o));
    return v;
}
__device__ __forceinline__ float dpp_f(float x, const int ctrl_sel) {
    const int xi = __float_as_int(x); int r;
    if (ctrl_sel == 0) r = __builtin_amdgcn_update_dpp(xi, xi, 0xB1, 0xF, 0xF, false);
    else if (ctrl_sel == 1) r = __builtin_amdgcn_update_dpp(xi, xi, 0x4E, 0xF, 0xF, false);
    else if (ctrl_sel == 2) r = __builtin_amdgcn_update_dpp(xi, xi, 0x141, 0xF, 0xF, false);
    else r = __builtin_amdgcn_update_dpp(xi, xi, 0x140, 0xF, 0xF, false);
    return __int_as_float(r);
}
__device__ __forceinline__ float red16(float x) { x += dpp_f(x, 0); x += dpp_f(x, 1); x += dpp_f(x, 2); x += dpp_f(x, 3); return x; }
__device__ __forceinline__ float sigmoid_f(float x) { return 1.0f / (1.0f + __expf(-x)); }

__host__ __device__ __forceinline__ int phys_col(int c) {
    if (c >= COL_QB && c < COL_VB) { int d = c & 63; if (d < 16) d = d < 8 ? 2 * d : 2 * (d - 8) + 1; return (c & ~63) + d; }
    if (c >= COL_QC && c < COL_VC) { int d = c & 63; d = d < 32 ? 2 * d : 2 * (d - 32) + 1; return (c & ~63) + d; }
    return c;
}
__host__ __device__ __forceinline__ int dimB(int p) { return p < 16 ? (p >> 1) + 8 * (p & 1) : p; }
__host__ __device__ __forceinline__ int dimC(int p) { return (p >> 1) + 32 * (p & 1); }
template <bool PERMUTE>
__device__ __forceinline__ void p0_transpose_item(const float* W, int K, int N, bf16* WT, int k0, int n0, int drow0, LAS float* scr, int lane) {
#pragma unroll 8
    for (int i = 0; i < 32; ++i) { const int kk = 2 * i + (lane >> 5); scr[kk * 33 + (lane & 31)] = W[(size_t)(k0 + kk) * N + n0 + (lane & 31)]; }
    LDS_WAIT(); asm volatile("" ::: "memory");
    const int c = lane & 7;
#pragma unroll
    for (int j = 0; j < 4; ++j) { const int n = (lane >> 3) + 8 * j; const LAS float* s = scr + (8 * c) * 33 + n;
        v4u o; o.x = pk2(s[0 * 33], s[1 * 33]); o.y = pk2(s[2 * 33], s[3 * 33]); o.z = pk2(s[4 * 33], s[5 * 33]); o.w = pk2(s[6 * 33], s[7 * 33]);
        *(GAS v4u*)(WT + (size_t)(PERMUTE ? phys_col(n0 + n) : drow0 + n) * K + k0 + 8 * c) = o; }
    LDS_WAIT(); asm volatile("" ::: "memory");
}
__device__ __forceinline__ void p0_prologue(Frame& F) {
    LAS float* scr = (LAS float*)(F.lds + F.wave * 16384);
    const int gw = F.bid * NWAVES + F.wave, NGW = F.G * NWAVES;
    constexpr int I_IN = 16 * (IN_COLS / 32), I_OUT = 16 * (DM / 32), I_G = 16 * (DFF / 32), I_D = (DFF / 64) * (DM / 32), I_L = I_IN + I_OUT + 2 * I_G + I_D;
    for (int it = gw; it < 2 * I_L; it += NGW) {
        const int l = it / I_L; int r = it % I_L; bf16* wb = (bf16*)(F.ws + WS_W + (size_t)l * LW);
        if (r < I_IN) { const int nblk = IN_COLS / 32, kb = r / nblk, nb = r % nblk; p0_transpose_item<true>(inp(F, 7) + (size_t)l * DM * IN_COLS, DM, IN_COLS, (bf16*)((char*)wb + W_IN), 64 * kb, 32 * nb, 32 * nb, scr, F.lane); continue; } r -= I_IN;
        if (r < I_OUT) { const int nblk = DM / 32, kb = r / nblk, nb = r % nblk; p0_transpose_item<false>(inp(F, 21) + (size_t)l * DM * DM, DM, DM, (bf16*)((char*)wb + W_OUT), 64 * kb, 32 * nb, 32 * nb, scr, F.lane); continue; } r -= I_OUT;
        if (r < 2 * I_G) { const int up = r >= I_G; if (up) r -= I_G; const int nblk = DFF / 32, kb = r / nblk, nb = r % nblk, n0 = 32 * nb;
            p0_transpose_item<false>((up ? inp(F, 25) : inp(F, 24)) + (size_t)l * DM * DFF, DM, DFF, (bf16*)((char*)wb + W_GU), 64 * kb, n0, (n0 >> 7) * 256 + (n0 & 127) + (up ? 128 : 0), scr, F.lane); continue; } r -= 2 * I_G;
        { const int nblk = DM / 32, kb = r / nblk, nb = r % nblk; p0_transpose_item<false>(inp(F, 26) + (size_t)l * DFF * DM, DFF, DM, (bf16*)((char*)wb + W_D), 64 * kb, 32 * nb, 32 * nb, scr, F.lane); }
    }
    bf16* XB = (bf16*)(F.ws + WS_XB); bf16* MIX = (bf16*)(F.ws + WS_MIX); bf16* X1B = (bf16*)(F.ws + WS_X1B); bf16* HFF = (bf16*)(F.ws + WS_HFF);
    for (int m = gw; m < MT; m += NGW) {
        GAS unsigned long long* o8 = (GAS unsigned long long*)(XB + (size_t)m * DM) + F.lane;
        if (m < MV) { const float* src = m < MP ? inp(F, 0) + (size_t)m * DM : inp(F, 1) + (size_t)(m - MP) * DM; const GAS f32x4* xr = (const GAS f32x4*)src + F.lane;
#pragma unroll
            for (int j = 0; j < 4; ++j) { const f32x4 v = xr[64 * j]; o8[64 * j] = (unsigned long long)pk2(v.x, v.y) | ((unsigned long long)pk2(v.z, v.w) << 32); }
        } else {
#pragma unroll
            for (int j = 0; j < 4; ++j) { o8[64 * j] = 0ull; ((GAS unsigned long long*)(MIX + (size_t)m * DM) + F.lane)[64 * j] = 0ull; ((GAS unsigned long long*)(X1B + (size_t)m * DM) + F.lane)[64 * j] = 0ull; }
            for (int j = F.lane; j < DFF / 4; j += 64) ((GAS unsigned long long*)(HFF + (size_t)m * DFF))[j] = 0ull;
        }
    }
    for (int e = F.bid * NTHR + F.tid; e < 2 * WA * 256; e += F.G * NTHR) {
        const int l = e / (WA * 256), r = e % (WA * 256), n = r >> 8, k = r & 255; unsigned char* wb = F.ws + WS_W + (size_t)l * LW;
        if (k < 64) ((bf16*)(wb + W_WL))[n * 64 + k] = (bf16)f2bf(inp(F, 10)[((size_t)l * 64 + k) * WA + n]);
        else if (k < 128) ((bf16*)(wb + W_AL))[n * 64 + (k - 64)] = (bf16)f2bf(inp(F, 12)[((size_t)l * 64 + (k - 64)) * WA + n]);
        else ((bf16*)(wb + W_GL))[n * 128 + (k - 128)] = (bf16)f2bf(inp(F, 13)[((size_t)l * 128 + (k - 128)) * WA + n]);
    }
    float* tab = (float*)(F.ws + WS_TAB);
    for (int e = F.bid * NTHR + F.tid; e < NPOS * 40; e += F.G * NTHR) {
        const int idx = e / 40, j = e % 40; const float pos = (float)(idx < SEQ ? idx : 8192 + (idx - SEQ));
        if (j < 8) { const float inv = powf(500000.0f, -(float)(2 * j) / 16.0f); const float ang = pos * inv; tab[TAB_COSB + idx * 8 + j] = cosf(ang); tab[TAB_SINB + idx * 8 + j] = sinf(ang); }
        else { const int jj = j - 8; const float inv = 1.0f / powf(10000.0f, (float)jj / 31.0f); const float ang = pos * inv; tab[TAB_COSC + idx * 32 + jj] = cosf(ang); tab[TAB_SINC + idx * 32 + jj] = sinf(ang); }
    }
}


namespace pg8 {
struct EpiHRot {
    static constexpr bool PERM = true, AFTER_DRAIN = false;
    bf16_t* O; int ldc; const float* tab;
    __device__ __forceinline__ void operator()(const f32x4 (&acc)[2][2][4][2], const Unit& u, int wr, int wc, int fr, int fq) const {
        const int row0 = u.pm * BM + wr * 64 + fr;
#pragma unroll
        for (int bj = 0; bj < 2; ++bj) {
            const int cb = u.pn * BM + bj * HALF + wc * 32;
            const int mode = (cb >= COL_QB && cb < COL_VB && (cb & 63) == 0) ? 1 : ((cb >= COL_QC && cb < COL_VC) ? 2 : 0);
            const float scale = (cb >= COL_KC && cb < COL_VC) ? 0.125f : 1.0f;
            const bool rot = mode == 2 || (mode == 1 && fq < 2);
            const int toff = mode == 1 ? 4 * fq : 16 * ((cb >> 5) & 1) + 4 * fq;
#pragma unroll
            for (int ai = 0; ai < 2; ++ai)
#pragma unroll
                for (int m = 0; m < 4; ++m) {
                    const int row = row0 + ai * HALF + m * 16;
                    f32x4 v0 = acc[ai][bj][m][0], v1 = acc[ai][bj][m][1];
                    if (mode != 0) {
                        if (rot) {
                            const int posidx = row < MP ? (row & (SEQ - 1)) : (row < MV ? SEQ + ((row - MP) & 3) : 0);
                            const f32x4 cs = *(const f32x4*)(tab + (mode == 1 ? TAB_COSB + posidx * 8 : TAB_COSC + posidx * 32) + toff);
                            const f32x4 sn = *(const f32x4*)(tab + (mode == 1 ? TAB_SINB + posidx * 8 : TAB_SINC + posidx * 32) + toff);
                            const f32x4 a = v0, b = v1;
                            v0[0] = a[0] * cs[0] - a[1] * sn[0]; v0[1] = a[1] * cs[0] + a[0] * sn[0]; v0[2] = a[2] * cs[1] - a[3] * sn[1]; v0[3] = a[3] * cs[1] + a[2] * sn[1];
                            v1[0] = b[0] * cs[2] - b[1] * sn[2]; v1[1] = b[1] * cs[2] + b[0] * sn[2]; v1[2] = b[2] * cs[3] - b[3] * sn[3]; v1[3] = b[3] * cs[3] + b[2] * sn[3];
                        }
                        v0 = v0 * scale; v1 = v1 * scale;
                    }
                    u32x4 w; w.x = cvt_pk_bf16(v0[0], v0[1]); w.y = cvt_pk_bf16(v0[2], v0[3]); w.z = cvt_pk_bf16(v1[0], v1[1]); w.w = cvt_pk_bf16(v1[2], v1[3]);
                    *(u32x4*)(O + (size_t)row * ldc + cb + 8 * fq) = w;
                }
        }
    }
};
}

__device__ __forceinline__ f32x4 mfma16(bf16x8 a, bf16x8 b, f32x4 c) { return __builtin_amdgcn_mfma_f32_16x16x32_bf16(a, b, c, 0, 0, 0); }

__device__ __forceinline__ void scan_item(Frame& F, const float* SC, float* OA, int scrow0, int rowbase, int T, int h, int half, const float* S0, float* Sout) {
    constexpr int CH = 32;
    LAS float* buf = (LAS float*)F.lds;
    LAS float* vbuf = buf + 2 * CH * 320;
    int tid = F.tid; asm volatile("" : "+v"(tid));
    const int lane = tid & 63, w = F.wave, rg = lane >> 4, j = lane & 15;
    const int vrow = half * 32 + w * 4 + rg;
    float S[4];
    if (S0) { const f32x4 s = *(const f32x4*)(S0 + vrow * 64 + 4 * j); S[0] = s[0]; S[1] = s[1]; S[2] = s[2]; S[3] = s[3]; } else { S[0] = S[1] = S[2] = S[3] = 0.f; }
    const int nch = (T + CH - 1) / CH;
    f32x4 st[5]; float sv[2];
    int sstep[5], soff[5], ldso[5];
#pragma unroll
    for (int i = 0; i < 5; ++i) { const int idx = tid + NTHR * i, step = idx / 80, rem = idx % 80, v5 = rem >> 4, q = rem & 15; const int vid = v5 < 3 ? v5 : v5 + 1;
        sstep[i] = step; soff[i] = vid * 64 + q * 4; ldso[i] = step * 320 + v5 * 64 + q * 4; }
    const int vstep0 = tid >> 5, vr = tid & 31;
#define SCAN_ISSUE(c) do { _Pragma("unroll") for (int i = 0; i < 5; ++i) { const int t = (c) * CH + sstep[i]; st[i] = t < T ? *(const f32x4*)(SC + ((size_t)(scrow0 + t) * 6 + h) * 384 + soff[i]) : (f32x4){0.f, 0.f, 0.f, 0.f}; } \
        _Pragma("unroll") for (int i = 0; i < 2; ++i) { const int t = (c) * CH + vstep0 + 16 * i; sv[i] = t < T ? SC[((size_t)(scrow0 + t) * 6 + h) * 384 + 192 + half * 32 + vr] : 0.f; } } while (0)
#define SCAN_WRITE(bs) do { _Pragma("unroll") for (int i = 0; i < 5; ++i) *(LAS f32x4*)(buf + (bs) * CH * 320 + ldso[i]) = st[i]; \
        _Pragma("unroll") for (int i = 0; i < 2; ++i) vbuf[(bs) * CH * 32 + (vstep0 + 16 * i) * 32 + vr] = sv[i]; } while (0)
    SCAN_ISSUE(0); SCAN_WRITE(0);
    __syncthreads();
    for (int c = 0; c < nch; ++c) {
        const int bs = c & 1;
        if (c + 1 < nch) SCAN_ISSUE(c + 1);
        const int ns = (T - c * CH) < CH ? (T - c * CH) : CH;
        const LAS float* bp = buf + bs * CH * 320 + 4 * j; const LAS float* vp = vbuf + bs * CH * 32 + w * 4 + rg;
        for (int s = 0; s < ns; ++s) {
            const f32x4 r4 = *(const LAS f32x4*)(bp + s * 320), w4 = *(const LAS f32x4*)(bp + s * 320 + 64), k4 = *(const LAS f32x4*)(bp + s * 320 + 128),
                        kk4 = *(const LAS f32x4*)(bp + s * 320 + 192), b4 = *(const LAS f32x4*)(bp + s * 320 + 256);
            const float vv = vp[s * 32];
            float sa = (S[0] * kk4[0] + S[1] * kk4[1]) + (S[2] * kk4[2] + S[3] * kk4[3]);
            sa = red16(sa);
#pragma unroll
            for (int e = 0; e < 4; ++e) S[e] = S[e] * w4[e] + (vv * k4[e] - sa * b4[e]);
            float o = (S[0] * r4[0] + S[1] * r4[1]) + (S[2] * r4[2] + S[3] * r4[3]);
            o = red16(o);
            if (j == 0) OA[(size_t)(rowbase + c * CH + s) * WA + h * 64 + vrow] = o;
        }
        if (c + 1 < nch) SCAN_WRITE(bs ^ 1);
        __syncthreads();
    }
#undef SCAN_ISSUE
#undef SCAN_WRITE
    *(f32x4*)(Sout + vrow * 64 + 4 * j) = (f32x4){S[0], S[1], S[2], S[3]};
}

__device__ __forceinline__ void attn_unit(Frame& F, const bf16* H, float* OB, float* LSE, int unit) {
    const int cls = unit & 31, di = (unit >> 5) % 3, bh = unit / 96, h = bh % 6, b = bh / 6;
    const int d = di == 0 ? 1 : (di == 1 ? 4 : 16), nbk = 32 / d, r = cls / nbk, n = cls % nbk;
    LAS bf16* Kl = (LAS bf16*)F.lds;
    LAS bf16* VT = Kl + 256 * 72;
    int tid = F.tid; asm volatile("" : "+v"(tid));
    const int lane = tid & 63, w = F.wave, g = lane >> 4, lq = lane & 15;
#pragma unroll
    for (int i = 0; i < 4; ++i) {
        const int cid = tid + NTHR * i, ki = cid >> 3, ch = cid & 7, ci = (n - 1) * 128 + ki;
        v4u kv = (v4u){0u, 0u, 0u, 0u}, vv = kv;
        if (ci >= 0) { const size_t row = (size_t)b * SEQ + (size_t)ci * d + r; kv = *(const v4u*)(H + row * IN_COLS + COL_KB + h * 64 + ch * 8); vv = *(const v4u*)(H + row * IN_COLS + COL_VB + h * 64 + ch * 8); }
        *(LAS v4u*)(Kl + ki * 72 + ch * 8) = kv;
        LAS bf16* vt = VT + (ch * 8) * 264 + ki;
        vt[0 * 264] = (bf16)(vv.x & 0xffffu); vt[1 * 264] = (bf16)(vv.x >> 16); vt[2 * 264] = (bf16)(vv.y & 0xffffu); vt[3 * 264] = (bf16)(vv.y >> 16);
        vt[4 * 264] = (bf16)(vv.z & 0xffffu); vt[5 * 264] = (bf16)(vv.z >> 16); vt[6 * 264] = (bf16)(vv.w & 0xffffu); vt[7 * 264] = (bf16)(vv.w >> 16);
    }
    __syncthreads();
    const int qi = 16 * w + lq;
    const size_t qrow = (size_t)b * SEQ + (size_t)(n * 128 + qi) * d + r;
    bf16x8 qf[2];
    qf[0] = *(const bf16x8*)(H + qrow * IN_COLS + COL_QB + h * 64 + 8 * g); qf[1] = *(const bf16x8*)(H + qrow * IN_COLS + COL_QB + h * 64 + 32 + 8 * g);
    f32x4 s[10];
#pragma unroll
    for (int tt = 0; tt < 9; ++tt) {
        const int kt = w + tt; s[tt] = (f32x4){0.f, 0.f, 0.f, 0.f};
#pragma unroll
        for (int ks = 0; ks < 2; ++ks) { const bf16x8 a = *(const LAS bf16x8*)(Kl + (kt * 16 + lq) * 72 + 32 * ks + 8 * g); s[tt] = mfma16(a, qf[ks], s[tt]); }
    }
    s[9] = (f32x4){0.f, 0.f, 0.f, 0.f};
    float m = -1e30f;
#pragma unroll
    for (int tt = 0; tt < 9; ++tt)
#pragma unroll
        for (int e = 0; e < 4; ++e) { const int ki = (w + tt) * 16 + 4 * g + e; const bool ok = ki >= qi && ki <= qi + 128 && (n > 0 || ki >= 128);
            const float sv = ok ? s[tt][e] * 0.125f : -1e30f; s[tt][e] = sv; m = fmaxf(m, sv); }
    m = fmaxf(m, __shfl_xor(m, 16)); m = fmaxf(m, __shfl_xor(m, 32));
    float lsum = 0.f;
#pragma unroll
    for (int tt = 0; tt < 9; ++tt)
#pragma unroll
        for (int e = 0; e < 4; ++e) { const float p = s[tt][e] > -1e29f ? __expf(s[tt][e] - m) : 0.f; s[tt][e] = p; lsum += p; }
    lsum += __shfl_xor(lsum, 16); lsum += __shfl_xor(lsum, 32);
    f32x4 o[4];
#pragma unroll
    for (int dt = 0; dt < 4; ++dt) o[dt] = (f32x4){0.f, 0.f, 0.f, 0.f};
#pragma unroll
    for (int pp = 0; pp < 5; ++pp) {
        const int T0 = 2 * pp, T1 = 2 * pp + 1;
        union { unsigned u[4]; bf16x8 v; } pb;
        pb.u[0] = pk2(s[T0][0], s[T0][1]); pb.u[1] = pk2(s[T0][2], s[T0][3]); pb.u[2] = pk2(s[T1][0], s[T1][1]); pb.u[3] = pk2(s[T1][2], s[T1][3]);
        const int k0 = (w + T0) * 16 + 4 * g, k1 = (w + (T1 < 9 ? T1 : T0)) * 16 + 4 * g;
#pragma unroll
        for (int dt = 0; dt < 4; ++dt) {
            union { unsigned long long q[2]; bf16x8 v; } av;
            av.q[0] = *(const LAS unsigned long long*)(VT + (dt * 16 + lq) * 264 + k0); av.q[1] = *(const LAS unsigned long long*)(VT + (dt * 16 + lq) * 264 + k1);
            o[dt] = mfma16(av.v, pb.v, o[dt]);
        }
    }
    const float inv = 1.0f / lsum;
    float* op = OB + ((size_t)di * MT + qrow) * 384 + h * 64 + 4 * g;
#pragma unroll
    for (int dt = 0; dt < 4; ++dt) *(f32x4*)(op + dt * 16) = o[dt] * inv;
    if (g == 0) LSE[((size_t)di * MT + qrow) * 6 + h] = m + __logf(lsum);
    __syncthreads();
}

__device__ __forceinline__ void copy_item(Frame& F, int l, int item) {
    const int which = item >> 8, b = (item >> 3) & 31, part = item & 7;
    constexpr int N4 = (WBUF - TS) * 384 / 4, P4 = N4 / 8;
    static_assert(N4 % 8 == 0, "copy split");
    const f32x4* src = (const f32x4*)((which ? inp(F, 5) : inp(F, 4)) + (((size_t)l * NBS + b) * WBUF + TS) * 384) + (size_t)part * P4;
    f32x4* dst = (f32x4*)(F.out + (which ? O_SWINV : O_SWINK) + ((size_t)l * NBS + b) * WBUF * 384) + (size_t)part * P4;
    int tid = F.tid; asm volatile("" : "+v"(tid));
    for (int base = tid; base < P4; base += NTHR * 8) {
        f32x4 v[8];
#pragma unroll
        for (int k = 0; k < 8; ++k) { const int i = base + NTHR * k; v[k] = __builtin_nontemporal_load(src + (i < P4 ? i : tid)); }
#pragma unroll
        for (int k = 0; k < 8; ++k) { const int i = base + NTHR * k; if (i < P4) __builtin_nontemporal_store(v[k], dst + i); }
    }
}


constexpr int CK_BYTES = 49152;
constexpr int CK_M = 0, CK_Q = 8192, CK_N = 16384, CK_O = 32768;
constexpr int MS_ = 72;
constexpr int L_XL = 0, L_KKD = 33792, L_RD = L_KKD + 9216, L_KDI = L_RD + 9216, L_BDI = L_KDI + 9216, L_KDET = L_BDI + 9216, L_BDET = L_KDET + 9216, L_VT = L_BDET + 9216,
              L_AUB = L_VT + 9216, L_AUK = L_AUB + 9216, L_AOK = L_AUK + 9216, L_AOB = L_AOK + 9216, L_DG = L_AOB + 9216, L_DI = L_DG + 4 * 16 * 17 * 4, L_TT = L_DI + 4 * 16 * 24 * 2,
              L_LC = L_TT + 1024, L_SS = L_LC + 256, L_END5 = L_SS + 1024;
constexpr int L_UT = L_KDI, L_KT = L_BDI;
constexpr int L_MQ = L_AUB;
static_assert(L_XL + 64 * 264 * 2 <= L_KKD && L_END5 <= RING_BYTES && (L_DI % 16) == 0 && (L_DG % 16) == 0, "rwkv item LDS map");
#define LBAR() asm volatile("s_waitcnt lgkmcnt(0)\n\ts_barrier" ::: "memory")

typedef unsigned u32x2 __attribute__((ext_vector_type(2)));
__device__ __forceinline__ float dpp_shr(float x, const int n) {
    const int xi = __float_as_int(x); int r;
    if (n == 1) r = __builtin_amdgcn_update_dpp(0, xi, 0x111, 0xF, 0xF, true);
    else if (n == 2) r = __builtin_amdgcn_update_dpp(0, xi, 0x112, 0xF, 0xF, true);
    else if (n == 4) r = __builtin_amdgcn_update_dpp(0, xi, 0x114, 0xF, 0xF, true);
    else r = __builtin_amdgcn_update_dpp(0, xi, 0x118, 0xF, 0xF, true);
    return __int_as_float(r);
}
__device__ __forceinline__ float bfw(unsigned w, int e) { return __uint_as_float((e & 1) ? (w & 0xffff0000u) : (w << 16)); }
__device__ __forceinline__ float fsig(float x) { return __builtin_amdgcn_rcpf(1.0f + __builtin_amdgcn_exp2f(-1.4426950408889634f * x)); }
__device__ __forceinline__ float ftanh(float x) { return 1.0f - 2.0f * __builtin_amdgcn_rcpf(1.0f + __builtin_amdgcn_exp2f(2.8853900817779268f * x)); }
__device__ __forceinline__ float fexp(float x) { return __builtin_amdgcn_exp2f(1.4426950408889634f * x); }

__device__ __forceinline__ void rwkv_item(Frame& F, int l, int tile) {
    int tid = F.tid; asm volatile("" : "+v"(tid));
    const int w = F.wave;
    const bool isS = tile >= 256;
    const int R0 = isS ? MP + (tile - 256) * 64 : tile * 64;
    const bf16* H = (const bf16*)(F.ws + WS_H);
    const unsigned char* wb = F.ws + WS_W + (size_t)l * LW;
    const float* mu = inp(F, 8) + l * A_COLS;
    LAS unsigned char* lds = F.lds;
    {
        const int tok = tid >> 3, cg = tid & 7, row = R0 + tok, col0 = 1152 + cg * 32;
        const bf16* hc = H + (size_t)row * IN_COLS + col0;
        bool zero_prev = false; const float* sp = nullptr;
        if (!isS) zero_prev = (row & (SEQ - 1)) == 0; else if (((row - MP) & 3) == 0) sp = inp(F, 2) + ((size_t)l * NBS + ((row - MP) >> 2)) * A_COLS + col0;
        v4u cu[4], pu[4];
#pragma unroll
        for (int q = 0; q < 4; ++q) { cu[q] = *(const v4u*)(hc + q * 8); pu[q] = (v4u){0u, 0u, 0u, 0u}; if (!zero_prev && !sp) pu[q] = *(const v4u*)(hc - IN_COLS + q * 8); }
#pragma unroll
        for (int q = 0; q < 4; ++q) {
            const unsigned cw[4] = {cu[q].x, cu[q].y, cu[q].z, cu[q].w}, pw[4] = {pu[q].x, pu[q].y, pu[q].z, pu[q].w};
            const f32x4 m0 = *(const f32x4*)(mu + col0 + q * 8), m1 = *(const f32x4*)(mu + col0 + q * 8 + 4);
            float xo[8];
#pragma unroll
            for (int e = 0; e < 8; ++e) {
                const float c = bfw(cw[e >> 1], e & 1); float p = bfw(pw[e >> 1], e & 1);
                if (sp) p = sp[q * 8 + e];
                float x = c + (p - c) * (e < 4 ? m0[e & 3] : m1[e & 3]);
                if (cg < 2) x = ftanh(x); else if (cg >= 4) x = fsig(x);
                xo[e] = x;
            }
            v4u o; o.x = pk2(xo[0], xo[1]); o.y = pk2(xo[2], xo[3]); o.z = pk2(xo[4], xo[5]); o.w = pk2(xo[6], xo[7]);
            *(LAS v4u*)(lds + L_XL + (tok * 264 + cg * 32 + q * 8) * 2) = o;
        }
    }
    LBAR();
    const int mt = w & 3, cth = w >> 2;
    const bf16* WlT = (const bf16*)(wb + W_WL); const bf16* AlT = (const bf16*)(wb + W_AL); const bf16* GlT = (const bf16*)(wb + W_GL);
    const float* w0 = inp(F, 9) + l * WA; const float* a0 = inp(F, 11) + l * WA; const float* kkw = inp(F, 14) + l * WA; const float* kaw = inp(F, 15) + l * WA; const float* rkw = inp(F, 16) + l * WA;
  for (int h = 0; h < 6; ++h) {
    int tidh = tid; asm volatile("" : "+v"(tidh));
    const int lane = tidh & 63, g = lane >> 4, lq = lane & 15, tk = mt * 16 + lq, row = R0 + tk;
    bool zero_prev = false; const float* sp = nullptr;
    if (!isS) zero_prev = (row & (SEQ - 1)) == 0; else if (((row - MP) & 3) == 0) sp = inp(F, 2) + ((size_t)l * NBS + ((row - MP) >> 2)) * A_COLS;
    float lwv[8], L[8], xr[8], k2[8], kk[8], bb[8];
    {
        f32x4 dw[2], da[2], dg[2];
#pragma unroll
        for (int cl = 0; cl < 2; ++cl) { const int ct = 2 * cth + cl; dw[cl] = (f32x4){0.f, 0.f, 0.f, 0.f}; da[cl] = dw[cl]; dg[cl] = dw[cl];
#pragma unroll
            for (int ks = 0; ks < 2; ++ks) {
                const bf16x8 a1 = *(const bf16x8*)(WlT + (size_t)(h * 64 + ct * 16 + lq) * 64 + 32 * ks + 8 * g), a2 = *(const bf16x8*)(AlT + (size_t)(h * 64 + ct * 16 + lq) * 64 + 32 * ks + 8 * g);
                const bf16x8 b1 = *(const LAS bf16x8*)(lds + L_XL + (tk * 264 + 32 * ks + 8 * g) * 2), b2 = *(const LAS bf16x8*)(lds + L_XL + (tk * 264 + 64 + 32 * ks + 8 * g) * 2);
                dw[cl] = mfma16(a1, b1, dw[cl]); da[cl] = mfma16(a2, b2, da[cl]); }
#pragma unroll
            for (int ks = 0; ks < 4; ++ks) { const bf16x8 a = *(const bf16x8*)(GlT + (size_t)(h * 64 + ct * 16 + lq) * 128 + 32 * ks + 8 * g);
                const bf16x8 b = *(const LAS bf16x8*)(lds + L_XL + (tk * 264 + 128 + 32 * ks + 8 * g) * 2); dg[cl] = mfma16(a, b, dg[cl]); } }
        float* gp = (float*)(F.ws + WS_G) + (size_t)row * WA + h * 64 + cth * 32 + 4 * g;
#pragma unroll
        for (int cl = 0; cl < 2; ++cl) *(f32x4*)(gp + cl * 16) = dg[cl];
        float ssum = 0.f, rksum = 0.f; float xv[8];
#pragma unroll
        for (int cl = 0; cl < 2; ++cl) {
            const int c16 = (2 * cth + cl) * 16 + 4 * g, ch = h * 64 + c16;
            float xs[3][4];
#pragma unroll
            for (int part = 0; part < 3; ++part) {
                const bf16* hp = H + (size_t)row * IN_COLS + part * WA + ch;
                const u32x2 cu = *(const u32x2*)hp; u32x2 pu = (u32x2){0u, 0u};
                if (!zero_prev && !sp) pu = *(const u32x2*)(hp - IN_COLS);
                const f32x4 m4 = *(const f32x4*)(mu + part * WA + ch);
                const unsigned cw[2] = {cu.x, cu.y}, pw[2] = {pu.x, pu.y};
#pragma unroll
                for (int e = 0; e < 4; ++e) {
                    const float c = bfw(cw[e >> 1], e & 1); float p = bfw(pw[e >> 1], e & 1);
                    if (sp) p = sp[part * WA + ch + e];
                    xs[part][e] = c + (p - c) * m4[e];
                }
            }
            const f32x4 w04 = *(const f32x4*)(w0 + ch), a04 = *(const f32x4*)(a0 + ch), kk4 = *(const f32x4*)(kkw + ch), ka4 = *(const f32x4*)(kaw + ch), rk4 = *(const f32x4*)(rkw + ch);
#pragma unroll
            for (int e = 0; e < 4; ++e) {
                const int i = cl * 4 + e;
                const float a = fsig(a04[e] + da[cl][e]);
                lwv[i] = -DECAY_SCALE * fsig(w04[e] + dw[cl][e]);
                xr[i] = xs[0][e]; xv[i] = xs[2][e];
                const float kq = xs[1][e] * kk4[e]; kk[i] = kq; ssum += kq * kq;
                k2[i] = xs[1][e] * (1.0f + (a - 1.0f) * ka4[e]);
                bb[i] = a;
                rksum += xr[i] * k2[i] * rk4[e];
                if (!isS) *(LAS bf16*)(lds + L_VT + ((c16 + e) * MS_ + tk) * 2) = (bf16)f2bf(xv[i]);
            }
        }
        ssum += __shfl_xor(ssum, 16); ssum += __shfl_xor(ssum, 32); rksum += __shfl_xor(rksum, 16); rksum += __shfl_xor(rksum, 32);
        if (g == 0) { *(LAS float*)(lds + L_SS + (tk * 4 + cth * 2) * 4) = ssum; *(LAS float*)(lds + L_SS + (tk * 4 + cth * 2 + 1) * 4) = rksum; }
        float* vx = (float*)(F.ws + WS_VX) + (size_t)row * WA + h * 64 + cth * 32 + 4 * g;
#pragma unroll
        for (int cl = 0; cl < 2; ++cl) *(f32x4*)(vx + cl * 16) = (f32x4){xv[cl * 4], xv[cl * 4 + 1], xv[cl * 4 + 2], xv[cl * 4 + 3]};
        if (isS) {
            float* sc = (float*)(F.ws + WS_SC) + ((size_t)(row - MP) * 6 + h) * 384 + cth * 32 + 4 * g;
#pragma unroll
            for (int cl = 0; cl < 2; ++cl) *(f32x4*)(sc + 192 + cl * 16) = (f32x4){xv[cl * 4], xv[cl * 4 + 1], xv[cl * 4 + 2], xv[cl * 4 + 3]};
        } else {
#pragma unroll
            for (int i = 0; i < 8; ++i) { float s = lwv[i];
                s += dpp_shr(s, 1); s += dpp_shr(s, 2); s += dpp_shr(s, 4); s += dpp_shr(s, 8); L[i] = s;
                if (lq == 15) *(LAS float*)(lds + L_TT + (mt * 64 + (2 * cth + (i >> 2)) * 16 + 4 * g + (i & 3)) * 4) = s; }
        }
    }
    LBAR();
    {
        const LAS float* ss = (const LAS float*)(lds + L_SS) + tk * 4;
        const float kn = rsqrtf(fmaxf(ss[0] + ss[2], 1e-12f));
#pragma unroll
        for (int i = 0; i < 8; ++i) { kk[i] *= kn; bb[i] *= kk[i]; }
        if (cth == 0 && g == 0) ((float*)(F.ws + WS_RK))[row * 6 + h] = ss[1] + ss[3];
    }
    if (isS) {
        float* sc = (float*)(F.ws + WS_SC) + ((size_t)(row - MP) * 6 + h) * 384 + cth * 32 + 4 * g;
#pragma unroll
        for (int cl = 0; cl < 2; ++cl) { const int i = cl * 4;
            *(f32x4*)(sc + cl * 16) = (f32x4){xr[i], xr[i + 1], xr[i + 2], xr[i + 3]};
            *(f32x4*)(sc + 64 + cl * 16) = (f32x4){fexp(lwv[i]), fexp(lwv[i + 1]), fexp(lwv[i + 2]), fexp(lwv[i + 3])};
            *(f32x4*)(sc + 128 + cl * 16) = (f32x4){k2[i], k2[i + 1], k2[i + 2], k2[i + 3]};
            *(f32x4*)(sc + 256 + cl * 16) = (f32x4){kk[i], kk[i + 1], kk[i + 2], kk[i + 3]};
            *(f32x4*)(sc + 320 + cl * 16) = (f32x4){bb[i], bb[i + 1], bb[i + 2], bb[i + 3]}; }
        LBAR();
        continue;
    }
#pragma unroll
    for (int cl = 0; cl < 2; ++cl) {
        float v_kkd[4], v_rd[4], v_kdi[4], v_bdi[4];
#pragma unroll
        for (int e = 0; e < 4; ++e) {
            const int i = cl * 4 + e, c16 = (2 * cth + cl) * 16 + 4 * g + e;
            const LAS float* tt = (const LAS float*)(lds + L_TT) + c16;
            const float t0 = tt[0], t1 = tt[64], t2 = tt[128], t3 = tt[192];
            const float off = (mt > 0 ? t0 : 0.f) + (mt > 1 ? t1 : 0.f) + (mt > 2 ? t2 : 0.f), LC = (t0 + t1) + (t2 + t3);
            const float Lt = L[i] + off, Lp = Lt - lwv[i];
            const float eL = fexp(Lt), eLp = fexp(Lp), eN = fexp(-Lt), eC = fexp(LC - Lt);
            v_kkd[e] = kk[i] * eLp; v_rd[e] = xr[i] * eL; v_kdi[e] = k2[i] * eN; v_bdi[e] = bb[i] * eN;
            *(LAS bf16*)(lds + L_KDET + (c16 * MS_ + tk) * 2) = (bf16)f2bf(k2[i] * eC);
            *(LAS bf16*)(lds + L_BDET + (c16 * MS_ + tk) * 2) = (bf16)f2bf(bb[i] * eC);
            if (mt == 0 && lq == 0) *(LAS float*)(lds + L_LC + c16 * 4) = fexp(LC);
        }
        const int o2 = (tk * MS_ + (2 * cth + cl) * 16 + 4 * g) * 2;
        *(LAS u32x2*)(lds + L_KKD + o2) = (u32x2){pk2(v_kkd[0], v_kkd[1]), pk2(v_kkd[2], v_kkd[3])};
        *(LAS u32x2*)(lds + L_RD + o2) = (u32x2){pk2(v_rd[0], v_rd[1]), pk2(v_rd[2], v_rd[3])};
        *(LAS u32x2*)(lds + L_KDI + o2) = (u32x2){pk2(v_kdi[0], v_kdi[1]), pk2(v_kdi[2], v_kdi[3])};
        *(LAS u32x2*)(lds + L_BDI + o2) = (u32x2){pk2(v_bdi[0], v_bdi[1]), pk2(v_bdi[2], v_bdi[3])};
    }
    LBAR();
    {
        const int p = w >> 1;
        const int xoff = p < 2 ? L_KKD : L_RD, yoff = (p == 0 || p == 3) ? L_BDI : L_KDI, doff = p == 0 ? L_AUB : (p == 1 ? L_AUK : (p == 2 ? L_AOK : L_AOB));
#pragma unroll
        for (int ti = 0; ti < 2; ++ti) {
            const int tt = 2 * (w & 1) + ti;
            const bf16x8 a0 = *(const LAS bf16x8*)(lds + xoff + ((tt * 16 + lq) * MS_ + 8 * g) * 2), a1 = *(const LAS bf16x8*)(lds + xoff + ((tt * 16 + lq) * MS_ + 32 + 8 * g) * 2);
#pragma unroll
            for (int st = 0; st < 4; ++st) {
                f32x4 acc = (f32x4){0.f, 0.f, 0.f, 0.f};
                if (st <= tt) {
                    const bf16x8 b0 = *(const LAS bf16x8*)(lds + yoff + ((st * 16 + lq) * MS_ + 8 * g) * 2), b1 = *(const LAS bf16x8*)(lds + yoff + ((st * 16 + lq) * MS_ + 32 + 8 * g) * 2);
                    acc = mfma16(a0, b0, acc); acc = mfma16(a1, b1, acc);
                }
                const int s = st * 16 + lq;
#pragma unroll
                for (int e = 0; e < 4; ++e) {
                    const int t = tt * 16 + 4 * g + e;
                    const float val = (p < 2 ? s < t : s <= t) ? acc[e] : 0.f;
                    *(LAS bf16*)(lds + doff + (t * MS_ + s) * 2) = (bf16)f2bf(val);
                    if (p == 0 && st == tt) *(LAS float*)(lds + L_DG + ((tt * 16 + 4 * g + e) * 17 + lq) * 4) = val;
                }
            }
        }
    }
    LBAR();
    f32x4 X[4];
    if (w < 4) {
#pragma unroll
        for (int tt = 0; tt < 4; ++tt) { X[tt] = (f32x4){0.f, 0.f, 0.f, 0.f};
#pragma unroll
            for (int ks = 0; ks < 2; ++ks) X[tt] = mfma16(*(const LAS bf16x8*)(lds + L_AUK + ((tt * 16 + lq) * MS_ + 32 * ks + 8 * g) * 2), *(const LAS bf16x8*)(lds + L_VT + ((w * 16 + lq) * MS_ + 32 * ks + 8 * g) * 2), X[tt]); }
    } else {
#pragma unroll
        for (int tt = 0; tt < 4; ++tt)
#pragma unroll
            for (int e = 0; e < 4; ++e) X[tt][e] = bf2f(*(const LAS bf16*)(lds + L_KKD + ((tt * 16 + 4 * g + e) * MS_ + (w - 4) * 16 + lq) * 2));
        if (w == 7) {
            const LAS float* dg = (const LAS float*)(lds + L_DG) + g * 16 * 17;
            float Y[16];
#pragma unroll
            for (int t = 0; t < 16; ++t) { float acc = (t == lq) ? 1.0f : 0.0f;
#pragma unroll
                for (int s = 0; s < t; ++s) acc -= dg[t * 17 + s] * Y[s];
                Y[t] = acc; }
#pragma unroll
            for (int t = 0; t < 16; ++t) *(LAS bf16*)(lds + L_DI + ((g * 16 + t) * 24 + lq) * 2) = (bf16)f2bf(Y[t]);
        }
    }
    LBAR();
    {
        union { unsigned u[4]; bf16x8 v; } xb[2];
        xb[0].u[0] = xb[0].u[1] = xb[0].u[2] = xb[0].u[3] = 0u; xb[1].u[0] = xb[1].u[1] = xb[1].u[2] = xb[1].u[3] = 0u;
#pragma unroll
        for (int I = 0; I < 4; ++I) {
            f32x4 acc = X[I];
            if (I > 0) {
                union { unsigned long long q[2]; bf16x8 v; } av; f32x4 up = (f32x4){0.f, 0.f, 0.f, 0.f};
                av.q[0] = *(const LAS unsigned long long*)(lds + L_AUB + ((I * 16 + lq) * MS_ + 4 * g) * 2); av.q[1] = *(const LAS unsigned long long*)(lds + L_AUB + ((I * 16 + lq) * MS_ + 16 + 4 * g) * 2);
                up = mfma16(av.v, xb[0].v, up);
                if (I > 2) { av.q[0] = *(const LAS unsigned long long*)(lds + L_AUB + ((I * 16 + lq) * MS_ + 32 + 4 * g) * 2); av.q[1] = 0ull; up = mfma16(av.v, xb[1].v, up); }
                acc = acc - up;
            }
            union { unsigned u[4]; bf16x8 v; } rb; rb.u[0] = pk2(acc[0], acc[1]); rb.u[1] = pk2(acc[2], acc[3]); rb.u[2] = 0u; rb.u[3] = 0u;
            union { unsigned long long q[2]; bf16x8 v; } dv; dv.q[0] = *(const LAS unsigned long long*)(lds + L_DI + ((I * 16 + lq) * 24 + 4 * g) * 2); dv.q[1] = 0ull;
            const f32x4 xi = mfma16(dv.v, rb.v, (f32x4){0.f, 0.f, 0.f, 0.f});
            X[I] = xi;
            if (I == 0) { xb[0].u[0] = pk2(xi[0], xi[1]); xb[0].u[1] = pk2(xi[2], xi[3]); }
            else if (I == 1) { xb[0].u[2] = pk2(xi[0], xi[1]); xb[0].u[3] = pk2(xi[2], xi[3]); }
            else if (I == 2) { xb[1].u[0] = pk2(xi[0], xi[1]); xb[1].u[1] = pk2(xi[2], xi[3]); }
            *(LAS u32x2*)(lds + (w < 4 ? L_UT + (w * 16 + lq) * MS_ * 2 : L_KT + ((w - 4) * 16 + lq) * MS_ * 2) + (I * 16 + 4 * g) * 2) = (u32x2){pk2(xi[0], xi[1]), pk2(xi[2], xi[3])};
        }
    }
    LBAR();
    unsigned char* ck = F.ws + WS_CK + (size_t)((((tile >> 6) * 6 + h) << 6) + (tile & 63)) * CK_BYTES;
    {
        const int which = w >> 1;
#pragma unroll
        for (int ri = 0; ri < 2; ++ri) {
            const int rt = 2 * (w & 1) + ri;
#pragma unroll
            for (int nt = 0; nt < 4; ++nt) {
                f32x4 acc = (f32x4){0.f, 0.f, 0.f, 0.f}, acc2 = acc;
                if (which == 0 || which == 2) {
                    const int aoff = which == 0 ? L_BDET : L_AOB;
#pragma unroll
                    for (int ks = 0; ks < 2; ++ks) acc = mfma16(*(const LAS bf16x8*)(lds + aoff + ((rt * 16 + lq) * MS_ + 32 * ks + 8 * g) * 2), *(const LAS bf16x8*)(lds + L_KT + ((nt * 16 + lq) * MS_ + 32 * ks + 8 * g) * 2), acc);
                    LAS bf16* dstp = (LAS bf16*)(lds + L_MQ + (which == 0 ? 0 : 8192)) + ((rt * 2 + (nt >> 1)) * 64 + (lq >> 2) * 16) * 8 + (nt & 1) * 4 + (lq & 3);
#pragma unroll
                    for (int e = 0; e < 4; ++e) {
                        const int rr = rt * 16 + 4 * g + e, cc = nt * 16 + lq;
                        float val;
                        if (which == 0) val = (rr == cc ? *(const LAS float*)(lds + L_LC + rr * 4) : 0.f) - acc[e];
                        else val = bf2f(*(const LAS bf16*)(lds + L_RD + (rr * MS_ + cc) * 2)) - acc[e];
                        dstp[(4 * g + e) * 8] = (bf16)f2bf(val);
                    }
                } else {
                    const int a1 = which == 1 ? L_KDET : L_AOK, a2 = which == 1 ? L_BDET : L_AOB;
#pragma unroll
                    for (int ks = 0; ks < 2; ++ks) {
                        acc = mfma16(*(const LAS bf16x8*)(lds + a1 + ((rt * 16 + lq) * MS_ + 32 * ks + 8 * g) * 2), *(const LAS bf16x8*)(lds + L_VT + ((nt * 16 + lq) * MS_ + 32 * ks + 8 * g) * 2), acc);
                        acc2 = mfma16(*(const LAS bf16x8*)(lds + a2 + ((rt * 16 + lq) * MS_ + 32 * ks + 8 * g) * 2), *(const LAS bf16x8*)(lds + L_UT + ((nt * 16 + lq) * MS_ + 32 * ks + 8 * g) * 2), acc2);
                    }
                    *(f32x4*)(ck + (which == 1 ? CK_N : CK_O) + (size_t)((nt * 4 + rt) * 64 + lane) * 16) = acc - acc2;
                }
            }
        }
    }
    LBAR();
#pragma unroll
    for (int i = 0; i < 2; ++i) { const int o16 = (tidh + NTHR * i) * 16; *(v4u*)(ck + CK_M + o16) = *(const LAS v4u*)(lds + L_MQ + o16); }
    LBAR();
  }
}

__device__ __forceinline__ void touch_lds(const void* gsrc, unsigned lds_dst) { unsigned keep;
    asm volatile("s_mov_b32 %0, m0\n\ts_mov_b32 m0, %2\n\ts_nop 0\n\tglobal_load_lds_dword %1, off\n\ts_mov_b32 m0, %0" : "=&s"(keep) : "v"(gsrc), "s"(lds_dst) : "memory"); }
#define CHAIN_LOAD_MN(MF, NF, cp_) do { const unsigned char* cq_ = (cp_); \
    _Pragma("unroll") for (int i = 0; i < 8; ++i) MF[i] = *(const bf16x8*)(cq_ + CK_M + (size_t)(i * 64 + lane) * 16); \
    _Pragma("unroll") for (int i = 0; i < 4; ++i) NF[i] = *(const f32x4*)(cq_ + CK_N + (size_t)((ft * 4 + i) * 64 + lane) * 16); } while (0)
#define CHAIN_STEP(MF, NF, MFN, NFN, c_) do { \
    CHAIN_LOAD_MN(MFN, NFN, ck + (size_t)((c_) + 1 < 64 ? (c_) + 1 : 63) * CK_BYTES); \
    union { unsigned u[4]; bf16x8 v; v4u q; } zb[2]; \
    _Pragma("unroll") for (int ks = 0; ks < 2; ++ks) { zb[ks].u[0] = pk2(Z[2 * ks][0], Z[2 * ks][1]); zb[ks].u[1] = pk2(Z[2 * ks][2], Z[2 * ks][3]); zb[ks].u[2] = pk2(Z[2 * ks + 1][0], Z[2 * ks + 1][1]); zb[ks].u[3] = pk2(Z[2 * ks + 1][2], Z[2 * ks + 1][3]); \
        *(LAS v4u*)(F.lds + ((c_) & 1) * 8192 + ((ft * 2 + ks) * 64 + lane) * 16) = zb[ks].q; } \
    _Pragma("unroll") for (int mt = 0; mt < 4; ++mt) { f32x4 z = NF[mt]; z = mfma16(MF[mt * 2], zb[0].v, z); z = mfma16(MF[mt * 2 + 1], zb[1].v, z); Z[mt] = z; } } while (0)
__device__ __forceinline__ void chain_item(Frame& F, int l, int item) {
    int tid = F.tid; asm volatile("" : "+v"(tid));
    const int lane = tid & 63, w = F.wave, g = lane >> 4, lq = lane & 15;
    const int bh = item, ft = w & 3, b = bh / 6, h = bh % 6;
    const unsigned char* ck = F.ws + WS_CK + (size_t)(bh << 6) * CK_BYTES;
    unsigned char* zf = F.ws + WS_ZF + (size_t)(bh << 6) * 8192;
    constexpr int PF = 6;
    if (w >= 4) {
        const int pt = tid - 256;
        const unsigned pdst = (unsigned)__builtin_amdgcn_readfirstlane((unsigned)(uintptr_t)(F.lds + 32768 + (w - 4) * 256));
        for (int c = 0; c < PF; ++c) if (pt < 192) touch_lds(ck + (size_t)c * CK_BYTES + (pt < 64 ? CK_M + pt * 128 : CK_N + (pt - 64) * 128), pdst);
        for (int c = 0; c < 64; ++c) {
            const int cc = c + PF;
            if (cc < 64 && pt < 192) touch_lds(ck + (size_t)cc * CK_BYTES + (pt < 64 ? CK_M + pt * 128 : CK_N + (pt - 64) * 128), pdst);
            LBAR();
#pragma unroll
            for (int i = 0; i < 2; ++i) { const int o16 = (pt + 256 * i) * 16; *(v4u*)(zf + (size_t)c * 8192 + o16) = *(const LAS v4u*)(F.lds + (c & 1) * 8192 + o16); }
        }
        return;
    }
    f32x4 Z[4];
#pragma unroll
    for (int mt = 0; mt < 4; ++mt) Z[mt] = (f32x4){0.f, 0.f, 0.f, 0.f};
    bf16x8 mfA[8], mfB[8]; f32x4 nfA[4], nfB[4];
    CHAIN_LOAD_MN(mfA, nfA, ck);
    for (int c = 0; c < 64; c += 2) {
        CHAIN_STEP(mfA, nfA, mfB, nfB, c);
        LBAR();
        CHAIN_STEP(mfB, nfB, mfA, nfA, c + 1);
        LBAR();
    }
    float* so = F.out + O_PWKV + (((size_t)l * NBP + b) * 6 + h) * 4096 + (size_t)(ft * 16 + lq) * 64 + 4 * g;
#pragma unroll
    for (int mt = 0; mt < 4; ++mt) *(f32x4*)(so + mt * 16) = Z[mt];
}

__device__ __forceinline__ int q_next(Frame& F, int qi) {
    volatile LAS unsigned* slot = F.MISC + 12;
    if (F.tid == 0) slot[0] = __hip_atomic_fetch_add(F.ctl + CW_Q + 64 * (qi + 8 * F.rep), 1u, RLX_AGENT);
    __syncthreads();
    const int v = (int)slot[0];
    __syncthreads();
    return v;
}


__device__ __forceinline__ void ret1_item(Frame& F, int item) {
    int tid = F.tid; asm volatile("" : "+v"(tid));
    const int lane = tid & 63, w = F.wave, g = lane >> 4, lq = lane & 15;
    const int c = item & 31, bh = item >> 5, b = bh >> 2, h = bh & 3;
    const bf16* H = (const bf16*)(F.ws + WS_H); float* OC = (float*)(F.ws + WS_OC);
    const float gam = 1.0f - exp2f(-5.0f - (float)h), lg2 = log2f(gam);
    LAS bf16* Kl = (LAS bf16*)F.lds;
    LAS bf16* KTd = Kl + 128 * 72;
    LAS bf16* VT = KTd + 64 * 136;
    const size_t rowc = (size_t)b * SEQ + c * 128;
    v4u kv[2], vv[2];
#pragma unroll
    for (int i = 0; i < 2; ++i) { const int cid = tid + NTHR * i, key = cid >> 3, ch = cid & 7;
        kv[i] = *(const v4u*)(H + (rowc + key) * IN_COLS + COL_KC + h * 64 + ch * 8); vv[i] = *(const v4u*)(H + (rowc + key) * IN_COLS + COL_VC + h * 64 + ch * 8); }
    const int qi = 16 * w + lq; const size_t qrow = rowc + qi;
    bf16x8 qf[2];
    qf[0] = *(const bf16x8*)(H + qrow * IN_COLS + COL_QC + h * 64 + 8 * g); qf[1] = *(const bf16x8*)(H + qrow * IN_COLS + COL_QC + h * 64 + 32 + 8 * g);
#pragma unroll
    for (int i = 0; i < 2; ++i) { const int cid = tid + NTHR * i, key = cid >> 3, ch = cid & 7;
        *(LAS v4u*)(Kl + key * 72 + ch * 8) = kv[i];
        const float kd = exp2f((float)(127 - key) * lg2);
        const unsigned ku[4] = {kv[i].x, kv[i].y, kv[i].z, kv[i].w}, vu[4] = {vv[i].x, vv[i].y, vv[i].z, vv[i].w};
#pragma unroll
        for (int e = 0; e < 8; ++e) { KTd[(ch * 8 + e) * 136 + key] = (bf16)f2bf(bfw(ku[e >> 1], e & 1) * kd); VT[(ch * 8 + e) * 136 + key] = (bf16)((vu[e >> 1] >> ((e & 1) * 16)) & 0xffffu); } }
    __syncthreads();
    f32x4 s[8];
#pragma unroll
    for (int jt = 0; jt < 8; ++jt) {
        s[jt] = (f32x4){0.f, 0.f, 0.f, 0.f};
        if (jt <= w) {
#pragma unroll
            for (int ks = 0; ks < 2; ++ks) { const bf16x8 a = *(const LAS bf16x8*)(Kl + (jt * 16 + lq) * 72 + 32 * ks + 8 * g); s[jt] = mfma16(a, qf[ks], s[jt]); }
#pragma unroll
            for (int e = 0; e < 4; ++e) { const int kj = jt * 16 + 4 * g + e; s[jt][e] = kj <= qi ? s[jt][e] * exp2f((float)(qi - kj) * lg2) : 0.f; }
        }
    }
    f32x4 o[4];
#pragma unroll
    for (int ft = 0; ft < 4; ++ft) o[ft] = (f32x4){0.f, 0.f, 0.f, 0.f};
#pragma unroll
    for (int pp = 0; pp < 4; ++pp) {
        if (2 * pp <= w) {
            union { unsigned u[4]; bf16x8 v; } pb;
            pb.u[0] = pk2(s[2 * pp][0], s[2 * pp][1]); pb.u[1] = pk2(s[2 * pp][2], s[2 * pp][3]); pb.u[2] = pk2(s[2 * pp + 1][0], s[2 * pp + 1][1]); pb.u[3] = pk2(s[2 * pp + 1][2], s[2 * pp + 1][3]);
            const int k0 = (2 * pp) * 16 + 4 * g, k1 = (2 * pp + 1) * 16 + 4 * g;
#pragma unroll
            for (int ft = 0; ft < 4; ++ft) {
                union { unsigned long long q[2]; bf16x8 v; } av;
                av.q[0] = *(const LAS unsigned long long*)(VT + (ft * 16 + lq) * 136 + k0); av.q[1] = *(const LAS unsigned long long*)(VT + (ft * 16 + lq) * 136 + k1);
                o[ft] = mfma16(av.v, pb.v, o[ft]);
            }
        }
    }
    float* op = OC + qrow * 256 + h * 64 + 4 * g;
#pragma unroll
    for (int ft = 0; ft < 4; ++ft) *(f32x4*)(op + ft * 16) = o[ft];
    float* kvp = (float*)(F.ws + WS_KV) + (size_t)item * 4096;
#pragma unroll
    for (int ti = 0; ti < 2; ++ti) {
        const int tl = 2 * w + ti, ft = tl >> 2, et = tl & 3;
        f32x4 acc = (f32x4){0.f, 0.f, 0.f, 0.f};
#pragma unroll
        for (int ks = 0; ks < 4; ++ks) acc = mfma16(*(const LAS bf16x8*)(VT + (ft * 16 + lq) * 136 + 32 * ks + 8 * g), *(const LAS bf16x8*)(KTd + (et * 16 + lq) * 136 + 32 * ks + 8 * g), acc);
#pragma unroll
        for (int e = 0; e < 4; ++e) kvp[(ft * 16 + 4 * g + e) * 64 + et * 16 + lq] = acc[e];
    }
    __syncthreads();
}
__device__ __forceinline__ void ret2_item(Frame& F, int l, int item) {
    int tid = F.tid; asm volatile("" : "+v"(tid));
    const int lane = tid & 63, w = F.wave, g = lane >> 4, lq = lane & 15;
    const int c = item & 31, bh = item >> 5, b = bh >> 2, h = bh & 3;
    if (c == 0) return;
    const bf16* H = (const bf16*)(F.ws + WS_H); float* OC = (float*)(F.ws + WS_OC2);
    const float gam = 1.0f - exp2f(-5.0f - (float)h), lg2 = log2f(gam), gch = exp2f(128.0f * lg2);
    LAS bf16* RT = (LAS bf16*)F.lds;
    const float* kvb = (const float*)(F.ws + WS_KV) + (size_t)(bh * 32) * 4096 + tid * 8;
    f32x4 r0 = (f32x4){0.f, 0.f, 0.f, 0.f}, r1 = r0;
#pragma unroll 4
    for (int cc = 0; cc < c; ++cc) { const f32x4 a = *(const f32x4*)(kvb + (size_t)cc * 4096), bq = *(const f32x4*)(kvb + (size_t)cc * 4096 + 4); r0 = r0 * gch + a; r1 = r1 * gch + bq; }
    { const int f = tid >> 3, e0 = (tid & 7) * 8;
      *(LAS v4u*)(RT + f * 72 + e0) = (v4u){pk2(r0[0], r0[1]), pk2(r0[2], r0[3]), pk2(r1[0], r1[1]), pk2(r1[2], r1[3])};
      if (c == 31) {
          const f32x4 a = *(const f32x4*)(kvb + (size_t)31 * 4096), bq = *(const f32x4*)(kvb + (size_t)31 * 4096 + 4); const f32x4 f0 = r0 * gch + a, f1 = r1 * gch + bq;
          float* po = F.out + O_PRET + (((size_t)l * NBP + b) * 4 + h) * 4096 + f;
#pragma unroll
          for (int e = 0; e < 4; ++e) { po[dimC(e0 + e) * 64] = f0[e]; po[dimC(e0 + 4 + e) * 64] = f1[e]; }
      } }
    __syncthreads();
    const int qi = 16 * w + lq; const size_t qrow = (size_t)b * SEQ + c * 128 + qi;
    const float qdec = exp2f((float)(qi + 1) * lg2);
    bf16x8 qf[2];
    qf[0] = *(const bf16x8*)(H + qrow * IN_COLS + COL_QC + h * 64 + 8 * g); qf[1] = *(const bf16x8*)(H + qrow * IN_COLS + COL_QC + h * 64 + 32 + 8 * g);
    float* op = OC + qrow * 256 + h * 64 + 4 * g;
#pragma unroll
    for (int ft = 0; ft < 4; ++ft) { f32x4 x = (f32x4){0.f, 0.f, 0.f, 0.f};
#pragma unroll
        for (int ks = 0; ks < 2; ++ks) x = mfma16(*(const LAS bf16x8*)(RT + (ft * 16 + lq) * 72 + 32 * ks + 8 * g), qf[ks], x);
        *(f32x4*)(op + ft * 16) = x * qdec; }
    __syncthreads();
}

__device__ __forceinline__ void sret_item(Frame& F, int l, const bf16* H, float* OC, int item) {
    int tid = F.tid; asm volatile("" : "+v"(tid));
    const int b = item >> 2, h = item & 3, f = tid & 63, eg = tid >> 6;
    const float gam = 1.0f - exp2f(-5.0f - (float)h);
    const float* r0 = inp(F, 6) + (((size_t)l * NBS + b) * 4 + h) * 4096;
    LAS float* red = (LAS float*)F.lds;
    float S[8];
#pragma unroll
    for (int e = 0; e < 8; ++e) S[e] = r0[dimC(eg * 8 + e) * 64 + f];
    for (int t = 0; t < TS; ++t) {
        const size_t row = MP + b * 4 + t; const bf16* hp = H + row * IN_COLS;
        const float vf = bf2f(hp[COL_VC + h * 64 + f]);
        float part = 0.f;
#pragma unroll
        for (int e = 0; e < 8; ++e) { const float ke = bf2f(hp[COL_KC + h * 64 + eg * 8 + e]), qe = bf2f(hp[COL_QC + h * 64 + eg * 8 + e]); S[e] = gam * S[e] + ke * vf; part += qe * S[e]; }
        red[eg * 64 + f] = part;
        __syncthreads();
        if (tid < 64) { float o = 0.f;
#pragma unroll
            for (int q = 0; q < 8; ++q) o += red[q * 64 + tid];
            OC[row * 256 + h * 64 + tid] = o; }
        __syncthreads();
    }
    float* so = F.out + O_SRET + (((size_t)l * NBS + b) * 4 + h) * 4096;
#pragma unroll
    for (int e = 0; e < 8; ++e) so[dimC(eg * 8 + e) * 64 + f] = S[e];
}

__device__ __forceinline__ void sattn_item(Frame& F, int l, const bf16* H, float* OB, float* LSE, int item) {
    int lane = F.lane; asm volatile("" : "+v"(lane));
    const int qx = item * 8 + F.wave;
    const int di = qx % 3, qq = qx / 3, b = qq / 24, t = (qq / 6) & 3, h = qq % 6; const size_t row = MP + b * 4 + t;
    const int d = di == 0 ? 1 : (di == 1 ? 4 : 16);
    LAS float* qs = (LAS float*)(F.lds + F.wave * 2048);
    LAS float* qp = qs + 64; LAS float* pw = qs + 128;
    const float* ck = inp(F, 4) + ((size_t)l * NBS + b) * WBUF * 384 + h * 64; const float* cv = inp(F, 5) + ((size_t)l * NBS + b) * WBUF * 384 + h * 64;
    const bf16* hk = H + (size_t)(MP + b * 4) * IN_COLS + COL_KB + h * 64; const bf16* hv = H + (size_t)(MP + b * 4) * IN_COLS + COL_VB + h * 64;
    { const float qv = bf2f(H[row * IN_COLS + COL_QB + h * 64 + lane]) * 0.125f; qs[dimB(lane)] = qv; qp[lane] = qv; }
    asm volatile("s_waitcnt lgkmcnt(0)" ::: "memory");
    float sc[3];
#pragma unroll
    for (int rnd = 0; rnd < 3; ++rnd) {
        const int jk = rnd * 64 + lane; float acc = -1e30f;
        if (jk <= 128) {
            const int idx = WBUF + t - d * jk; acc = 0.f;
            if (idx < WBUF) { const f32x4* kp = (const f32x4*)(ck + (size_t)idx * 384); f32x4 kx[16];
#pragma unroll
                for (int q = 0; q < 16; ++q) kx[q] = kp[q];
#pragma unroll
                for (int q = 0; q < 16; ++q) { const f32x4 q4 = *(const LAS f32x4*)(qs + 4 * q); acc += (kx[q][0] * q4[0] + kx[q][1] * q4[1]) + (kx[q][2] * q4[2] + kx[q][3] * q4[3]); }
            } else { const v4u* kp = (const v4u*)(hk + (size_t)(idx - WBUF) * IN_COLS);
#pragma unroll
                for (int q = 0; q < 8; ++q) { const v4u kx = kp[q]; const f32x4 q0 = *(const LAS f32x4*)(qp + 8 * q), q1 = *(const LAS f32x4*)(qp + 8 * q + 4);
                    acc += (bfw(kx.x, 0) * q0[0] + bfw(kx.x, 1) * q0[1]) + (bfw(kx.y, 0) * q0[2] + bfw(kx.y, 1) * q0[3]) + (bfw(kx.z, 0) * q1[0] + bfw(kx.z, 1) * q1[1]) + (bfw(kx.w, 0) * q1[2] + bfw(kx.w, 1) * q1[3]); }
            }
        }
        sc[rnd] = acc;
    }
    const float m = wave_max(fmaxf(fmaxf(sc[0], sc[1]), sc[2]));
    float psum = 0.f;
#pragma unroll
    for (int rnd = 0; rnd < 3; ++rnd) { const int jk = rnd * 64 + lane; const float p = jk <= 128 ? __expf(sc[rnd] - m) : 0.f; psum += p; pw[jk] = p; }
    const float lsum = wave_sum(psum);
    asm volatile("s_waitcnt lgkmcnt(0)" ::: "memory");
    const int kg = lane >> 4, dq = (lane & 15) * 4;
    f32x4 o4 = (f32x4){0.f, 0.f, 0.f, 0.f};
#pragma unroll 11
    for (int i = 0; i < 33; ++i) {
        const int jk = 4 * i + kg;
        if (jk <= 128) {
            const int idx = WBUF + t - d * jk; f32x4 vv;
            if (idx >= WBUF) { const u32x2 u = *(const u32x2*)(hv + (size_t)(idx - WBUF) * IN_COLS + dq); vv = (f32x4){bfw(u.x, 0), bfw(u.x, 1), bfw(u.y, 0), bfw(u.y, 1)}; }
            else vv = *(const f32x4*)(cv + (size_t)idx * 384 + dq);
            o4 = o4 + vv * pw[jk];
        }
    }
#pragma unroll
    for (int e = 0; e < 4; ++e) { o4[e] += __shfl_xor(o4[e], 16); o4[e] += __shfl_xor(o4[e], 32); }
    if (kg == 0) *(f32x4*)(OB + ((size_t)di * MT + row) * 384 + h * 64 + dq) = o4 * (1.0f / lsum);
    if (lane == 0) LSE[((size_t)di * MT + row) * 6 + h] = m + __logf(lsum);
}

__device__ __forceinline__ void winout_item(Frame& F, int l, int item) {
    int tid = F.tid; asm volatile("" : "+v"(tid));
    const bf16* H = (const bf16*)(F.ws + WS_H);
    for (int q = tid; q < 64 * 96; q += NTHR) {
        const int r = item * 64 + q / 96, tk = q % 96;
        size_t row; float* ok; float* ov; size_t wrow;
        if (r < NBP * WBUF) { const int b = r >> 11, tt = r & (WBUF - 1); row = (size_t)b * SEQ + (SEQ - WBUF) + tt; wrow = ((size_t)l * NBP + b) * WBUF + tt; ok = F.out + O_PWINK; ov = F.out + O_PWINV; }
        else { const int rs = r - NBP * WBUF, b = rs >> 2, t = rs & 3; row = MP + rs; wrow = ((size_t)l * NBS + b) * WBUF + (WBUF - TS + t); ok = F.out + O_SWINK; ov = F.out + O_SWINV; }
        const bf16* hp = H + row * IN_COLS;
        if (tk < 48) {
            const int hh = tk >> 3, part = tk & 7; const v4u a = *(const v4u*)(hp + COL_KB + hh * 64 + 8 * part);
            const float v[8] = {bfw(a.x, 0), bfw(a.x, 1), bfw(a.y, 0), bfw(a.y, 1), bfw(a.z, 0), bfw(a.z, 1), bfw(a.w, 0), bfw(a.w, 1)};
            float* o = ok + wrow * 384 + hh * 64;
            if (part < 2) { *(f32x4*)(o + 4 * part) = (f32x4){v[0], v[2], v[4], v[6]}; *(f32x4*)(o + 8 + 4 * part) = (f32x4){v[1], v[3], v[5], v[7]}; }
            else { *(f32x4*)(o + 8 * part) = (f32x4){v[0], v[1], v[2], v[3]}; *(f32x4*)(o + 8 * part + 4) = (f32x4){v[4], v[5], v[6], v[7]}; }
        } else { const int c2 = tk - 48; const v4u a = *(const v4u*)(hp + COL_VB + 8 * c2); float* o = ov + wrow * 384 + 8 * c2;
            *(f32x4*)o = (f32x4){bfw(a.x, 0), bfw(a.x, 1), bfw(a.y, 0), bfw(a.y, 1)}; *(f32x4*)(o + 4) = (f32x4){bfw(a.z, 0), bfw(a.z, 1), bfw(a.w, 0), bfw(a.w, 1)}; }
    }
    if (item < NBP + NBS) {
        const bool isS = item >= NBP; const int b = isS ? item - NBP : item; const size_t row = isS ? MP + b * 4 + 3 : (size_t)b * SEQ + SEQ - 1;
        float* o = F.out + (isS ? O_SSHIFT + ((size_t)l * NBS + b) * A_COLS : O_PSHIFT + ((size_t)l * NBP + b) * A_COLS);
        for (int c = tid; c < A_COLS; c += NTHR) o[c] = bf2f(H[row * IN_COLS + c]);
    }
}
__device__ __forceinline__ void pa_phase(Frame& F, int l) {
    const bf16* H = (const bf16*)(F.ws + WS_H); float* OB = (float*)(F.ws + WS_OB); float* LSE = (float*)(F.ws + WS_LSE);
    constexpr int N_RW = 258, N_RET1 = NBP * 4 * 32, N_ATT = NBP * 6 * 3 * 32;
    for (;;) {
        int r = q_next(F, l * 4 + 0);
        if (r >= N_RW + N_RET1 + N_ATT) break;
        if (r < N_RW) { rwkv_item(F, l, r); continue; } r -= N_RW;
        if (r < N_RET1) { ret1_item(F, r); continue; } r -= N_RET1;
        attn_unit(F, H, OB, LSE, r);
    }
}
__device__ __forceinline__ void mixers_phase(Frame& F, int l) {
    const bf16* H = (const bf16*)(F.ws + WS_H); const float* SC = (const float*)(F.ws + WS_SC); float* OA = (float*)(F.ws + WS_OA);
    float* OB = (float*)(F.ws + WS_OB); float* LSE = (float*)(F.ws + WS_LSE); float* OC = (float*)(F.ws + WS_OC);
    constexpr int N_CHAIN = NBP * 6, N_RET2 = NBP * 4 * 32, N_SATT = (MS * 6 * 3) / 8, N_SRET = NBS * 4, N_SSCAN = NBS * 6 * 2, N_WOUT = (NBP * WBUF + MS) / 64, N_COPY = 512;
    constexpr int N_ALL = N_CHAIN + N_RET2 + N_SATT + N_SRET + N_SSCAN + N_WOUT + N_COPY;
    for (;;) {
        int r = q_next(F, l * 4 + 1);
        if (r >= N_ALL) break;
#ifndef PBX
#define PBX 0
#endif
        if (r < N_CHAIN) { chain_item(F, l, r); if (PBX & 1) chain_item(F, l, r); continue; } r -= N_CHAIN;
        if (r < N_SATT) { sattn_item(F, l, H, OB, LSE, r); if (PBX & 2) sattn_item(F, l, H, OB, LSE, r); continue; } r -= N_SATT;
        if (r < N_RET2) { ret2_item(F, l, r); if (PBX & 4) ret2_item(F, l, r); continue; } r -= N_RET2;
        if (r < N_SRET) { sret_item(F, l, H, OC, r); if (PBX & 8) sret_item(F, l, H, OC, r); continue; } r -= N_SRET;
        if (r < N_SSCAN) { const int bh = r >> 1, half = r & 1, b = bh / 6, h = bh % 6;
            scan_item(F, SC, OA, b * TS, MP + b * TS, TS, h, half, inp(F, 3) + (((size_t)l * NBS + b) * 6 + h) * 4096, F.out + O_SWKV + (((size_t)l * NBS + b) * 6 + h) * 4096); continue; } r -= N_SSCAN;
        if (r < N_WOUT) { winout_item(F, l, r); if (PBX & 32) winout_item(F, l, r); continue; } r -= N_WOUT;
        copy_item(F, l, r);
    }
}

__device__ __forceinline__ void copy_tail(Frame& F, int l, int qi, int lo, int hi) {
    for (;;) { const int r = q_next(F, qi) + lo; if (r >= hi) break; copy_item(F, l, r); }
}

__device__ __forceinline__ void skinny_tail(Frame& F, const bf16* A, const bf16* Bt, int K, const float* base, float* V, float alpha) {
    int tid = F.tid; asm volatile("" : "+v"(tid));
    const int lane = tid & 63, w = F.wave, g = lane >> 4, lq = lane & 15;
    LAS float* red = (LAS float*)F.lds;
    for (int piece = F.bid; piece < 256; piece += F.G) {
        const int rg = piece >> 5, cg = piece & 31, kw = K >> 3, k0 = w * kw;
        const bf16* ap = A + (size_t)(rg * 16 + lq) * K + k0 + 8 * g; const bf16* b0p = Bt + (size_t)(cg * 32 + lq) * K + k0 + 8 * g; const bf16* b1p = b0p + (size_t)16 * K;
        f32x4 acc0 = (f32x4){0.f, 0.f, 0.f, 0.f}, acc1 = acc0;
#pragma unroll 4
        for (int ks = 0; ks < kw / 32; ++ks) { const bf16x8 a = *(const bf16x8*)(ap + 32 * ks), b0 = *(const bf16x8*)(b0p + 32 * ks), b1 = *(const bf16x8*)(b1p + 32 * ks);
            acc0 = mfma16(b0, a, acc0); acc1 = mfma16(b1, a, acc1); }
        *(LAS f32x4*)(red + ((w * 2 + 0) * 64 + lane) * 4) = acc0; *(LAS f32x4*)(red + ((w * 2 + 1) * 64 + lane) * 4) = acc1;
        __syncthreads();
        if (tid < 128) { const int tile = tid >> 6, ln = tid & 63; f32x4 s = (f32x4){0.f, 0.f, 0.f, 0.f};
#pragma unroll
            for (int q = 0; q < 8; ++q) s = s + *(const LAS f32x4*)(red + ((q * 2 + tile) * 64 + ln) * 4);
            const int r = rg * 16 + (ln & 15), c = cg * 32 + tile * 16 + 4 * (ln >> 4);
            const f32x4 bv = *(const f32x4*)(base + (size_t)r * DM + c);
            *(f32x4*)(V + (size_t)(MP + r) * DM + c) = bv * alpha + s; }
        __syncthreads();
    }
}

__device__ __forceinline__ void post_item(Frame& F, int l, int tile) {
    const bf16* H = (const bf16*)(F.ws + WS_H); const float* VX = (const float*)(F.ws + WS_VX); const float* OA = (const float*)(F.ws + WS_OA);
    const float* OB = (const float*)(F.ws + WS_OB); const float* LSE = (const float*)(F.ws + WS_LSE); const float* OC = (const float*)(F.ws + WS_OC); const float* OC2 = (const float*)(F.ws + WS_OC2);
    const float* Gt = (const float*)(F.ws + WS_G); const float* RK = (const float*)(F.ws + WS_RK); bf16* MIX = (bf16*)(F.ws + WS_MIX);
    const float* gna = inp(F, 17) + l * WA; const float* gnb = inp(F, 18) + l * WA; const float* rgg = inp(F, 19) + l * 256; const float* rgb = inp(F, 20) + l * 256;
    int tid = F.tid; asm volatile("" : "+v"(tid));
    const int lane = tid & 63, w = F.wave, g = lane >> 4, lq = lane & 15;
    const bool isS = tile >= 256; const int R0 = isS ? MP + (tile - 256) * 64 : tile * 64;
    LAS float* OL = (LAS float*)F.lds;
    if (isS) {
        for (int q = tid; q < 64 * 96; q += NTHR) { const int r = q / 96, c4 = q % 96; *(LAS f32x4*)(OL + r * 388 + c4 * 4) = *(const f32x4*)(OA + (size_t)(R0 + r) * WA + c4 * 4); }
    } else {
        const int b = tile >> 6, c = tile & 63, tt = w & 3, fth = w >> 2;
#pragma unroll 2
        for (int h = 0; h < 6; ++h) {
            const size_t ci = (size_t)(((b * 6 + h) << 6) + c);
            const unsigned char* cp = F.ws + WS_CK + ci * CK_BYTES; const unsigned char* zp = F.ws + WS_ZF + ci * 8192;
            const bf16x8 q0 = *(const bf16x8*)(cp + CK_Q + (size_t)((tt * 2) * 64 + lane) * 16), q1 = *(const bf16x8*)(cp + CK_Q + (size_t)((tt * 2 + 1) * 64 + lane) * 16);
#pragma unroll
            for (int fi = 0; fi < 2; ++fi) { const int ft = fth * 2 + fi;
                f32x4 o = *(const f32x4*)(cp + CK_O + (size_t)((ft * 4 + tt) * 64 + lane) * 16);
                o = mfma16(q0, *(const bf16x8*)(zp + (size_t)((ft * 2) * 64 + lane) * 16), o); o = mfma16(q1, *(const bf16x8*)(zp + (size_t)((ft * 2 + 1) * 64 + lane) * 16), o);
#pragma unroll
                for (int e = 0; e < 4; ++e) OL[(tt * 16 + 4 * g + e) * 388 + h * 64 + ft * 16 + lq] = o[e]; }
        }
    }
    __syncthreads();
    const int nrow = (R0 + 64 <= MV) ? 64 : (MV - R0);
    for (int r = w; r < nrow; r += NWAVES) {
        const int row = R0 + r;
        bf16* mx = MIX + (size_t)row * DM;
#pragma unroll
        for (int bt = 0; bt < 2; ++bt) {
            const int i4 = lane + 64 * bt; const bool act = i4 < 96; const int c = (act ? i4 : 0) * 4, h = c >> 6;
            { const f32x4 o = *(const LAS f32x4*)(OL + r * 388 + c);
              const float mean = red16((o[0] + o[1]) + (o[2] + o[3])) * (1.f / 64.f); const f32x4 d = o - mean;
              const float var = red16((d[0] * d[0] + d[1] * d[1]) + (d[2] * d[2] + d[3] * d[3])) * (1.f / 64.f); const float rstd = rsqrtf(var + GN_EPS_A);
              const f32x4 gg = *(const f32x4*)(gna + c), gb = *(const f32x4*)(gnb + c), vx = *(const f32x4*)(VX + (size_t)row * WA + c), gt = *(const f32x4*)(Gt + (size_t)row * WA + c);
              const float rk = RK[row * 6 + h];
              const f32x4 y = (d * rstd * gg + gb + vx * rk) * gt;
              if (act) *(u32x2*)(mx + c) = (u32x2){pk2(y[0], y[1]), pk2(y[2], y[3])}; }
            { const float l0 = LSE[((size_t)0 * MT + row) * 6 + h], l1 = LSE[((size_t)1 * MT + row) * 6 + h], l2 = LSE[((size_t)2 * MT + row) * 6 + h];
              const float m = fmaxf(fmaxf(l0, l1), l2); const float e0 = fexp(l0 - m), e1 = fexp(l1 - m), e2 = fexp(l2 - m); const float inv = __builtin_amdgcn_rcpf(e0 + e1 + e2);
              const f32x4 b0 = *(const f32x4*)(OB + ((size_t)0 * MT + row) * 384 + c), b1 = *(const f32x4*)(OB + ((size_t)1 * MT + row) * 384 + c), b2 = *(const f32x4*)(OB + ((size_t)2 * MT + row) * 384 + c);
              const f32x4 y = (b0 * e0 + b1 * e1 + b2 * e2) * inv;
              if (act) *(u32x2*)(mx + WA + c) = (u32x2){pk2(y[0], y[1]), pk2(y[2], y[3])}; }
        }
        {
            const int c = lane * 4;
            f32x4 o = *(const f32x4*)(OC + (size_t)row * 256 + c);
            if (row < MP && (row & (SEQ - 1)) >= 128) o = o + *(const f32x4*)(OC2 + (size_t)row * 256 + c);
            const float mean = red16((o[0] + o[1]) + (o[2] + o[3])) * (1.f / 64.f); const f32x4 d = o - mean;
            const float var = red16((d[0] * d[0] + d[1] * d[1]) + (d[2] * d[2] + d[3] * d[3])) * (1.f / 64.f); const float rstd = rsqrtf(var + LN_EPS);
            const f32x4 gg = *(const f32x4*)(rgg + c), gb = *(const f32x4*)(rgb + c);
            const u32x2 gu = *(const u32x2*)(H + (size_t)row * IN_COLS + COL_GC + c);
            const f32x4 gc = (f32x4){bfw(gu.x, 0), bfw(gu.x, 1), bfw(gu.y, 0), bfw(gu.y, 1)};
            f32x4 y = d * rstd * gg + gb;
#pragma unroll
            for (int e = 0; e < 4; ++e) y[e] = y[e] * gc[e] * fsig(gc[e]);
            *(u32x2*)(mx + 2 * WA + c) = (u32x2){pk2(y[0], y[1]), pk2(y[2], y[3])};
        }
    }
    __syncthreads();
}
__device__ __forceinline__ void post_phase(Frame& F, int l) {
    for (int tile = F.bid; tile < 258; tile += F.G) post_item(F, l, tile);
}

__device__ __forceinline__ void ln_phase(Frame& F, const float* V, const float* gw, const float* bw, float* outP, float* outS, bf16* ob) {
    const int lane = F.lane;
    for (int row = F.bid * NWAVES + F.wave; row < MV; row += F.G * NWAVES) {
        const GAS f32x4* xr = (const GAS f32x4*)(V + (size_t)row * DM) + lane;
        f32x4 v[4]; float s = 0.f;
#pragma unroll
        for (int j = 0; j < 4; ++j) { v[j] = xr[64 * j]; s += (v[j].x + v[j].y) + (v[j].z + v[j].w); }
        const float mean = wave_sum(s) * (1.f / DM); float s2 = 0.f;
#pragma unroll
        for (int j = 0; j < 4; ++j) { v[j] = v[j] - mean; s2 += (v[j].x * v[j].x + v[j].y * v[j].y) + (v[j].z * v[j].z + v[j].w * v[j].w); }
        const float rstd = rsqrtf(wave_sum(s2) * (1.f / DM) + LN_EPS);
        float* orow = row < MP ? outP + (size_t)row * DM : outS + (size_t)(row - MP) * DM;
#pragma unroll
        for (int j = 0; j < 4; ++j) {
            const f32x4 gg = ((const f32x4*)gw)[lane + 64 * j], bb = ((const f32x4*)bw)[lane + 64 * j];
            const f32x4 y = v[j] * rstd * gg + bb;
            ((GAS f32x4*)orow)[lane + 64 * j] = y;
            if (ob) ((GAS unsigned long long*)(ob + (size_t)row * DM))[lane + 64 * j] = (unsigned long long)pk2(y.x, y.y) | ((unsigned long long)pk2(y.z, y.w) << 32);
        }
    }
}

struct Args { const float* in[29]; float* out; unsigned char* ws; int ph_lo, ph_hi; };
static_assert(sizeof(Args) == 29 * 8 + 8 + 8 + 8, "Args has no padding");
__global__ void __launch_bounds__(NTHR, 2) mk_fwd(Args args) {
    extern __shared__ __attribute__((aligned(16))) unsigned char lds[];
    Frame F;
    F.lds = (LAS unsigned char*)lds; F.MISC = (volatile LAS unsigned*)(F.lds + MISC_OFF);
    F.tid = threadIdx.x; F.lane = F.tid & 63; F.wave = __builtin_amdgcn_readfirstlane(F.tid >> 6); F.G = gridDim.x; F.bid = blockIdx.x;
    F.out = args.out; F.ws = args.ws; F.ctl = (gu32*)(args.ws + WS_CTL);
    for (int u = F.tid; u < (LDS_BYTES - LDSCTL_OFF) / 4; u += NTHR) ((LAS unsigned*)(F.lds + LDSCTL_OFF))[u] = 0u;
    __syncthreads();
    const bool multi = args.ph_hi - args.ph_lo > 1;
    XcdBarrier bar; bar.bar = (unsigned*)(F.ctl + CW_BAR); bar.x = 0; bar.st = nullptr;
    if (multi) bar = xcd_barrier_post((unsigned*)(F.ctl + CW_BAR), F.MISC + 8);
    for (int ph = args.ph_lo; ph < args.ph_hi; ++ph) {
#ifndef PHM
#define PHM 0x3ff
#endif
#ifndef DBL
#define DBL 0
#endif
        const int nrep_ = (DBL != 0 && ((ph == 0) ? ((DBL >> 9) & 1) : ((DBL >> ((ph - 1) % NST)) & 1))) ? 2 : 1;
        for (int rep_ = 0; rep_ < nrep_; ++rep_) {
        { unsigned zoff; asm volatile("s_mov_b32 %0, 0" : "=s"(zoff));
          F.ws = args.ws + zoff; F.out = args.out + zoff; F.inb = args.in; F.zoff = zoff;
          int tl = threadIdx.x; asm volatile("" : "+v"(tl)); F.tid = tl; F.lane = tl & 63; F.wave = __builtin_amdgcn_readfirstlane(tl >> 6); F.rep = rep_; }
        if (rep_) { XcdBarrier b2 = bar; unsigned* bb = bar.bar; unsigned xx = bar.x; asm volatile("" : "+s"(bb), "+s"(xx)); b2.bar = bb; b2.x = xx; xcd_barrier(b2); }
        if (ph == 0) { if (PHM & 1) p0_prologue(F); }
        else {
            const int l = (ph - 1) / NST, st = (ph - 1) % NST;
            unsigned char* wb = F.ws + WS_W + (size_t)l * LW;
            if (st == 0 && (PHM & 2)) {
                pg8::Gemm g{(const bf16*)(F.ws + WS_XB), (const bf16*)(wb + W_IN), MT, IN_COLS, DM}; pg8::StaticOrder S; S.init(MT, IN_COLS, F.G, F.bid);
                pg8::EpiHRot E{(bf16*)(F.ws + WS_H), IN_COLS, (const float*)(F.ws + WS_TAB)};
                pg8::gemm_phase<pg8::EpiHRot, pg8::StaticOrder, true, true>(F.lds, g, S, E);
            } else if (st == 1) { if (PHM & 4) pa_phase(F, l); }
            else if (st == 2) { if (PHM & 8) mixers_phase(F, l); }
            else if (st == 3) { if (PHM & 16) post_phase(F, l); }
            else if (st == 4) { if (PHM & 32) {
                pg8::Gemm g{(const bf16*)(F.ws + WS_MIX), (const bf16*)(wb + W_OUT), MP, DM, DM}; pg8::StaticOrder S; S.init(MP, DM, F.G, F.bid);
                const float* bP = l == 0 ? inp(F, 0) : (const float*)(F.ws + WS_XF); const float* bS = l == 0 ? inp(F, 1) : (const float*)(F.ws + WS_XF) + (size_t)MP * DM;
                pg8::EpiResF32 E{bP, bS, (float*)(F.ws + WS_V), DN_ALPHA, MP, MV};
                pg8::gemm_phase<pg8::EpiResF32, pg8::StaticOrder, true, true>(F.lds, g, S, E);
                skinny_tail(F, (const bf16*)(F.ws + WS_MIX) + (size_t)MP * DM, (const bf16*)(wb + W_OUT), DM, bS, (float*)(F.ws + WS_V), DN_ALPHA); }
            } else if (st == 5) ln_phase(F, (const float*)(F.ws + WS_V), inp(F, 22) + l * DM, inp(F, 23) + l * DM, (float*)(F.ws + WS_X1F), (float*)(F.ws + WS_X1F) + (size_t)MP * DM, (bf16*)(F.ws + WS_X1B));
            else if (st == 6) { if (PHM & 64) {
                pg8::Gemm g{(const bf16*)(F.ws + WS_X1B), (const bf16*)(wb + W_GU), MT, NGU, DM}; pg8::StaticOrder S; S.init(MT, NGU, F.G, F.bid);
                pg8::EpiSwiglu E{(bf16*)(F.ws + WS_HFF), DFF};
                pg8::gemm_phase<pg8::EpiSwiglu, pg8::StaticOrder, true, true>(F.lds, g, S, E); }
            } else if (st == 7) { if (PHM & 128) {
                pg8::Gemm g{(const bf16*)(F.ws + WS_HFF), (const bf16*)(wb + W_D), MP, DM, DFF}; pg8::StaticOrder S; S.init(MP, DM, F.G, F.bid);
                pg8::EpiResF32 E{(const float*)(F.ws + WS_X1F), (const float*)(F.ws + WS_X1F) + (size_t)MP * DM, (float*)(F.ws + WS_V), DN_ALPHA, MP, MV};
                pg8::gemm_phase<pg8::EpiResF32, pg8::StaticOrder, true, true>(F.lds, g, S, E);
                skinny_tail(F, (const bf16*)(F.ws + WS_HFF) + (size_t)MP * DFF, (const bf16*)(wb + W_D), DFF, (const float*)(F.ws + WS_X1F) + (size_t)MP * DM, (float*)(F.ws + WS_V), DN_ALPHA); }
            } else {
                if (l == 0) ln_phase(F, (const float*)(F.ws + WS_V), inp(F, 27) + l * DM, inp(F, 28) + l * DM, (float*)(F.ws + WS_XF), (float*)(F.ws + WS_XF) + (size_t)MP * DM, (bf16*)(F.ws + WS_XB));
                else ln_phase(F, (const float*)(F.ws + WS_V), inp(F, 27) + l * DM, inp(F, 28) + l * DM, F.out + O_YP, F.out + O_YS, nullptr);
            }
        }
        }
        if (ph + 1 < args.ph_hi) { XcdBarrier b2 = bar; unsigned* bb = bar.bar; unsigned xx = bar.x; asm volatile("" : "+s"(bb), "+s"(xx)); b2.bar = bb; b2.x = xx; xcd_barrier(b2); }
    }
}

#ifndef MK_SPLIT
#define MK_SPLIT 0
#endif
extern "C" void kernel_launch(void* const* d_in, const int* in_sizes, int n_in, void* d_out, int out_size, void* d_ws, size_t ws_size, hipStream_t stream) {
    static int grid = 0;
    if (grid == 0) {
        if (n_in != 29 || out_size != (int)O_END || ws_size < WS_END) { fprintf(stderr, "kernel_launch: unexpected shapes (n_in %d out %d ws %zu)\n", n_in, out_size, ws_size); grid = -1; return; }
        int dev = 0, cus = 0, per_cu = 0;
        if (hipGetDevice(&dev) != hipSuccess || hipDeviceGetAttribute(&cus, hipDeviceAttributeMultiprocessorCount, dev) != hipSuccess) { grid = -1; return; }
        if (hipFuncSetAttribute((const void*)mk_fwd, hipFuncAttributeMaxDynamicSharedMemorySize, LDS_BYTES) != hipSuccess) { fprintf(stderr, "kernel_launch: hipFuncSetAttribute failed\n"); grid = -1; return; }
        if (hipOccupancyMaxActiveBlocksPerMultiprocessor(&per_cu, (const void*)mk_fwd, NTHR, LDS_BYTES) != hipSuccess || per_cu < 1) { fprintf(stderr, "kernel_launch: occupancy query says %d blocks per CU\n", per_cu); (void)hipGetLastError(); grid = -1; return; }
        grid = cus;
        if (grid != 256) { fprintf(stderr, "kernel_launch: built for 256 CUs, device has %d\n", cus); grid = -1; return; }
    }
    if (grid < 0) return;
    (void)hipMemsetAsync((char*)d_ws + WS_CTL, 0, CTL_ZERO_BYTES, stream);
    Args a{};
    for (int i = 0; i < 29; ++i) a.in[i] = (const float*)d_in[i];
    a.out = (float*)d_out; a.ws = (unsigned char*)d_ws;
#if MK_SPLIT
    for (int ph = 0; ph < NPHASE; ++ph) { a.ph_lo = ph; a.ph_hi = ph + 1; hipLaunchKernelGGL(mk_fwd, dim3(grid), dim3(NTHR), LDS_BYTES, stream, a); }
#else
    a.ph_lo = 0; a.ph_hi = NPHASE; hipLaunchKernelGGL(mk_fwd, dim3(grid), dim3(NTHR), LDS_BYTES, stream, a);
#endif
}
```
